# Optimizing an MI355X kernel written in HIP

```python
import jax, jax.numpy as jnp
from jax import lax
import numpy as np

D_MODEL = 1024
BATCH = 4
SEQ = 8192
DEPTH = 2

CHUNK = 64
N_EVEN = (DEPTH + 1) // 2
N_ODD = DEPTH // 2
A_WIDTH = D_MODEL // 2
A_GROUPS = 8
A_WIDTH_CONV = 31
B_WIDTH = D_MODEL // 2
B_GROUPS = 8
B_WIDTH_CONV = 3
IN_EVEN = 2 * A_WIDTH + 3 * B_WIDTH
MIX_EVEN = A_WIDTH + B_WIDTH
C_WIDTH = D_MODEL
C_GROUPS = 8
C_GROUP_DIM = C_WIDTH // C_GROUPS
C_BLOCK = 128
MEM_LEN = 256
XA_HEADS = 4
XA_HEAD_DIM = D_MODEL // XA_HEADS
D_FF = 2816
N_EXPERTS = 8
TOP_K = 2
RMS_EPS = 1e-6
LN_EPS = 1e-5

kernel_name = "hybrid_conv_gmlp_moe_encoder"


def rms_norm(x, g):
    xf = x.astype(jnp.float32)
    y = xf * lax.rsqrt(jnp.mean(xf * xf, axis=-1, keepdims=True) + RMS_EPS)
    return (y * g.astype(jnp.float32)).astype(x.dtype)


def layer_norm(x, g, b):
    xf = x.astype(jnp.float32)
    mu = jnp.mean(xf, axis=-1, keepdims=True)
    var = jnp.mean(jnp.square(xf - mu), axis=-1, keepdims=True)
    y = (xf - mu) * lax.rsqrt(var + LN_EPS)
    return (y * g.astype(jnp.float32) + b.astype(jnp.float32)).astype(x.dtype)


def causal_depthwise_conv(x, w):
    k_len, ch = w.shape
    return lax.conv_general_dilated(
        x, w[:, None, :].astype(x.dtype), window_strides=(1,), padding=[(k_len - 1, 0)],
        dimension_numbers=("NWC", "WIO", "NWC"), feature_group_count=ch)


def swiglu(h, w_gate, w_up, w_down):
    return (jax.nn.silu(h @ w_gate) * (h @ w_up)) @ w_down


def conv_mixers(h, w_in, a_conv_w, a_conv_b, a_ln_g, a_ln_b, b_conv_w, w_out):
    z = h @ w_in
    a_in, b_in = z[..., :2 * A_WIDTH], z[..., 2 * A_WIDTH:]
    a_val, a_gate = jnp.split(a_in, 2, axis=-1)
    a = a_val * jax.nn.sigmoid(a_gate)
    a = causal_depthwise_conv(a, a_conv_w) + a_conv_b.astype(a.dtype)
    a = jax.nn.silu(layer_norm(a, a_ln_g, a_ln_b))
    g_b, g_c, hb = jnp.split(b_in, 3, axis=-1)
    bo = g_b * causal_depthwise_conv(g_c * hb, b_conv_w)
    return jnp.concatenate([a, bo], axis=-1) @ w_out


def spatial_gating_mixer(h, w_in, ln_g, ln_b, w_s, b_s, w_out):
    bsz, seq, _ = h.shape
    z = jax.nn.gelu(h @ w_in)
    u, v = jnp.split(z, 2, axis=-1)
    v = layer_norm(v, ln_g, ln_b)
    v = v.reshape(bsz, seq // C_BLOCK, C_BLOCK, C_GROUPS, C_GROUP_DIM)
    pos = jnp.arange(C_BLOCK)
    mask = (pos[None, :] // CHUNK) <= (pos[:, None] // CHUNK)
    ws = jnp.where(mask[None], w_s, jnp.zeros_like(w_s)).astype(v.dtype)
    s = jnp.einsum("gij,bnjgc->bnigc", ws, v) + b_s.T[:, :, None].astype(v.dtype)
    s = s.reshape(bsz, seq, C_WIDTH)
    return (u * s) @ w_out


def memory_cross_attention(h, mem_n, w_q, w_k, w_v, w_o):
    bsz, seq, _ = h.shape
    m = mem_n.shape[1]
    q = (h @ w_q).reshape(bsz, seq, XA_HEADS, XA_HEAD_DIM)
    k = (mem_n @ w_k).reshape(bsz, m, XA_HEADS, XA_HEAD_DIM)
    v = (mem_n @ w_v).reshape(bsz, m, XA_HEADS, XA_HEAD_DIM)
    s = jnp.einsum("bshd,bmhd->bhsm", q, k).astype(jnp.float32) * (XA_HEAD_DIM ** -0.5)
    p = jax.nn.softmax(s, axis=-1).astype(v.dtype)
    o = jnp.einsum("bhsm,bmhd->bshd", p, v).reshape(bsz, seq, XA_HEADS * XA_HEAD_DIM)
    return o @ w_o


def moe_swiglu(h, w_router, w_gate, w_up, w_down):
    bsz, seq, d = h.shape
    t = h.reshape(bsz * seq, d)
    logits = (t @ w_router).astype(jnp.float32)
    top_v, top_i = lax.top_k(logits, TOP_K)
    top_w = jax.nn.softmax(top_v, axis=-1)
    gates = jnp.sum(jax.nn.one_hot(top_i, N_EXPERTS, dtype=jnp.float32) * top_w[..., None], axis=1)
    gates = gates.astype(t.dtype)
    out = jnp.zeros_like(t)
    for e in range(N_EXPERTS):
        out = out + gates[:, e:e + 1] * swiglu(t, w_gate[e], w_up[e], w_down[e])
    return out.reshape(bsz, seq, d)


def setup_inputs(seed: int = 0) -> dict:
    key = jax.random.key(seed)
    ks = iter(jax.random.split(key, 40))
    f32 = jnp.float32

    def nrm(shape, scale):
        return jax.random.normal(next(ks), shape, f32) * scale

    def gain(shape):
        return 1.0 + 0.05 * jax.random.normal(next(ks), shape, f32)

    d = D_MODEL
    return {
        "x": nrm((BATCH, SEQ, d), 1.0),
        "mem": nrm((BATCH, MEM_LEN, d), 1.0),
        "norm_mix_g": gain((DEPTH, d)),
        "norm_xattn_g": gain((DEPTH, d)),
        "norm_mem_g": gain((DEPTH, d)),
        "norm_ffn_g": gain((DEPTH, d)),
        "final_norm_g": gain((d,)),
        "xa_w_q": nrm((DEPTH, d, d), d ** -0.5),
        "xa_w_k": nrm((DEPTH, d, d), d ** -0.5),
        "xa_w_v": nrm((DEPTH, d, d), d ** -0.5),
        "xa_w_o": nrm((DEPTH, d, d), d ** -0.5),
        "cv_w_in": nrm((N_EVEN, d, IN_EVEN), d ** -0.5),
        "cv_a_conv_w": nrm((N_EVEN, A_WIDTH_CONV, A_WIDTH), A_WIDTH_CONV ** -0.5),
        "cv_a_conv_b": nrm((N_EVEN, A_WIDTH), 0.02),
        "cv_a_ln_g": gain((N_EVEN, A_WIDTH)),
        "cv_a_ln_b": nrm((N_EVEN, A_WIDTH), 0.02),
        "cv_b_conv_w": nrm((N_EVEN, B_WIDTH_CONV, B_WIDTH), B_WIDTH_CONV ** -0.5),
        "cv_w_out": nrm((N_EVEN, MIX_EVEN, d), MIX_EVEN ** -0.5),
        "ffn_w_gate": nrm((N_EVEN, d, D_FF), d ** -0.5),
        "ffn_w_up": nrm((N_EVEN, d, D_FF), d ** -0.5),
        "ffn_w_down": nrm((N_EVEN, D_FF, d), D_FF ** -0.5),
        "sg_w_in": nrm((N_ODD, d, 2 * C_WIDTH), d ** -0.5),
        "sg_ln_g": gain((N_ODD, C_WIDTH)),
        "sg_ln_b": nrm((N_ODD, C_WIDTH), 0.02),
        "sg_w_s": nrm((N_ODD, C_GROUPS, C_BLOCK, C_BLOCK), C_BLOCK ** -0.5),
        "sg_b_s": gain((N_ODD, C_GROUPS, C_BLOCK)),
        "sg_w_out": nrm((N_ODD, C_WIDTH, d), C_WIDTH ** -0.5),
        "moe_w_router": nrm((N_ODD, d, N_EXPERTS), d ** -0.5),
        "moe_w_gate": nrm((N_ODD, N_EXPERTS, d, D_FF), d ** -0.5),
        "moe_w_up": nrm((N_ODD, N_EXPERTS, d, D_FF), d ** -0.5),
        "moe_w_down": nrm((N_ODD, N_EXPERTS, D_FF, d), D_FF ** -0.5),
    }


def reference(x, mem, norm_mix_g, norm_xattn_g, norm_mem_g, norm_ffn_g, final_norm_g,
              xa_w_q, xa_w_k, xa_w_v, xa_w_o,
              cv_w_in, cv_a_conv_w, cv_a_conv_b, cv_a_ln_g, cv_a_ln_b, cv_b_conv_w, cv_w_out,
              ffn_w_gate, ffn_w_up, ffn_w_down,
              sg_w_in, sg_ln_g, sg_ln_b, sg_w_s, sg_b_s, sg_w_out,
              moe_w_router, moe_w_gate, moe_w_up, moe_w_down):
    h = x
    for i in range(DEPTH):
        j = i // 2
        hn = rms_norm(h, norm_mix_g[i])
        if i % 2 == 0:
            h = h + conv_mixers(hn, cv_w_in[j], cv_a_conv_w[j], cv_a_conv_b[j], cv_a_ln_g[j],
                                cv_a_ln_b[j], cv_b_conv_w[j], cv_w_out[j])
        else:
            h = h + spatial_gating_mixer(hn, sg_w_in[j], sg_ln_g[j], sg_ln_b[j], sg_w_s[j],
                                         sg_b_s[j], sg_w_out[j])
        h = h + memory_cross_attention(rms_norm(h, norm_xattn_g[i]), rms_norm(mem, norm_mem_g[i]),
                                       xa_w_q[i], xa_w_k[i], xa_w_v[i], xa_w_o[i])
        hn = rms_norm(h, norm_ffn_g[i])
        if i % 2 == 0:
            h = h + swiglu(hn, ffn_w_gate[j], ffn_w_up[j], ffn_w_down[j])
        else:
            h = h + moe_swiglu(hn, moe_w_router[j], moe_w_gate[j], moe_w_up[j], moe_w_down[j])
    return rms_norm(h, final_norm_g)
```

```cpp
#include <hip/hip_runtime.h>
#include <cstdio>
#include <cstdint>
#define FK_MODE 1
#define FK_NSUB 0
namespace fk {
#define LAS __attribute__((address_space(3)))
#define GAS __attribute__((address_space(1)))
typedef unsigned short bf16_t;
typedef short bf16x8 __attribute__((ext_vector_type(8)));
typedef float f32x4 __attribute__((ext_vector_type(4)));
typedef float f32x2 __attribute__((ext_vector_type(2)));
typedef unsigned u32x4 __attribute__((ext_vector_type(4)));
typedef unsigned u32x2 __attribute__((ext_vector_type(2)));
typedef int i32x4 __attribute__((ext_vector_type(4)));
typedef GAS unsigned gu32;

constexpr int NTOK = 32768, DM = 1024, SEQL = 8192, MEML = 256, DFF = 2816, NEXP = 8;
constexpr int ZW = 1536;
constexpr int HALF_TILES = 136, HALF_ROWS = HALF_TILES * 256;
constexpr int BM = 256, BK = 64, HALF = 128, HTB = HALF * BK * 2, NXCD = 8, WGM = 8;

constexpr int RING_OFF = 0, RING_BYTES = 131072;
constexpr int LDSCTL_OFF = RING_BYTES, MISC_OFF = LDSCTL_OFF + 320;
constexpr int TAB_OFF = LDSCTL_OFF + 512;
constexpr int MT_OFF = TAB_OFF + 8192;
constexpr int RSCR_OFF = MT_OFF + 256;
constexpr int LDS_BYTES = 147456;
static_assert(RSCR_OFF + 4096 <= LDS_BYTES, "LDS map");

constexpr size_t MiB = 1u << 20;
constexpr size_t WS_CTL = 0, CTL_ZERO_BYTES = 64 * 1024;
constexpr size_t WS_RSS = 1 * MiB;
constexpr size_t WS_VST = 2 * MiB;
constexpr size_t WS_TSL = 3 * MiB;
constexpr size_t WS_STOK = 4 * MiB;
constexpr size_t WS_SGW = 6 * MiB;
constexpr size_t WS_MEMN = 8 * MiB;
constexpr size_t WS_KP = 12 * MiB;
constexpr size_t WS_WGU1 = 20 * MiB;
constexpr size_t WS_WD1 = 64 * MiB;
constexpr size_t WS_HB = 86 * MiB;
constexpr size_t WS_HB8 = 150 * MiB;
constexpr size_t WS_WIN0 = 182 * MiB;
constexpr size_t WS_WOUT0 = 187 * MiB;
constexpr size_t WS_WGU0 = 189 * MiB;
constexpr size_t WS_WD0 = 200 * MiB;
constexpr size_t WS_WQS = 206 * MiB;
constexpr size_t WS_WOT = 210 * MiB;
constexpr size_t WS_WKT = 214 * MiB;
constexpr size_t WS_MK = 222 * MiB;
constexpr size_t WS_WSG = 254 * MiB;
constexpr size_t WS_WSO = 258 * MiB;
constexpr size_t WS_R = 262 * MiB;
constexpr size_t WS_ZB = WS_R, WS_MIX = WS_R + 96 * MiB, WS_PB = WS_R, WS_ACT0 = WS_R, WS_UV = WS_R, WS_US = WS_R + 128 * MiB;
constexpr int SEGCAP = 32768;
constexpr int MOE_TILES = 2 * HALF_TILES;
constexpr size_t WS_ACT8 = 182 * MiB;
constexpr size_t WS_Y = 369 * MiB;
constexpr size_t WS_END = 512 * MiB;
static_assert(WS_ACT8 + (size_t)MOE_TILES * 256 * DFF <= WS_Y && WS_Y + (size_t)MOE_TILES * 256 * DM * 2 <= WS_END && WS_R + 216 * MiB <= WS_END, "ws map");
constexpr int CW_SEG = 512;
constexpr int CW_BAR = 1024;

#define RLX_AGENT __ATOMIC_RELAXED, __HIP_MEMORY_SCOPE_AGENT
#define LDS_WAIT() asm volatile("s_waitcnt lgkmcnt(0)" ::: "memory")
#define VM_WAIT() asm volatile("s_waitcnt vmcnt(0)" ::: "memory")
__device__ __forceinline__ unsigned cvt_pk_bf16(float lo, float hi) { unsigned r; asm volatile("v_cvt_pk_bf16_f32 %0, %1, %2" : "=v"(r) : "v"(lo), "v"(hi)); return r; }
__device__ __forceinline__ float bf_lo(unsigned w) { return __uint_as_float(w << 16); }
__device__ __forceinline__ float bf_hi(unsigned w) { return __uint_as_float(w & 0xffff0000u); }
__device__ __forceinline__ float fast_sigmoid(float x) { return __builtin_amdgcn_rcpf(1.0f + __builtin_amdgcn_exp2f(-1.4426950408889634f * x)); }
__device__ __forceinline__ float fast_exp(float x) { return __builtin_amdgcn_exp2f(1.4426950408889634f * x); }
__device__ __forceinline__ float gelu_tanh_f(float x) { const float y = 1.5957691216057308f * (x + 0.044715f * x * x * x); return x * fast_sigmoid(y); }
__device__ __forceinline__ float wave_sum(float v) {
#pragma unroll
    for (int o = 1; o < 64; o <<= 1) v += __shfl_xor(v, o);
    return v;
}
__device__ __forceinline__ float rstd_from_rss(const float* RSS4, int row) { const f32x4 s = *(const f32x4*)(RSS4 + (size_t)row * 4); return rsqrtf(((s.x + s.y) + (s.z + s.w)) * (1.0f / DM) + 1e-6f); }

__host__ __device__ __forceinline__ int lds_byte(int r, int c) { const int st = (r >> 4) * 2 + (c >> 5), rr = r & 15, cc = c & 31, ob = rr * 64 + cc * 2; return st * 1024 + (ob ^ (((ob >> 9) & 1) << 5)); }
__host__ __device__ __forceinline__ void stage_rc(int b, int& R, int& C) { const int st = b / 1024, sb = b % 1024, swz = sb ^ (((sb >> 9) & 1) << 5); R = (st >> 1) * 16 + swz / 64; C = (st & 1) * 32 + (swz % 64) / 2; }
__host__ __device__ __forceinline__ int perm32(int rho) { const int n = rho >> 4, i = rho & 15; return 8 * (i >> 2) + 4 * n + (i & 3); }

struct Unit { const char* A; const char* B; int pm, pn, aux, aux2; };

__device__ __forceinline__ bool tile_order(int i, int G, int c, int nM, int nN, int& pm, int& pn) {
    const int nwg = nM * nN; const long L = (long)i * G + c; if (L >= nwg) return false;
    int wgid = (int)L; { const int q = nwg / NXCD, r = nwg % NXCD, xcd = wgid % NXCD, off = wgid / NXCD; wgid = (xcd < r ? xcd * (q + 1) : r * (q + 1) + (xcd - r) * q) + off; }
    const int nig = WGM * nN, gid = wgid / nig, fm = gid * WGM, gsz = (nM - fm) < WGM ? (nM - fm) : WGM;
    pm = fm + ((wgid % nig) % gsz); pn = (wgid % nig) / gsz; return true;
}
struct DenseOrder {
    const char* A; const char* Bt; int lda, ldb, nM, nN, G, c, pm_per_b; size_t bstride; int rev;
    __device__ __forceinline__ void init(const void* A_, const void* Bt_, int M, int N, int lda_, int ldb_, int G_, int c_, int pmb = 0, size_t bs = 0) {
        A = (const char*)A_; Bt = (const char*)Bt_; lda = lda_; ldb = ldb_; nM = M / BM; nN = N / BM; G = G_; c = c_; pm_per_b = pmb; bstride = bs; rev = 0; }
    __device__ __forceinline__ bool next(int i, Unit& u) const {
        int pm, pn; if (!tile_order(i, G, c, nM, nN, pm, pn)) return false;
        if (rev) pm = nM - 1 - pm;
        u.pm = pm; u.pn = pn; u.aux = 0; u.aux2 = 0; u.A = A + (size_t)pm * BM * lda * 2; u.B = Bt + (size_t)pn * BM * ldb * 2 + (pm_per_b ? (size_t)(pm / pm_per_b) * bstride : 0); return true; }
};

typedef int v4i_t __attribute__((ext_vector_type(4)));
typedef int v8i_t __attribute__((ext_vector_type(8)));
__device__ __forceinline__ v8i_t lds_ld32(const LAS unsigned char* p) { const v4i_t a = *(const LAS v4i_t*)p, b = *(const LAS v4i_t*)(p + 1024); return __builtin_shufflevector(a, b, 0, 1, 2, 3, 4, 5, 6, 7); }
template <class Epi, class Sched, bool GATHER = false, bool FP8 = false, bool ALIGN_EPI = true, bool SP2 = true>
__device__ __forceinline__ void gemm_phase(LAS unsigned char* lds, const int K, const int lda, const int ldb, const Sched& S, const Epi& E) {
    int tid_ = threadIdx.x; asm volatile("" : "+v"(tid_));
    const int tid = tid_, wid = __builtin_amdgcn_readfirstlane(tid >> 6), lane = tid & 63, wr = wid >> 2, wc = wid & 3, fr = lane & 15, fq = lane >> 4;
    int K_ = K; asm volatile("" : "+s"(K_));
    constexpr int ES = FP8 ? 1 : 2;
    const int nt = K_ * ES / 128;
    unsigned voffA[2][2], voffB[2];
#pragma unroll
    for (int i = 0; i < 2; ++i) { int R, C; stage_rc(tid * 16 + i * 8192, R, C); const int Rb = Epi::PERM ? ((R & ~31) + perm32(R & 31)) : R;
        voffA[0][i] = (unsigned)(R * lda * ES + C * 2); voffA[1][i] = (unsigned)((R + HALF) * lda * ES + C * 2); voffB[i] = (unsigned)(Rb * ldb * ES + C * 2); }
#define PG8_GIDX(dst, un) do { _Pragma("unroll") for (int _h = 0; _h < 2; ++_h) _Pragma("unroll") for (int _i = 0; _i < 2; ++_i) { int _R0, _C0; stage_rc(tid * 16 + _i * 8192, _R0, _C0); const int _R = _R0 + HALF * _h, _m = (un).aux2 - 1; \
        dst[_h][_i] = S.stok[(un).pm + (_R < _m ? _R : _m)]; } } while (0)
#define PG8_GOFF(dst, src) do { _Pragma("unroll") for (int _h = 0; _h < 2; ++_h) _Pragma("unroll") for (int _i = 0; _i < 2; ++_i) { int _R0, _C0; stage_rc(tid * 16 + _i * 8192, _R0, _C0); dst[_h][_i] = (unsigned)(src[_h][_i] * lda * ES + _C0 * 2); } } while (0)
    const size_t kstep = (size_t)(BK * 2);
    const size_t hstepB = (size_t)HALF * ldb * ES;
    const unsigned ldsw = (unsigned)wid * 1024u;
    const int aoff = lds_byte(wr * 64 + fr, fq * 8), boff = lds_byte(wc * 32 + fr, fq * 8);
#define PG8_SA(b, h) (((b) * 2 + (h)) * HTB)
#define PG8_SB(b, h) ((4 + (b) * 2 + (h)) * HTB)
#define PG8_STAGE(bufoff, gbase, voff) do { _Pragma("unroll") for (int _i = 0; _i < 2; ++_i) { unsigned _o = (voff)[_i]; asm volatile("" : "+v"(_o));     \
        __builtin_amdgcn_global_load_lds((const unsigned*)((const char*)(gbase) + _o), (LAS unsigned*)(lds + (bufoff) + ldsw + _i * 8192), 16, 0, 0); } } while (0)
#define PG8_LDA(dst, b, h) do { if constexpr (FP8) { _Pragma("unroll") for (int m = 0; m < 4; ++m) dst##8[m] = lds_ld32(lds + PG8_SA(b, h) + aoff + m * 2048); } else { \
        _Pragma("unroll") for (int m = 0; m < 4; ++m) _Pragma("unroll") for (int k = 0; k < 2; ++k) dst[m][k] = *(const LAS bf16x8*)(lds + PG8_SA(b, h) + aoff + m * 2048 + k * 1024); } } while (0)
#define PG8_LDB(dst, b, h) do { if constexpr (FP8) { _Pragma("unroll") for (int n = 0; n < 2; ++n) dst##8[n] = lds_ld32(lds + PG8_SB(b, h) + boff + n * 2048); } else { \
        _Pragma("unroll") for (int n = 0; n < 2; ++n) _Pragma("unroll") for (int k = 0; k < 2; ++k) dst[n][k] = *(const LAS bf16x8*)(lds + PG8_SB(b, h) + boff + n * 2048 + k * 1024); } } while (0)
#define PG8_MMA8(ai, bj, At8, Bt8) asm volatile("s_nop 1\n\t" \
        "v_mfma_f32_16x16x128_f8f6f4 %0, %12, %8, %0\n\tv_mfma_f32_16x16x128_f8f6f4 %1, %13, %8, %1\n\t" \
        "v_mfma_f32_16x16x128_f8f6f4 %2, %12, %9, %2\n\tv_mfma_f32_16x16x128_f8f6f4 %3, %13, %9, %3\n\t" \
        "v_mfma_f32_16x16x128_f8f6f4 %4, %12, %10, %4\n\tv_mfma_f32_16x16x128_f8f6f4 %5, %13, %10, %5\n\t" \
        "v_mfma_f32_16x16x128_f8f6f4 %6, %12, %11, %6\n\tv_mfma_f32_16x16x128_f8f6f4 %7, %13, %11, %7" \
        : "+v"(acc[ai][bj][0][0]), "+v"(acc[ai][bj][0][1]), "+v"(acc[ai][bj][1][0]), "+v"(acc[ai][bj][1][1]), "+v"(acc[ai][bj][2][0]), "+v"(acc[ai][bj][2][1]), "+v"(acc[ai][bj][3][0]), "+v"(acc[ai][bj][3][1]) \
        : "v"(At8[0]), "v"(At8[1]), "v"(At8[2]), "v"(At8[3]), "v"(Bt8[0]), "v"(Bt8[1]))
#define PG8_MMA(ai, bj, At, Bt) do { __builtin_amdgcn_s_setprio(1); if constexpr (FP8) { PG8_MMA8(ai, bj, At##8, Bt##8); } else { \
        _Pragma("unroll") for (int m = 0; m < 4; ++m) _Pragma("unroll") for (int n = 0; n < 2; ++n) _Pragma("unroll") for (int k = 0; k < 2; ++k) \
        acc[ai][bj][m][n] = __builtin_amdgcn_mfma_f32_16x16x32_bf16(Bt[n][k], At[m][k], acc[ai][bj][m][n], 0, 0, 0); } __builtin_amdgcn_s_setprio(0); } while (0)
#define PG8_WAIT_V(n) asm volatile("s_waitcnt vmcnt(" #n ")" ::: "memory")
#define PG8_WAIT_L(n) asm volatile("s_waitcnt lgkmcnt(" #n ")" ::: "memory")
#define PG8_BAR __builtin_amdgcn_s_barrier()
#define PG8_SCHED __builtin_amdgcn_sched_barrier(0)
    Unit cur, nxt; int ui = 0;
    if (!S.next(0, cur)) return;
    f32x4 acc[2][2][4][2];
#pragma unroll
    for (int a = 0; a < 2; ++a)
#pragma unroll
        for (int b = 0; b < 2; ++b)
#pragma unroll
            for (int m = 0; m < 4; ++m)
#pragma unroll
                for (int n = 0; n < 2; ++n) acc[a][b][m][n] = (f32x4){0.f, 0.f, 0.f, 0.f};
    bf16x8 At[4][2], B0[2][2], B1[2][2]; v8i_t At8[4], B08[2], B18[2];
    const char* cA = cur.A; const char* cB = cur.B;
    int ntok[2][2] = {{0, 0}, {0, 0}}, ntok2[2][2] = {{0, 0}, {0, 0}};
    if constexpr (GATHER) { PG8_GIDX(ntok, cur); PG8_GOFF(voffA, ntok); Unit u1; if (S.next(1, u1)) PG8_GIDX(ntok, u1); }
    if constexpr (SP2) {
        PG8_STAGE(PG8_SB(0, 0), cB, voffB); PG8_STAGE(PG8_SB(0, 1), cB + hstepB, voffB); PG8_STAGE(PG8_SA(0, 0), cA, voffA[0]); PG8_STAGE(PG8_SA(0, 1), cA, voffA[1]);
        if (wr == 1) PG8_BAR;
        PG8_WAIT_V(2); PG8_BAR;
        PG8_STAGE(PG8_SB(1, 0), cB + kstep, voffB); PG8_STAGE(PG8_SA(1, 0), cA + kstep, voffA[0]); PG8_STAGE(PG8_SB(1, 1), cB + hstepB + kstep, voffB);
        PG8_WAIT_V(6); PG8_BAR;
    } else {
        PG8_STAGE(PG8_SB(0, 0), cB, voffB); PG8_STAGE(PG8_SA(0, 0), cA, voffA[0]); PG8_STAGE(PG8_SB(0, 1), cB + hstepB, voffB); PG8_STAGE(PG8_SA(0, 1), cA, voffA[1]);
        if (wr == 1) PG8_BAR;
        PG8_WAIT_V(4); PG8_BAR;
        PG8_STAGE(PG8_SB(1, 0), cB + kstep, voffB); PG8_STAGE(PG8_SA(1, 0), cA + kstep, voffA[0]); PG8_STAGE(PG8_SB(1, 1), cB + hstepB + kstep, voffB);
        PG8_WAIT_V(6); PG8_BAR;
    }
    for (;;) {
        const bool has_next = S.next(ui + 1, nxt);
        const char* nA = has_next ? nxt.A : cA; const char* nB = has_next ? nxt.B : cB;
        Unit u2; const bool has_next2 = GATHER ? S.next(ui + 2, u2) : false;
        for (int t = 0; t < nt; t += 2) {
            const bool last = (t == nt - 2);
            unsigned v2A[2][2];
#pragma unroll
            for (int _h = 0; _h < 2; ++_h)
#pragma unroll
                for (int _i = 0; _i < 2; ++_i) v2A[_h][_i] = voffA[_h][_i];
            if constexpr (GATHER) { if (t == 0 && has_next2) PG8_GIDX(ntok2, u2);
                if (last && has_next) PG8_GOFF(v2A, ntok); }
            const char* a1 = cA + (size_t)(t + 1) * kstep;
            const char* a2 = last ? nA : cA + (size_t)(t + 2) * kstep; const char* b2 = last ? nB : cB + (size_t)(t + 2) * kstep;
            const char* a3 = a2 + kstep; const char* b3 = b2 + kstep;
            if constexpr (SP2) {
            PG8_LDB(B0, 0, 0); PG8_LDB(B1, 0, 1); PG8_SCHED; PG8_LDA(At, 0, 0); PG8_STAGE(PG8_SA(1, 1), a1, voffA[1]);
            PG8_WAIT_V(8); PG8_WAIT_L(0); PG8_BAR; PG8_MMA(0, 0, At, B0); PG8_MMA(0, 1, At, B1); PG8_BAR; PG8_SCHED;
            PG8_LDA(At, 0, 1); PG8_STAGE(PG8_SB(0, 0), b2, voffB); PG8_STAGE(PG8_SB(0, 1), b2 + hstepB, voffB); PG8_STAGE(PG8_SA(0, 0), a2, v2A[0]);
            PG8_WAIT_V(8); PG8_WAIT_L(0); PG8_BAR; PG8_MMA(1, 0, At, B0); PG8_MMA(1, 1, At, B1); PG8_BAR; PG8_SCHED;
            PG8_LDB(B0, 1, 0); PG8_LDB(B1, 1, 1); PG8_SCHED; PG8_LDA(At, 1, 0); PG8_STAGE(PG8_SA(0, 1), a2, v2A[1]);
            PG8_WAIT_V(8); PG8_WAIT_L(0); PG8_BAR; PG8_MMA(0, 0, At, B0); PG8_MMA(0, 1, At, B1); PG8_BAR; PG8_SCHED;
            PG8_LDA(At, 1, 1); PG8_STAGE(PG8_SB(1, 0), b3, voffB); PG8_STAGE(PG8_SB(1, 1), b3 + hstepB, voffB); PG8_STAGE(PG8_SA(1, 0), a3, v2A[0]);
            PG8_WAIT_V(8); PG8_WAIT_L(0); PG8_BAR; PG8_MMA(1, 0, At, B0); PG8_MMA(1, 1, At, B1); PG8_BAR; PG8_SCHED;
            } else {
            PG8_LDB(B0, 0, 0); PG8_SCHED; PG8_LDA(At, 0, 0); PG8_STAGE(PG8_SA(1, 1), a1, voffA[1]);
            PG8_WAIT_L(8); PG8_BAR; PG8_WAIT_L(0); PG8_MMA(0, 0, At, B0); PG8_BAR; PG8_SCHED;
            PG8_LDB(B1, 0, 1); PG8_STAGE(PG8_SB(0, 0), b2, voffB);
            PG8_BAR; PG8_WAIT_L(0); PG8_MMA(0, 1, At, B1); PG8_BAR;
            PG8_LDA(At, 0, 1); PG8_STAGE(PG8_SA(0, 0), a2, v2A[0]);
            PG8_BAR; PG8_WAIT_L(0); PG8_MMA(1, 0, At, B0); PG8_BAR; PG8_SCHED;
            PG8_STAGE(PG8_SB(0, 1), b2 + hstepB, voffB);
            PG8_WAIT_V(6); PG8_BAR; PG8_MMA(1, 1, At, B1); PG8_BAR;
            PG8_LDB(B0, 1, 0); PG8_SCHED; PG8_LDA(At, 1, 0); PG8_STAGE(PG8_SA(0, 1), a2, v2A[1]);
            PG8_WAIT_L(8); PG8_BAR; PG8_WAIT_L(0); PG8_MMA(0, 0, At, B0); PG8_BAR; PG8_SCHED;
            PG8_LDB(B1, 1, 1); PG8_STAGE(PG8_SB(1, 0), b3, voffB);
            PG8_BAR; PG8_WAIT_L(0); PG8_MMA(0, 1, At, B1); PG8_BAR;
            PG8_LDA(At, 1, 1); PG8_STAGE(PG8_SA(1, 0), a3, v2A[0]);
            PG8_BAR; PG8_WAIT_L(0); PG8_MMA(1, 0, At, B0); PG8_BAR; PG8_SCHED;
            PG8_STAGE(PG8_SB(1, 1), b3 + hstepB, voffB);
            PG8_WAIT_V(6); PG8_BAR; PG8_MMA(1, 1, At, B1); PG8_BAR;
            }
        }
        if constexpr (ALIGN_EPI) { if (wr == 0) PG8_BAR; }
        if constexpr (FP8) asm volatile("s_nop 15\n\ts_nop 15" ::: "memory");
        E(acc, cur, wr, wc, fr, fq, tid);
        if (!has_next) break;
#pragma unroll
        for (int a = 0; a < 2; ++a)
#pragma unroll
            for (int b = 0; b < 2; ++b)
#pragma unroll
                for (int m = 0; m < 4; ++m)
#pragma unroll
                    for (int n = 0; n < 2; ++n) acc[a][b][m][n] = (f32x4){0.f, 0.f, 0.f, 0.f};
        cur = nxt; cA = nA; cB = nB; ++ui;
        if constexpr (GATHER) { PG8_GOFF(voffA, ntok);
#pragma unroll
            for (int _h = 0; _h < 2; ++_h)
#pragma unroll
                for (int _i = 0; _i < 2; ++_i) ntok[_h][_i] = ntok2[_h][_i]; }
        if constexpr (ALIGN_EPI) { if (wr == 1) PG8_BAR; }
    }
    PG8_WAIT_V(0);
    if constexpr (!ALIGN_EPI) { if (wr == 0) PG8_BAR; }
    PG8_BAR;
#undef PG8_SA
#undef PG8_SB
#undef PG8_STAGE
#undef PG8_LDA
#undef PG8_LDB
#undef PG8_MMA
#undef PG8_MMA8
#undef PG8_WAIT_V
#undef PG8_WAIT_L
#undef PG8_BAR
#undef PG8_SCHED
#undef PG8_GOFF
#undef PG8_GIDX
}

#define EPI_BAR() do { asm volatile("s_waitcnt lgkmcnt(0)" ::: "memory"); __builtin_amdgcn_s_barrier(); asm volatile("" ::: "memory"); } while (0)
typedef f32x4 acc_t[2][2][4][2];

struct EpiPlain {
    static constexpr bool PERM = true;
    bf16_t* O; int ldc; size_t aux_stride;
    __device__ __forceinline__ void operator()(acc_t& acc, const Unit& u, int wr, int wc, int fr, int fq, int tid) const {
        bf16_t* base = O + (size_t)u.aux * aux_stride + (size_t)(u.pm * BM + wr * 64 + fr) * ldc + u.pn * BM + wc * 32 + 8 * fq;
#pragma unroll
        for (int ai = 0; ai < 2; ++ai)
#pragma unroll
            for (int m = 0; m < 4; ++m) { bf16_t* rowp = base + (size_t)(ai * HALF + m * 16) * ldc;
#pragma unroll
                for (int bj = 0; bj < 2; ++bj) { const f32x4 v0 = acc[ai][bj][m][0], v1 = acc[ai][bj][m][1];
                    u32x4 w; w.x = cvt_pk_bf16(v0[0], v0[1]); w.y = cvt_pk_bf16(v0[2], v0[3]); w.z = cvt_pk_bf16(v1[0], v1[1]); w.w = cvt_pk_bf16(v1[2], v1[3]);
                    *(u32x4*)(rowp + bj * HALF) = w; } }
    }
};

struct EpiGluZ {
    static constexpr bool PERM = true;
    bf16_t* ZB; const float* RSS4;
    __device__ __forceinline__ void operator()(acc_t& acc, const Unit& u, int wr, int wc, int fr, int fq, int tid) const {
        const int pn = u.pn;
#pragma unroll
        for (int ai = 0; ai < 2; ++ai)
#pragma unroll
            for (int m = 0; m < 4; ++m) {
                const int r = u.pm * BM + ai * HALF + wr * 64 + m * 16 + fr; const float rs = rstd_from_rss(RSS4, r);
                bf16_t* rowp = ZB + (size_t)r * ZW + wc * 32 + 8 * fq;
                if (pn < 4 || pn >= 6) {
                    float o[8];
#pragma unroll
                    for (int n = 0; n < 2; ++n)
#pragma unroll
                        for (int e = 0; e < 4; ++e) { const float a = acc[ai][0][m][n][e] * rs, b = acc[ai][1][m][n][e] * rs; o[n * 4 + e] = (pn < 4) ? a * fast_sigmoid(b) : a * b; }
                    u32x4 w; w.x = cvt_pk_bf16(o[0], o[1]); w.y = cvt_pk_bf16(o[2], o[3]); w.z = cvt_pk_bf16(o[4], o[5]); w.w = cvt_pk_bf16(o[6], o[7]);
                    *(u32x4*)(rowp + (pn < 4 ? 128 * pn : 1024 + 128 * (pn - 6))) = w;
                } else {
#pragma unroll
                    for (int bj = 0; bj < 2; ++bj) { const f32x4 v0 = acc[ai][bj][m][0] * rs, v1 = acc[ai][bj][m][1] * rs;
                        u32x4 w; w.x = cvt_pk_bf16(v0[0], v0[1]); w.y = cvt_pk_bf16(v0[2], v0[3]); w.z = cvt_pk_bf16(v1[0], v1[1]); w.w = cvt_pk_bf16(v1[2], v1[3]);
                        *(u32x4*)(rowp + 512 + 256 * (pn - 4) + bj * HALF) = w; }
                }
            }
    }
};

template <bool MOE> struct EpiSwiGLU {
    static constexpr bool PERM = true;
    bf16_t* ACT; int ldc; const float* RSx;
    __device__ __forceinline__ void operator()(acc_t& acc, const Unit& u, int wr, int wc, int fr, int fq, int tid) const {
#pragma unroll
        for (int ai = 0; ai < 2; ++ai)
#pragma unroll
            for (int m = 0; m < 4; ++m) {
                const int rl = ai * HALF + wr * 64 + m * 16 + fr;
                float rs; if (MOE) { const int mx = u.aux2 - 1; rs = RSx[u.pm + (rl < mx ? rl : mx)]; rs = rl < u.aux2 ? rs : 0.f; } else rs = rstd_from_rss(RSx, u.pm * BM + rl);
                const int orow = (MOE ? u.aux : u.pm) * BM + rl;
                bf16_t* AO = ACT;
                float o[8];
#pragma unroll
                for (int n = 0; n < 2; ++n)
#pragma unroll
                    for (int e = 0; e < 4; ++e) { const float g = acc[ai][0][m][n][e] * rs, up = acc[ai][1][m][n][e] * rs; o[n * 4 + e] = g * fast_sigmoid(g) * up; }
                u32x4 w; w.x = cvt_pk_bf16(o[0], o[1]); w.y = cvt_pk_bf16(o[2], o[3]); w.z = cvt_pk_bf16(o[4], o[5]); w.w = cvt_pk_bf16(o[6], o[7]);
                __builtin_nontemporal_store(w, (u32x4*)(AO + (size_t)orow * ldc + 128 * u.pn + wc * 32 + 8 * fq));
            }
    }
};

template <bool BASE_F32> struct EpiResid {
    static constexpr bool PERM = true;
    const void* base; bf16_t* HB; float* RSS4; LAS float* T;
    __device__ __forceinline__ void operator()(acc_t& acc, const Unit& u, int wr, int wc, int fr, int fq, int tid) const {
        const int col0 = u.pn * BM + wc * 32 + 8 * fq;
#pragma unroll
        for (int ai = 0; ai < 2; ++ai)
#pragma unroll
            for (int m = 0; m < 4; ++m) {
                const int rl = ai * HALF + wr * 64 + m * 16 + fr; const size_t off = (size_t)(u.pm * BM + rl) * DM + col0; float ss = 0.f;
#pragma unroll
                for (int bj = 0; bj < 2; ++bj) {
                    f32x4 b0, b1;
                    if (BASE_F32) { b0 = *(const f32x4*)((const float*)base + off + bj * HALF); b1 = *(const f32x4*)((const float*)base + off + bj * HALF + 4); }
                    else { const u32x4 w = *(const u32x4*)((const bf16_t*)base + off + bj * HALF); b0 = (f32x4){bf_lo(w.x), bf_hi(w.x), bf_lo(w.y), bf_hi(w.y)}; b1 = (f32x4){bf_lo(w.z), bf_hi(w.z), bf_lo(w.w), bf_hi(w.w)}; }
                    const f32x4 v0 = b0 + acc[ai][bj][m][0], v1 = b1 + acc[ai][bj][m][1];
                    ss += ((v0[0] * v0[0] + v0[1] * v0[1]) + (v0[2] * v0[2] + v0[3] * v0[3])) + ((v1[0] * v1[0] + v1[1] * v1[1]) + (v1[2] * v1[2] + v1[3] * v1[3]));
                    u32x4 o; o.x = cvt_pk_bf16(v0[0], v0[1]); o.y = cvt_pk_bf16(v0[2], v0[3]); o.z = cvt_pk_bf16(v1[0], v1[1]); o.w = cvt_pk_bf16(v1[2], v1[3]);
                    *(u32x4*)(HB + off + bj * HALF) = o; }
                ss += __shfl_xor(ss, 16); ss += __shfl_xor(ss, 32);
                if (fq == 0) T[rl * 4 + wc] = ss;
            }
        EPI_BAR();
        if (tid < 256) { const f32x4 p = *(const LAS f32x4*)(T + tid * 4); RSS4[(size_t)(u.pm * BM + tid) * 4 + u.pn] = (p.x + p.y) + (p.z + p.w); }
    }
};

struct EpiSoftmax {
    static constexpr bool PERM = true;
    bf16_t* PB; const float* RSS4; LAS float* T;
    __device__ __forceinline__ void operator()(acc_t& acc, const Unit& u, int wr, int wc, int fr, int fq, int tid) const {
        LAS f32x2* T2 = (LAS f32x2*)T;
        float mw[2][4];
#pragma unroll
        for (int ai = 0; ai < 2; ++ai)
#pragma unroll
            for (int m = 0; m < 4; ++m) {
                const int rl = ai * HALF + wr * 64 + m * 16 + fr; const float rs = rstd_from_rss(RSS4, u.pm * BM + rl);
                float mx = -3.0e38f;
#pragma unroll
                for (int bj = 0; bj < 2; ++bj)
#pragma unroll
                    for (int n = 0; n < 2; ++n) { f32x4 v = acc[ai][bj][m][n] * rs; acc[ai][bj][m][n] = v; mx = fmaxf(fmaxf(mx, fmaxf(v[0], v[1])), fmaxf(v[2], v[3])); }
                mx = fmaxf(mx, __shfl_xor(mx, 16)); mx = fmaxf(mx, __shfl_xor(mx, 32));
                float l = 0.f;
#pragma unroll
                for (int bj = 0; bj < 2; ++bj)
#pragma unroll
                    for (int n = 0; n < 2; ++n) { f32x4 v = acc[ai][bj][m][n]; v[0] = fast_exp(v[0] - mx); v[1] = fast_exp(v[1] - mx); v[2] = fast_exp(v[2] - mx); v[3] = fast_exp(v[3] - mx); acc[ai][bj][m][n] = v; l += (v[0] + v[1]) + (v[2] + v[3]); }
                l += __shfl_xor(l, 16); l += __shfl_xor(l, 32);
                if (fq == 0) T2[rl * 4 + wc] = (f32x2){mx, l};
                mw[ai][m] = mx;
            }
        EPI_BAR();
#pragma unroll
        for (int ai = 0; ai < 2; ++ai)
#pragma unroll
            for (int m = 0; m < 4; ++m) {
                const int rl = ai * HALF + wr * 64 + m * 16 + fr;
                const f32x2 p0 = T2[rl * 4 + 0], p1 = T2[rl * 4 + 1], p2 = T2[rl * 4 + 2], p3 = T2[rl * 4 + 3];
                const float M = fmaxf(fmaxf(p0.x, p1.x), fmaxf(p2.x, p3.x));
                const float L = (p0.y * fast_exp(p0.x - M) + p1.y * fast_exp(p1.x - M)) + (p2.y * fast_exp(p2.x - M) + p3.y * fast_exp(p3.x - M));
                const float f = fast_exp(mw[ai][m] - M) / L;
                bf16_t* rowp = PB + (size_t)(u.pm * BM + rl) * DM + u.pn * BM + wc * 32 + 8 * fq;
#pragma unroll
                for (int bj = 0; bj < 2; ++bj) { const f32x4 v0 = acc[ai][bj][m][0] * f, v1 = acc[ai][bj][m][1] * f;
                    u32x4 w; w.x = cvt_pk_bf16(v0[0], v0[1]); w.y = cvt_pk_bf16(v0[2], v0[3]); w.z = cvt_pk_bf16(v1[0], v1[1]); w.w = cvt_pk_bf16(v1[2], v1[3]);
                    *(u32x4*)(rowp + bj * HALF) = w; }
            }
    }
};

struct EpiGeluUV {
    static constexpr bool PERM = true;
    bf16_t* UV; const float* RSS4; f32x2* VST; LAS float* T;
    __device__ __forceinline__ void operator()(acc_t& acc, const Unit& u, int wr, int wc, int fr, int fq, int tid) const {
        LAS f32x2* T2 = (LAS f32x2*)T;
#pragma unroll
        for (int ai = 0; ai < 2; ++ai)
#pragma unroll
            for (int m = 0; m < 4; ++m) {
                const int rl = ai * HALF + wr * 64 + m * 16 + fr; const float rs = rstd_from_rss(RSS4, u.pm * BM + rl);
                bf16_t* rowp = UV + (size_t)(u.pm * BM + rl) * 2048 + u.pn * BM + wc * 32 + 8 * fq; float s1 = 0.f, s2 = 0.f;
#pragma unroll
                for (int bj = 0; bj < 2; ++bj) { f32x4 v0 = acc[ai][bj][m][0] * rs, v1 = acc[ai][bj][m][1] * rs;
#pragma unroll
                    for (int e = 0; e < 4; ++e) { v0[e] = gelu_tanh_f(v0[e]); v1[e] = gelu_tanh_f(v1[e]); s1 += v0[e] + v1[e]; s2 += v0[e] * v0[e] + v1[e] * v1[e]; }
                    u32x4 w; w.x = cvt_pk_bf16(v0[0], v0[1]); w.y = cvt_pk_bf16(v0[2], v0[3]); w.z = cvt_pk_bf16(v1[0], v1[1]); w.w = cvt_pk_bf16(v1[2], v1[3]);
                    *(u32x4*)(rowp + bj * HALF) = w; }
                s1 += __shfl_xor(s1, 16); s1 += __shfl_xor(s1, 32); s2 += __shfl_xor(s2, 16); s2 += __shfl_xor(s2, 32);
                if (fq == 0) T2[rl * 4 + wc] = (f32x2){s1, s2};
            }
        EPI_BAR();
        if (u.pn >= 4 && tid < 256) { const f32x2 p0 = T2[tid * 4 + 0], p1 = T2[tid * 4 + 1], p2 = T2[tid * 4 + 2], p3 = T2[tid * 4 + 3];
            VST[(size_t)(u.pm * BM + tid) * 4 + (u.pn - 4)] = (f32x2){(p0.x + p1.x) + (p2.x + p3.x), (p0.y + p1.y) + (p2.y + p3.y)}; }
    }
};

__device__ __forceinline__ float clamp448(float x) { return fminf(fmaxf(x, -448.f), 448.f); }
__device__ __forceinline__ unsigned pk4_fp8(float a, float b, float c, float d) { unsigned w = 0u; w = __builtin_amdgcn_cvt_pk_fp8_f32(clamp448(a), clamp448(b), w, false); w = __builtin_amdgcn_cvt_pk_fp8_f32(clamp448(c), clamp448(d), w, true); return w; }
constexpr float W8_SCALE = 64.0f, W8_INV = 1.0f / 64.0f;

struct EpiSwiGLU8 {
    static constexpr bool PERM = true;
    unsigned char* ACT8;
    __device__ __forceinline__ void operator()(acc_t& acc, const Unit& u, int wr, int wc, int fr, int fq, int tid) const {
#pragma unroll
        for (int ai = 0; ai < 2; ++ai)
#pragma unroll
            for (int m = 0; m < 4; ++m) {
                const int rl = ai * HALF + wr * 64 + m * 16 + fr; float o[8];
#pragma unroll
                for (int n = 0; n < 2; ++n)
#pragma unroll
                    for (int e = 0; e < 4; ++e) { const float g = acc[ai][0][m][n][e] * W8_INV, up = acc[ai][1][m][n][e] * W8_INV; o[n * 4 + e] = g * fast_sigmoid(g) * up; }
                u32x2 w; w.x = pk4_fp8(o[0], o[1], o[2], o[3]); w.y = pk4_fp8(o[4], o[5], o[6], o[7]);
                __builtin_nontemporal_store(w, (u32x2*)(ACT8 + (size_t)(u.aux * BM + rl) * DFF + 128 * u.pn + wc * 32 + 8 * fq));
            }
    }
};
struct EpiMoeDown8 {
    static constexpr bool PERM = true;
    bf16_t* Y; const float* SGW;
    __device__ __forceinline__ void operator()(acc_t& acc, const Unit& u, int wr, int wc, int fr, int fq, int tid) const {
        const int col0 = u.pn * BM + wc * 32 + 8 * fq;
#pragma unroll
        for (int ai = 0; ai < 2; ++ai)
#pragma unroll
            for (int m = 0; m < 4; ++m) {
                const int rl = ai * HALF + wr * 64 + m * 16 + fr, mx = u.aux2 - 1; const float gw = SGW[u.pm + (rl < mx ? rl : mx)] * W8_INV;
                bf16_t* rowp = Y + (size_t)(u.aux * BM + rl) * DM + col0;
#pragma unroll
                for (int bj = 0; bj < 2; ++bj) { const f32x4 v0 = acc[ai][bj][m][0] * gw, v1 = acc[ai][bj][m][1] * gw;
                    u32x4 o; o.x = cvt_pk_bf16(v0[0], v0[1]); o.y = cvt_pk_bf16(v0[2], v0[3]); o.z = cvt_pk_bf16(v1[0], v1[1]); o.w = cvt_pk_bf16(v1[2], v1[3]);
                    *(u32x4*)(rowp + bj * HALF) = o; }
            }
    }
};
#define XB_TMO      128
#define XB_XCNT(j)  (256  + 64 * (j))
#define XB_XSUB(j)  (1280 + 64 * (j))
#define XB_XGEN(j)  (2304 + 64 * (j))
#define XB_TOP      3328
#define XB_TOPGEN   3392
#define XCD_BAR_WORDS 3456
#define XB_SPIN_CAP (1u << 18)
__device__ __forceinline__ unsigned xb_ld(unsigned* p)              { return __hip_atomic_load(p, __ATOMIC_RELAXED, __HIP_MEMORY_SCOPE_AGENT); }
__device__ __forceinline__ unsigned xb_add(unsigned* p, unsigned v) { return __hip_atomic_fetch_add(p, v, __ATOMIC_RELAXED, __HIP_MEMORY_SCOPE_AGENT); }
__device__ __forceinline__ unsigned xb_xcc_id() { return (unsigned)__builtin_amdgcn_s_getreg((3 << 11) | 20) & 0xFu; }
#define XB_SPIN(cond, bar) do { unsigned _sp = 0; while (cond) { __builtin_amdgcn_s_sleep(1); \
    if ((++_sp & 255u) == 0u) { if (xb_ld(&(bar)[XB_TMO])) break; if (_sp > XB_SPIN_CAP) { atomicAdd(&(bar)[XB_TMO], 1u); break; } } } } while (0)
struct XcdBarrier { unsigned* bar; unsigned x; volatile LAS unsigned* st; };
__device__ __forceinline__ XcdBarrier xcd_barrier_post(unsigned* bar, volatile LAS unsigned* st) {
    XcdBarrier b; b.bar = bar; b.x = xb_xcc_id(); b.st = st;
    if (threadIdx.x == 0) (void)xb_add(&bar[XB_XCNT(b.x)], 1u);
    return b;
}
__device__ __forceinline__ void xcd_barrier_complete(unsigned* bar, unsigned x, unsigned& nloc, unsigned& nx) {
    const unsigned G = gridDim.x * gridDim.y * gridDim.z;
    unsigned sum, cnt, mine, sp = 0u;
    for (;;) {
        sum = 0u; cnt = 0u; mine = 0u;
#pragma unroll
        for (unsigned j = 0; j < 16; ++j) { const unsigned c = xb_ld(&bar[XB_XCNT(j)]); sum += c; cnt += (c > 0u) ? 1u : 0u; mine = (j == x) ? c : mine; }
        if (sum == G) break;
        __builtin_amdgcn_s_sleep(1);
        if ((++sp & 255u) == 0u) { if (xb_ld(&bar[XB_TMO])) break; if (sp > XB_SPIN_CAP) { atomicAdd(&bar[XB_TMO], 1u); break; } }
    }
    nloc = mine > 0u ? mine : 1u; nx = cnt > 0u ? cnt : 1u;
}
__device__ __forceinline__ void xcd_barrier(const XcdBarrier& b) {
    asm volatile("s_waitcnt vmcnt(0)" ::: "memory");
    __syncthreads();
    if (threadIdx.x == 0) {
        unsigned* bar = b.bar;
        __builtin_amdgcn_s_waitcnt(0);
        unsigned nloc = b.st[0], nx = b.st[1];
        if (nloc == 0u) { xcd_barrier_complete(bar, b.x, nloc, nx); b.st[0] = nloc; b.st[1] = nx; }
        const unsigned old = xb_add(&bar[XB_XSUB(b.x)], 1u);
        const unsigned gen = old / nloc;
        if (old + 1u == (gen + 1u) * nloc) {
            __builtin_amdgcn_fence(__ATOMIC_RELEASE, "agent");
            asm volatile("s_waitcnt vmcnt(0)" ::: "memory");
            const unsigned og = xb_add(&bar[XB_TOP], 1u);
            const unsigned tg = og / nx;
            if (og + 1u == (tg + 1u) * nx) xb_add(&bar[XB_TOPGEN], 1u);
            else XB_SPIN(xb_ld(&bar[XB_TOPGEN]) == tg, bar);
            __builtin_amdgcn_fence(__ATOMIC_ACQUIRE, "agent");
            xb_add(&bar[XB_XGEN(b.x)], 1u);
            asm volatile("s_waitcnt vmcnt(0)" ::: "memory");
        } else {
            XB_SPIN(xb_ld(&bar[XB_XGEN(b.x)]) == gen, bar);
            __builtin_amdgcn_fence(__ATOMIC_ACQUIRE, "agent");
            asm volatile("s_waitcnt vmcnt(0)" ::: "memory");
        }
    }
    __syncthreads();
}

struct Args { const float* in[31]; float* out; unsigned char* ws; int ph_lo, ph_hi; };
struct Frame { LAS unsigned char* lds; int tid, lane, wave, G, bx; float* H; unsigned char* ws; };
__device__ __forceinline__ const float* karg_in(int k) { typedef const float* __attribute__((address_space(4))) const* kp_t; return ((kp_t)__builtin_amdgcn_kernarg_segment_ptr())[k]; }

__device__ __forceinline__ void transpose_item(const float* W, int ldw, int k0, int n0, bf16_t* WT, int K, int dst_row0, const float* gk, LAS float* scr, int lane) {
    float tv[64];
#pragma unroll
    for (int i = 0; i < 64; ++i) tv[i] = W[(size_t)(k0 + i) * ldw + n0 + lane];
#pragma unroll
    for (int i = 0; i < 64; ++i) { const float g = gk ? gk[k0 + i] : 1.0f; scr[i * 64 + (lane ^ (((i >> 3) & 7) << 3))] = tv[i] * g; }
    LDS_WAIT(); asm volatile("" ::: "memory");
    const int c = lane & 7;
#pragma unroll
    for (int j = 0; j < 8; ++j) { const int n = (lane >> 3) + 8 * j; const LAS float* s = scr + (8 * c) * 64 + (n ^ (c << 3));
        u32x4 o; o.x = cvt_pk_bf16(s[0 * 64], s[1 * 64]); o.y = cvt_pk_bf16(s[2 * 64], s[3 * 64]); o.z = cvt_pk_bf16(s[4 * 64], s[5 * 64]); o.w = cvt_pk_bf16(s[6 * 64], s[7 * 64]);
        *(u32x4*)(WT + (size_t)(dst_row0 + n) * K + k0 + 8 * c) = o; }
    LDS_WAIT(); asm volatile("" ::: "memory");
}
__device__ __forceinline__ void transpose_item_fp8(const float* W, int ldw, int k0, int n0, unsigned char* WT8, int K, int dst_row0, const float* gk, float scale, LAS float* scr, int lane) {
    float tv[64];
#pragma unroll
    for (int i = 0; i < 64; ++i) tv[i] = W[(size_t)(k0 + i) * ldw + n0 + lane];
#pragma unroll
    for (int i = 0; i < 64; ++i) { const float g = (gk ? gk[k0 + i] : 1.0f) * scale; scr[i * 64 + (lane ^ (((i >> 3) & 7) << 3))] = tv[i] * g; }
    LDS_WAIT(); asm volatile("" ::: "memory");
    const int c = lane & 3;
#pragma unroll
    for (int j = 0; j < 4; ++j) { const int n = (lane >> 2) + 16 * j; float v[16];
#pragma unroll
        for (int e = 0; e < 16; ++e) v[e] = scr[(16 * c + e) * 64 + (n ^ (((2 * c + (e >> 3)) & 7) << 3))];
        u32x4 o; o.x = pk4_fp8(v[0], v[1], v[2], v[3]); o.y = pk4_fp8(v[4], v[5], v[6], v[7]); o.z = pk4_fp8(v[8], v[9], v[10], v[11]); o.w = pk4_fp8(v[12], v[13], v[14], v[15]);
        *(u32x4*)(WT8 + (size_t)(dst_row0 + n) * K + k0 + 16 * c) = o; }
    LDS_WAIT(); asm volatile("" ::: "memory");
}
__device__ __forceinline__ int glu5_map(int n0) {
    if (n0 < 512) return 256 * (n0 >> 7) + (n0 & 127);
    if (n0 < 1024) { const int c = n0 - 512; return 256 * (c >> 7) + 128 + (c & 127); }
    if (n0 < 1536) return n0;
    if (n0 < 2048) { const int c = n0 - 1536; return 1536 + 256 * (c >> 7) + (c & 127); }
    const int c = n0 - 2048; return 1536 + 256 * (c >> 7) + 128 + (c & 127);
}
__device__ __forceinline__ int gu_map(int n0, int up) { return 256 * (n0 >> 7) + 128 * up + (n0 & 127); }

template <int MAP  >
__device__ __forceinline__ void conv_matrix(const float* W, int ldw, int nkb, int nnb, bf16_t* WT, int K, int up, const float* gk, int item0, int gw, int NGW, LAS float* scr, int lane) {
    const int n = nkb * nnb; int first = (gw - item0) % NGW; if (first < 0) first += NGW;
    for (int r = first; r < n; r += NGW) { const int kb = r / nnb, nb = r % nnb;
        const int dst = MAP == 0 ? 64 * nb : (MAP == 1 ? glu5_map(64 * nb) : gu_map(64 * nb, up));
        transpose_item(W, ldw, 64 * kb, 64 * nb, WT, K, dst, gk, scr, lane); }
}
template <int MAP>
__device__ __forceinline__ void conv_matrix8(const float* W, int ldw, int nkb, int nnb, unsigned char* WT8, int K, int up, const float* gk, float scale, int item0, int gw, int NGW, LAS float* scr, int lane) {
    const int n = nkb * nnb; int first = (gw - item0) % NGW; if (first < 0) first += NGW;
    for (int r = first; r < n; r += NGW) { const int kb = r / nnb, nb = r % nnb;
        const int dst = MAP == 0 ? 64 * nb : gu_map(64 * nb, up);
        transpose_item_fp8(W, ldw, 64 * kb, 64 * nb, WT8, K, dst, gk, scale, scr, lane); }
}
__device__ __forceinline__ void p0_prologue(Frame& F) {
    LAS float* scr = (LAS float*)(F.lds + RING_OFF + F.wave * 16384);
    const int gw = F.bx * 8 + F.wave, NGW = F.G * 8, lane = F.lane;
    unsigned char* ws = F.ws;
    constexpr int I_SQ = 256, I_WIN = 16 * 40, I_GU = 16 * 44, I_DN = 44 * 16, I_SG = 16 * 32;
    int o = 0;
    conv_matrix<1>(karg_in(11), 2560, 16, 40, (bf16_t*)(ws + WS_WIN0), 1024, 0, karg_in(2), o, gw, NGW, scr, lane); o += I_WIN;
    conv_matrix<0>(karg_in(17), 1024, 16, 16, (bf16_t*)(ws + WS_WOUT0), 1024, 0, nullptr, o, gw, NGW, scr, lane); o += I_SQ;
    conv_matrix<2>(karg_in(18), 2816, 16, 44, (bf16_t*)(ws + WS_WGU0), 1024, 0, karg_in(5), o, gw, NGW, scr, lane); o += I_GU;
    conv_matrix<2>(karg_in(19), 2816, 16, 44, (bf16_t*)(ws + WS_WGU0), 1024, 1, karg_in(5), o, gw, NGW, scr, lane); o += I_GU;
    conv_matrix<0>(karg_in(20), 1024, 44, 16, (bf16_t*)(ws + WS_WD0), 2816, 0, nullptr, o, gw, NGW, scr, lane); o += I_DN;
    for (int l = 0; l < 2; ++l) {
        conv_matrix<0>(karg_in(10) + (size_t)l * DM * DM, 1024, 16, 16, (bf16_t*)(ws + WS_WOT) + (size_t)l * DM * DM, 1024, 0, nullptr, o, gw, NGW, scr, lane); o += I_SQ;
        conv_matrix<0>(karg_in(8) + (size_t)l * DM * DM, 1024, 16, 16, (bf16_t*)(ws + WS_WKT) + (size_t)l * DM * DM, 1024, 0, nullptr, o, gw, NGW, scr, lane); o += I_SQ;
        conv_matrix<0>(karg_in(9) + (size_t)l * DM * DM, 1024, 16, 16, (bf16_t*)(ws + WS_WKT) + (size_t)(2 + l) * DM * DM, 1024, 0, nullptr, o, gw, NGW, scr, lane); o += I_SQ;
    }
    conv_matrix<0>(karg_in(21), 2048, 16, 32, (bf16_t*)(ws + WS_WSG), 1024, 0, karg_in(2) + DM, o, gw, NGW, scr, lane); o += I_SG;
    conv_matrix<0>(karg_in(26), 1024, 16, 16, (bf16_t*)(ws + WS_WSO), 1024, 0, nullptr, o, gw, NGW, scr, lane); o += I_SQ;
    for (int e = 0; e < NEXP; ++e) {
        conv_matrix8<2>(karg_in(28) + (size_t)e * DM * DFF, 2816, 16, 44, (unsigned char*)(ws + WS_WGU1) + (size_t)e * 5632 * DM, 1024, 0, karg_in(5) + DM, W8_SCALE, o, gw, NGW, scr, lane); o += I_GU;
        conv_matrix8<2>(karg_in(29) + (size_t)e * DM * DFF, 2816, 16, 44, (unsigned char*)(ws + WS_WGU1) + (size_t)e * 5632 * DM, 1024, 1, karg_in(5) + DM, W8_SCALE, o, gw, NGW, scr, lane); o += I_GU;
        conv_matrix8<0>(karg_in(30) + (size_t)e * DFF * DM, 1024, 44, 16, (unsigned char*)(ws + WS_WD1) + (size_t)e * DM * DFF, 2816, 0, nullptr, W8_SCALE, o, gw, NGW, scr, lane); o += I_DN;
    }
    for (int r = gw; r < 2 * DM; r += NGW) { const int l = r >> 10, k = r & 1023; const float g = karg_in(3)[l * DM + k] * 0.0625f;
        const f32x4* src = (const f32x4*)(karg_in(7) + (size_t)r * DM) + lane; u32x2* dst = (u32x2*)((bf16_t*)(ws + WS_WQS) + (size_t)r * DM) + lane;
#pragma unroll
        for (int j = 0; j < 4; ++j) { const f32x4 v = src[64 * j] * g; u32x2 w; w.x = cvt_pk_bf16(v[0], v[1]); w.y = cvt_pk_bf16(v[2], v[3]); dst[64 * j] = w; } }
    for (int r = gw; r < 2 * 4 * MEML; r += NGW) { const int l = r >> 10, mr = r & 1023;
        const f32x4* src = (const f32x4*)(karg_in(1) + (size_t)mr * DM) + lane; const f32x4* gg = (const f32x4*)(karg_in(4) + l * DM) + lane;
        u32x2* dst = (u32x2*)((bf16_t*)(ws + WS_MEMN) + (size_t)r * DM) + lane; f32x4 v[4]; float s = 0.f;
#pragma unroll
        for (int j = 0; j < 4; ++j) { v[j] = src[64 * j]; s += (v[j][0] * v[j][0] + v[j][1] * v[j][1]) + (v[j][2] * v[j][2] + v[j][3] * v[j][3]); }
        const float rs = rsqrtf(wave_sum(s) * (1.0f / DM) + 1e-6f);
#pragma unroll
        for (int j = 0; j < 4; ++j) { const f32x4 o = v[j] * rs * gg[64 * j]; u32x2 w; w.x = cvt_pk_bf16(o[0], o[1]); w.y = cvt_pk_bf16(o[2], o[3]); dst[64 * j] = w; } }
    for (int r = gw; r < NTOK; r += NGW) {
        const f32x4* src = (const f32x4*)(karg_in(0) + (size_t)r * DM) + lane; u32x2* dst = (u32x2*)((bf16_t*)(ws + WS_HB) + (size_t)r * DM) + lane; f32x4 v[4]; float s = 0.f;
#pragma unroll
        for (int j = 0; j < 4; ++j) { v[j] = src[64 * j]; s += (v[j][0] * v[j][0] + v[j][1] * v[j][1]) + (v[j][2] * v[j][2] + v[j][3] * v[j][3]); }
        s = wave_sum(s);
#pragma unroll
        for (int j = 0; j < 4; ++j) { u32x2 w; w.x = cvt_pk_bf16(v[j][0], v[j][1]); w.y = cvt_pk_bf16(v[j][2], v[j][3]); dst[64 * j] = w; }
        if (lane == 0) *(f32x4*)((float*)(ws + WS_RSS) + (size_t)r * 4) = (f32x4){s, 0.f, 0.f, 0.f}; }
}

struct KvOrder {
    const char* memn; const char* wkt; int G, c;
    __device__ __forceinline__ bool next(int i, Unit& u) const { const int L = i * G + c; if (L >= 64) return false;
        const int which = L >> 4, t = L & 15, l = which & 1; u.pm = t >> 2; u.pn = t & 3; u.aux = which;
        u.A = memn + ((size_t)l * DM * DM + (size_t)u.pm * BM * DM) * 2; u.B = wkt + ((size_t)which * DM * DM + (size_t)u.pn * BM * DM) * 2; return true; }
};
struct MkVwOrder {
    const char* kp; const char* wqs; const char* wot; int G, c;
    __device__ __forceinline__ bool next(int i, Unit& u) const { const int L = i * G + c; if (L >= 256) return false;
        const int vw = L >> 7, q = L & 127, l = q >> 6, b = (q >> 4) & 3, hd = (q >> 2) & 3, t = q & 3;
        if (!vw) { u.pm = hd; u.pn = t; u.aux = l * 4 + b;
            u.A = kp + ((size_t)l * DM * DM + (size_t)(b * MEML) * DM + hd * 256) * 2; u.B = wqs + ((size_t)l * DM * DM + (size_t)(t * BM) * DM + hd * 256) * 2; }
        else { u.pm = t; u.pn = hd; u.aux = 8 + l * 4 + b;
            u.A = wot + ((size_t)l * DM * DM + (size_t)(t * BM) * DM + hd * 256) * 2; u.B = kp + ((size_t)(2 + l) * DM * DM + (size_t)(b * MEML) * DM + hd * 256) * 2; }
        return true; }
};

__device__ __forceinline__ void conv_phase(Frame& F) {
    const int tid = F.tid, half = tid >> 8, t2 = tid & 255, c0 = 2 * t2, wih = (tid >> 6) & 3, lane = F.lane;
    const bf16_t* ZB = (const bf16_t*)(F.ws + WS_ZB); bf16_t* MIX = (bf16_t*)(F.ws + WS_MIX);
    LAS float* RED = (LAS float*)(F.lds + RING_OFF);
    f32x2 wa[31], wb[3];
#pragma unroll
    for (int k = 0; k < 31; ++k) wa[k] = *(const f32x2*)(karg_in(12) + k * 512 + c0);
#pragma unroll
    for (int k = 0; k < 3; ++k) wb[k] = *(const f32x2*)(karg_in(16) + k * 512 + c0);
    const f32x2 bias = *(const f32x2*)(karg_in(13) + c0), lg = *(const f32x2*)(karg_in(14) + c0), lb = *(const f32x2*)(karg_in(15) + c0);
    unsigned xin[38], gb[8], gh[10];
#define CONV_LOAD(it_) do { const int blk_ = (F.bx * 8 + (it_)) * 2 + half, tk_ = blk_ * 8, tp_ = tk_ & (SEQL - 1); \
        _Pragma("unroll") for (int j = 0; j < 38; ++j) { const int pos = tp_ - 30 + j; xin[j] = (pos >= 0) ? *(const unsigned*)(ZB + (size_t)(tk_ - 30 + j) * ZW + c0) : 0u; } \
        _Pragma("unroll") for (int j = 0; j < 8; ++j) gb[j] = *(const unsigned*)(ZB + (size_t)(tk_ + j) * ZW + 512 + c0); \
        _Pragma("unroll") for (int j = 0; j < 10; ++j) { const int pos = tp_ - 2 + j; gh[j] = (pos >= 0) ? *(const unsigned*)(ZB + (size_t)(tk_ - 2 + j) * ZW + 1024 + c0) : 0u; } } while (0)
    CONV_LOAD(0);
    for (int it = 0; it < 8; ++it) {
        const int blk = (F.bx * 8 + it) * 2 + half, tok0 = blk * 8;
        f32x2 a[8], bo[8];
#pragma unroll
        for (int o = 0; o < 8; ++o) a[o] = bias;
#pragma unroll
        for (int j = 0; j < 38; ++j) { const f32x2 x = (f32x2){bf_lo(xin[j]), bf_hi(xin[j])};
#pragma unroll
            for (int o = 0; o < 8; ++o) { const int k = j - o; if (k >= 0 && k < 31) a[o] = __builtin_elementwise_fma(wa[k], x, a[o]); } }
#pragma unroll
        for (int o = 0; o < 8; ++o) { f32x2 b = (f32x2){0.f, 0.f};
#pragma unroll
            for (int k = 0; k < 3; ++k) b = __builtin_elementwise_fma(wb[k], (f32x2){bf_lo(gh[o + k]), bf_hi(gh[o + k])}, b);
            bo[o] = b * (f32x2){bf_lo(gb[o]), bf_hi(gb[o])}; }
        if (it < 7) CONV_LOAD(it + 1);
#pragma unroll
        for (int o = 0; o < 8; ++o) { const f32x2 sq = a[o] * a[o]; const float s1 = wave_sum(a[o].x + a[o].y), s2 = wave_sum(sq.x + sq.y);
            if (lane == 0) { RED[((half * 4 + wih) * 8 + o) * 2 + 0] = s1; RED[((half * 4 + wih) * 8 + o) * 2 + 1] = s2; } }
        LDS_WAIT(); __syncthreads();
#pragma unroll
        for (int o = 0; o < 8; ++o) { float s1 = 0.f, s2 = 0.f;
#pragma unroll
            for (int w = 0; w < 4; ++w) { s1 += RED[((half * 4 + w) * 8 + o) * 2 + 0]; s2 += RED[((half * 4 + w) * 8 + o) * 2 + 1]; }
            const float mu = s1 * (1.0f / 512.f), var = s2 * (1.0f / 512.f) - mu * mu, rstd = rsqrtf(fmaxf(var, 0.f) + 1e-5f);
            const f32x2 y = (a[o] - mu) * rstd * lg + lb;
            *(unsigned*)(MIX + (size_t)(tok0 + o) * DM + c0) = cvt_pk_bf16(y.x * fast_sigmoid(y.x), y.y * fast_sigmoid(y.y));
            *(unsigned*)(MIX + (size_t)(tok0 + o) * DM + 512 + c0) = cvt_pk_bf16(bo[o].x, bo[o].y); }
        LDS_WAIT(); __syncthreads();
    }
#undef CONV_LOAD
}

__device__ __forceinline__ void spatial_phase(Frame& F) {
    const int tid = F.tid, lane = F.lane, wv = F.wave, fr = lane & 15, fq = lane >> 4, g = F.bx & 7;
    constexpr int RS = 272;
    LAS unsigned char* WL = F.lds + RING_OFF;
    LAS unsigned char* VT = F.lds + RING_OFF + 128 * RS;
    const bf16_t* UV = (const bf16_t*)(F.ws + WS_UV); bf16_t* US = (bf16_t*)(F.ws + WS_US); const f32x4* VST = (const f32x4*)(F.ws + WS_VST);
    { const int i = tid >> 2, jq = (tid & 3) * 32; const float* src = karg_in(24) + ((size_t)g * 128 + i) * 128 + jq;
#pragma unroll
        for (int q = 0; q < 4; ++q) { const f32x4 a = *(const f32x4*)(src + 8 * q), b = *(const f32x4*)(src + 8 * q + 4); const bool ok = ((jq + 8 * q) >> 6) <= (i >> 6);
            u32x4 w; w.x = cvt_pk_bf16(a[0], a[1]); w.y = cvt_pk_bf16(a[2], a[3]); w.z = cvt_pk_bf16(b[0], b[1]); w.w = cvt_pk_bf16(b[2], b[3]);
            if (!ok) w = (u32x4){0u, 0u, 0u, 0u}; *(LAS u32x4*)(WL + i * RS + (jq + 8 * q) * 2) = w; } }
    const int j = tid >> 2, cq = (tid & 3) * 8;
    f32x4 lgv[8], lbv[8];
#pragma unroll
    for (int q = 0; q < 8; ++q) { lgv[q] = *(const f32x4*)(karg_in(22) + g * 128 + cq + 32 * (q >> 1) + 4 * (q & 1)); lbv[q] = *(const f32x4*)(karg_in(23) + g * 128 + cq + 32 * (q >> 1) + 4 * (q & 1)); }
    u32x4 vw[4]; f32x4 st0, st1;
#define SP_LOADV(r_) do { const size_t tk_ = (size_t)((F.bx >> 3) + 32 * (r_)) * 128 + j; st0 = VST[tk_ * 2]; st1 = VST[tk_ * 2 + 1]; const bf16_t* vr_ = UV + tk_ * 2048 + 1024 + g * 128 + cq; \
        _Pragma("unroll") for (int q = 0; q < 4; ++q) vw[q] = *(const u32x4*)(vr_ + 32 * q); } while (0)
    SP_LOADV(0);
    for (int r = 0; r < 8; ++r) {
        const int nb = (F.bx >> 3) + 32 * r;
        { const float s1 = (st0[0] + st0[2]) + (st1[0] + st1[2]), s2 = (st0[1] + st0[3]) + (st1[1] + st1[3]);
          const float mu = s1 * (1.0f / 1024.f), var = s2 * (1.0f / 1024.f) - mu * mu, rstd = rsqrtf(fmaxf(var, 0.f) + 1e-5f);
#pragma unroll
          for (int q = 0; q < 4; ++q) { const u32x4 w = vw[q];
            const float v[8] = {bf_lo(w.x), bf_hi(w.x), bf_lo(w.y), bf_hi(w.y), bf_lo(w.z), bf_hi(w.z), bf_lo(w.w), bf_hi(w.w)};
            const float gg[8] = {lgv[2 * q][0], lgv[2 * q][1], lgv[2 * q][2], lgv[2 * q][3], lgv[2 * q + 1][0], lgv[2 * q + 1][1], lgv[2 * q + 1][2], lgv[2 * q + 1][3]};
            const float bbv[8] = {lbv[2 * q][0], lbv[2 * q][1], lbv[2 * q][2], lbv[2 * q][3], lbv[2 * q + 1][0], lbv[2 * q + 1][1], lbv[2 * q + 1][2], lbv[2 * q + 1][3]};
#pragma unroll
            for (int e = 0; e < 8; e += 2) { const unsigned pk = cvt_pk_bf16((v[e] - mu) * rstd * gg[e] + bbv[e], (v[e + 1] - mu) * rstd * gg[e + 1] + bbv[e + 1]);
                *(LAS unsigned short*)(VT + (cq + 32 * q + e) * RS + j * 2) = (unsigned short)(pk & 0xffffu);
                *(LAS unsigned short*)(VT + (cq + 32 * q + e + 1) * RS + j * 2) = (unsigned short)(pk >> 16); } } }
        LDS_WAIT(); __syncthreads();
        u32x4 uu[4];
#pragma unroll
        for (int b = 0; b < 4; ++b) { const size_t tok = (size_t)nb * 128 + (4 * (wv >> 2) + b) * 16 + fr; uu[b] = *(const u32x4*)(UV + tok * 2048 + g * 128 + 32 * (wv & 3) + 8 * fq); }
        if (r < 7) SP_LOADV(r + 1);
        f32x4 acc[2][4];
#pragma unroll
        for (int a = 0; a < 2; ++a)
#pragma unroll
            for (int b = 0; b < 4; ++b) acc[a][b] = (f32x4){0.f, 0.f, 0.f, 0.f};
#pragma unroll
        for (int ks = 0; ks < 4; ++ks) {
            bf16x8 xf[2], yf[4];
#pragma unroll
            for (int a = 0; a < 2; ++a) xf[a] = *(const LAS bf16x8*)(VT + (32 * (wv & 3) + 8 * (fr >> 2) + 4 * a + (fr & 3)) * RS + (ks * 32 + fq * 8) * 2);
#pragma unroll
            for (int b = 0; b < 4; ++b) yf[b] = *(const LAS bf16x8*)(WL + ((4 * (wv >> 2) + b) * 16 + fr) * RS + (ks * 32 + fq * 8) * 2);
#pragma unroll
            for (int a = 0; a < 2; ++a)
#pragma unroll
                for (int b = 0; b < 4; ++b) acc[a][b] = __builtin_amdgcn_mfma_f32_16x16x32_bf16(xf[a], yf[b], acc[a][b], 0, 0, 0);
        }
#pragma unroll
        for (int b = 0; b < 4; ++b) { const int i = (4 * (wv >> 2) + b) * 16 + fr; const size_t tok = (size_t)nb * 128 + i; const float bs = karg_in(25)[g * 128 + i]; const u32x4 u4 = uu[b];
            u32x4 o; o.x = cvt_pk_bf16(bf_lo(u4.x) * (acc[0][b][0] + bs), bf_hi(u4.x) * (acc[0][b][1] + bs)); o.y = cvt_pk_bf16(bf_lo(u4.y) * (acc[0][b][2] + bs), bf_hi(u4.y) * (acc[0][b][3] + bs));
            o.z = cvt_pk_bf16(bf_lo(u4.z) * (acc[1][b][0] + bs), bf_hi(u4.z) * (acc[1][b][1] + bs)); o.w = cvt_pk_bf16(bf_lo(u4.w) * (acc[1][b][2] + bs), bf_hi(u4.w) * (acc[1][b][3] + bs));
            *(u32x4*)(US + tok * DM + g * 128 + 32 * (wv & 3) + 8 * fq) = o; }
        LDS_WAIT(); __syncthreads();
    }
#undef SP_LOADV
}

__device__ __forceinline__ void router_phase(Frame& F) {
    const int lane = F.lane, wv = F.wave, tid = F.tid;
    LAS int* CL = (LAS int*)(F.lds + RSCR_OFF); LAS int* BASE = CL + 16; LAS unsigned* TE = (LAS unsigned*)(CL + 32);
    LAS int* TR1 = (LAS int*)(TE + 128); LAS int* TR2 = TR1 + 128; LAS float* TW1 = (LAS float*)(TR2 + 128); LAS float* TW2 = TW1 + 128; LAS float* TRS = TW2 + 128;
    if (tid < 16) CL[tid] = 0;
    float wr[16][8];
#pragma unroll
    for (int j = 0; j < 2; ++j)
#pragma unroll
        for (int e8 = 0; e8 < 8; ++e8) { const int k = 8 * lane + 512 * j + e8; const float g = karg_in(5)[DM + k]; const f32x4 a = *(const f32x4*)(karg_in(27) + k * 8), b = *(const f32x4*)(karg_in(27) + k * 8 + 4);
            wr[j * 8 + e8][0] = a[0] * g; wr[j * 8 + e8][1] = a[1] * g; wr[j * 8 + e8][2] = a[2] * g; wr[j * 8 + e8][3] = a[3] * g; wr[j * 8 + e8][4] = b[0] * g; wr[j * 8 + e8][5] = b[1] * g; wr[j * 8 + e8][6] = b[2] * g; wr[j * 8 + e8][7] = b[3] * g; }
    __syncthreads();
    const bf16_t* HBr = (const bf16_t*)(F.ws + WS_HB);
    u32x4 hw[2]; { const u32x4* hr = (const u32x4*)(HBr + (size_t)(F.bx * 128 + wv * 16) * DM) + lane; hw[0] = hr[0]; hw[1] = hr[64]; }
    for (int q = 0; q < 16; ++q) {
        const int il = wv * 16 + q, t = F.bx * 128 + il;
        const u32x4 w0 = hw[0], w1v = hw[1];
        if (q < 15) { const u32x4* hr = (const u32x4*)(HBr + (size_t)(t + 1) * DM) + lane; hw[0] = hr[0]; hw[1] = hr[64]; }
        float lg[8];
#pragma unroll
        for (int e = 0; e < 8; ++e) lg[e] = 0.f;
#pragma unroll
        for (int j = 0; j < 2; ++j) { const u32x4 w = j ? w1v : w0; const float x[8] = {bf_lo(w.x), bf_hi(w.x), bf_lo(w.y), bf_hi(w.y), bf_lo(w.z), bf_hi(w.z), bf_lo(w.w), bf_hi(w.w)};
#pragma unroll
            for (int e8 = 0; e8 < 8; ++e8)
#pragma unroll
                for (int e = 0; e < 8; ++e) lg[e] += x[e8] * wr[j * 8 + e8][e]; }
        const float rs = rstd_from_rss((const float*)(F.ws + WS_RSS), t);
        { u32x2 q0, q1;
          q0.x = pk4_fp8(bf_lo(w0.x) * rs, bf_hi(w0.x) * rs, bf_lo(w0.y) * rs, bf_hi(w0.y) * rs); q0.y = pk4_fp8(bf_lo(w0.z) * rs, bf_hi(w0.z) * rs, bf_lo(w0.w) * rs, bf_hi(w0.w) * rs);
          q1.x = pk4_fp8(bf_lo(w1v.x) * rs, bf_hi(w1v.x) * rs, bf_lo(w1v.y) * rs, bf_hi(w1v.y) * rs); q1.y = pk4_fp8(bf_lo(w1v.z) * rs, bf_hi(w1v.z) * rs, bf_lo(w1v.w) * rs, bf_hi(w1v.w) * rs);
          u32x2* h8 = (u32x2*)(F.ws + WS_HB8 + (size_t)t * DM) + lane; h8[0] = q0; h8[64] = q1; }
#pragma unroll
        for (int e = 0; e < 8; ++e) lg[e] = wave_sum(lg[e]) * rs;
        int i1 = 0; float v1 = lg[0];
#pragma unroll
        for (int e = 1; e < 8; ++e) if (lg[e] > v1) { v1 = lg[e]; i1 = e; }
        int i2 = 0; float v2 = -3.0e38f;
#pragma unroll
        for (int e = 0; e < 8; ++e) if (e != i1 && lg[e] > v2) { v2 = lg[e]; i2 = e; }
        const float e2 = __expf(v2 - v1), w1 = 1.0f / (1.0f + e2), w2 = e2 / (1.0f + e2);
        if (lane == 0) { TE[il] = (unsigned)i1 | ((unsigned)i2 << 8); TW1[il] = w1; TW2[il] = w2;
            TR1[il] = __hip_atomic_fetch_add(&CL[i1], 1, __ATOMIC_RELAXED, __HIP_MEMORY_SCOPE_WORKGROUP); TR2[il] = __hip_atomic_fetch_add(&CL[8 + i2], 1, __ATOMIC_RELAXED, __HIP_MEMORY_SCOPE_WORKGROUP); }
    }
    LDS_WAIT(); __syncthreads();
    if (tid < 16) BASE[tid] = (int)__hip_atomic_fetch_add((unsigned*)(F.ws + WS_CTL) + CW_SEG + 16 * tid, (unsigned)CL[tid], __ATOMIC_RELAXED, __HIP_MEMORY_SCOPE_AGENT);
    LDS_WAIT(); __syncthreads();
    if (tid < 128) { const unsigned te = TE[tid]; const int e1 = (int)(te & 0xffu), e2 = (int)(te >> 8), t = F.bx * 128 + tid;
        const int s1 = e1 * SEGCAP + BASE[e1] + TR1[tid], s2 = (8 + e2) * SEGCAP + BASE[8 + e2] + TR2[tid];
        int* STOK = (int*)(F.ws + WS_STOK); float* SGW = (float*)(F.ws + WS_SGW);
        STOK[s1] = t; SGW[s1] = TW1[tid]; STOK[s2] = t; SGW[s2] = TW2[tid]; ((int*)(F.ws + WS_TSL))[2 * t] = s1; ((int*)(F.ws + WS_TSL))[2 * t + 1] = s2; }
}
__device__ __forceinline__ void moe_tables(Frame& F) {
    LAS int* MT = (LAS int*)(F.lds + MT_OFF); LAS int* CN = MT + 32;
    if (F.tid < 16) CN[F.tid] = (int)__hip_atomic_load((unsigned*)(F.ws + WS_CTL) + CW_SEG + 16 * F.tid, __ATOMIC_RELAXED, __HIP_MEMORY_SCOPE_AGENT);
    LDS_WAIT(); __syncthreads();
    if (F.tid == 0) { int a = 0; for (int s = 0; s < 16; ++s) { MT[s] = a; a += (CN[s] + 255) >> 8; } MT[16] = a; }
    LDS_WAIT(); __syncthreads();
}
struct MoeOrder {
    const char* A; const char* W; size_t wstride; int lda_b, ldb_b, nN, G, c; const LAS int* MT; int gather_a; const int* stok; int rev;
    __device__ __forceinline__ bool next(int i, Unit& u) const {
        const int nM = MT[16]; int pm, pn; if (!tile_order(i, G, c, nM, nN, pm, pn)) return false;
        if (rev) pm = nM - 1 - pm;
        int s = 0;
#pragma unroll
        for (int q = 1; q < 16; ++q) s += (pm >= MT[q]) ? 1 : 0;
        const int tis = pm - MT[s], cnt = MT[32 + s];
        u.pm = s * SEGCAP + tis * BM; u.aux2 = cnt - tis * BM; u.pn = pn; u.aux = pm;
        u.A = gather_a ? A : A + (size_t)pm * BM * lda_b; u.B = W + (size_t)(s & 7) * wstride + (size_t)pn * BM * ldb_b; return true; }
};

__device__ __forceinline__ f32x4 bfx4_lo(const u32x4 a) { return (f32x4){bf_lo(a.x), bf_hi(a.x), bf_lo(a.y), bf_hi(a.y)}; }
__device__ __forceinline__ f32x4 bfx4_hi(const u32x4 a) { return (f32x4){bf_lo(a.z), bf_hi(a.z), bf_lo(a.w), bf_hi(a.w)}; }
__device__ __forceinline__ void final_phase(Frame& F) {
    const int gw = F.bx * 8 + F.wave, lane = F.lane;
    const LAS int* MT = (const LAS int*)(F.lds + MT_OFF);
    const f32x4 g0 = ((const f32x4*)karg_in(6))[2 * lane], g1 = ((const f32x4*)karg_in(6))[2 * lane + 1], g2 = ((const f32x4*)karg_in(6))[128 + 2 * lane], g3 = ((const f32x4*)karg_in(6))[128 + 2 * lane + 1];
    const bf16_t* HB = (const bf16_t*)(F.ws + WS_HB); const bf16_t* Y = (const bf16_t*)(F.ws + WS_Y); const int* TSL = (const int*)(F.ws + WS_TSL);
    for (int r0 = gw * 16; r0 < NTOK; r0 += F.G * 8 * 16) {
        const int sl = TSL[2 * r0 + (lane & 31)];
        const int cm = MT[sl >> 15] * BM + (sl & (SEGCAP - 1));
        u32x4 a[2], b[2], a1[2], b1[2], a2[2], b2[2];
#define FIN_LOAD(buf, i) do { const int c1 = __shfl(cm, 2 * (i)), c2 = __shfl(cm, 2 * (i) + 1); \
            const u32x4* p = (const u32x4*)(HB + (size_t)(r0 + (i)) * DM) + lane; const u32x4* y1 = (const u32x4*)(Y + (size_t)c1 * DM) + lane; const u32x4* y2 = (const u32x4*)(Y + (size_t)c2 * DM) + lane; \
            a[buf] = p[0]; b[buf] = p[64]; a1[buf] = y1[0]; b1[buf] = y1[64]; a2[buf] = y2[0]; b2[buf] = y2[64]; } while (0)
        FIN_LOAD(0, 0);
#pragma unroll
        for (int i = 0; i < 16; ++i) {
            const int cb = i & 1;
            if (i < 15) FIN_LOAD(cb ^ 1, i + 1);
            const f32x4 v0 = bfx4_lo(a[cb]) + bfx4_lo(a1[cb]) + bfx4_lo(a2[cb]), v1 = bfx4_hi(a[cb]) + bfx4_hi(a1[cb]) + bfx4_hi(a2[cb]), v2 = bfx4_lo(b[cb]) + bfx4_lo(b1[cb]) + bfx4_lo(b2[cb]), v3 = bfx4_hi(b[cb]) + bfx4_hi(b1[cb]) + bfx4_hi(b2[cb]);
            float s = ((v0[0] * v0[0] + v0[1] * v0[1]) + (v0[2] * v0[2] + v0[3] * v0[3])) + ((v1[0] * v1[0] + v1[1] * v1[1]) + (v1[2] * v1[2] + v1[3] * v1[3]));
            s += ((v2[0] * v2[0] + v2[1] * v2[1]) + (v2[2] * v2[2] + v2[3] * v2[3])) + ((v3[0] * v3[0] + v3[1] * v3[1]) + (v3[2] * v3[2] + v3[3] * v3[3]));
            const float rs = rsqrtf(wave_sum(s) * (1.0f / DM) + 1e-6f);
            f32x4* o = (f32x4*)(F.H + (size_t)(r0 + i) * DM) + 2 * lane;
            o[0] = v0 * rs * g0; o[1] = v1 * rs * g1; o[128] = v2 * rs * g2; o[129] = v3 * rs * g3; }
#undef FIN_LOAD
    }
}
constexpr int NPHASE = 19;
__global__ void __launch_bounds__(512, 2) mega(Args args) {
    extern __shared__ __attribute__((aligned(16))) unsigned char lds_raw[];
    Frame F;
    F.lds = (LAS unsigned char*)lds_raw;
    F.tid = threadIdx.x; F.lane = F.tid & 63; F.wave = __builtin_amdgcn_readfirstlane(F.tid >> 6); F.G = gridDim.x; F.bx = blockIdx.x;
    F.H = args.out; F.ws = args.ws;
    unsigned char* ws = args.ws;
    volatile LAS unsigned* MISC = (volatile LAS unsigned*)(F.lds + MISC_OFF);
    for (int u = F.tid; u < (LDS_BYTES - LDSCTL_OFF) / 4; u += 512) ((LAS unsigned*)(F.lds + LDSCTL_OFF))[u] = 0u;
    __syncthreads();
    const int lo = args.ph_lo, hi = args.ph_hi;
    const bool use_bar = (hi - lo) > 1;
    XcdBarrier bar; bar.bar = (unsigned*)(ws + WS_CTL) + CW_BAR; bar.x = 0; bar.st = nullptr;
    if (use_bar) bar = xcd_barrier_post((unsigned*)(ws + WS_CTL) + CW_BAR, MISC + 8);
#ifndef FK_PHASE_MASK
#define FK_PHASE_MASK 0x7ffff
#endif
#define IN(k) (((FK_PHASE_MASK >> (k)) & 1) && lo <= (k) && (k) < hi)
#define SEAM(k) do { if (IN((k) + 1)) xcd_barrier(bar); } while (0)
#ifndef FK_REPEAT_MASK
#define FK_REPEAT_MASK 0
#endif
#define REP(k) ((FK_REPEAT_MASK >> (k)) & 1)
#define PHASE(k, ...) if (IN(k)) { { __VA_ARGS__ } if (REP(k)) { if (use_bar) xcd_barrier(bar); { __VA_ARGS__ } } SEAM(k); }
    LAS unsigned char* ring = F.lds + RING_OFF; LAS float* TAB = (LAS float*)(F.lds + TAB_OFF);
    float* RSS = (float*)(ws + WS_RSS); bf16_t* HB = (bf16_t*)(ws + WS_HB);
    const int c = (int)blockIdx.x, G = (int)gridDim.x;

    PHASE(0, p0_prologue(F);)
    PHASE(1, KvOrder S{(const char*)(ws + WS_MEMN), (const char*)(ws + WS_WKT), G, c}; EpiPlain E{(bf16_t*)(ws + WS_KP), DM, (size_t)DM * DM};
        gemm_phase<EpiPlain, KvOrder>(ring, DM, DM, DM, S, E);)
    PHASE(2, MkVwOrder S{(const char*)(ws + WS_KP), (const char*)(ws + WS_WQS), (const char*)(ws + WS_WOT), G, c}; EpiPlain E{(bf16_t*)(ws + WS_MK), DM, (size_t)DM * DM};
        gemm_phase<EpiPlain, MkVwOrder>(ring, 256, DM, DM, S, E);)
    PHASE(3, DenseOrder S; S.init(HB, ws + WS_WIN0, NTOK, 2560, DM, DM, G, c); EpiGluZ E{(bf16_t*)(ws + WS_ZB), RSS};
        gemm_phase<EpiGluZ, DenseOrder>(ring, DM, DM, DM, S, E);)
    PHASE(4, conv_phase(F);)
    PHASE(5, DenseOrder S; S.init(ws + WS_MIX, ws + WS_WOUT0, NTOK, DM, DM, DM, G, c); EpiResid<true> E{karg_in(0), HB, RSS, TAB};
        gemm_phase<EpiResid<true>, DenseOrder>(ring, DM, DM, DM, S, E);)
    PHASE(6, DenseOrder S; S.init(HB, ws + WS_MK, NTOK, DM, DM, DM, G, c, 32, (size_t)DM * DM * 2); EpiSoftmax E{(bf16_t*)(ws + WS_PB), RSS, TAB};
        gemm_phase<EpiSoftmax, DenseOrder>(ring, DM, DM, DM, S, E);)
    PHASE(7, DenseOrder S; S.init(ws + WS_PB, ws + WS_MK + (size_t)8 * DM * DM * 2, NTOK, DM, DM, DM, G, c, 32, (size_t)DM * DM * 2); EpiResid<false> E{HB, HB, RSS, TAB};
        gemm_phase<EpiResid<false>, DenseOrder>(ring, DM, DM, DM, S, E);)
    PHASE(8, DenseOrder S; S.init(HB, ws + WS_WGU0, NTOK, 2 * DFF, DM, DM, G, c); EpiSwiGLU<false> E{(bf16_t*)(ws + WS_ACT0), DFF, RSS};
        gemm_phase<EpiSwiGLU<false>, DenseOrder>(ring, DM, DM, DM, S, E);)
    PHASE(9, DenseOrder S; S.init(ws + WS_ACT0, ws + WS_WD0, NTOK, DM, DFF, DFF, G, c); S.rev = 1; EpiResid<false> E{HB, HB, RSS, TAB};
        gemm_phase<EpiResid<false>, DenseOrder>(ring, DFF, DFF, DFF, S, E);)
    PHASE(10, DenseOrder S; S.init(HB, ws + WS_WSG, NTOK, 2048, DM, DM, G, c); EpiGeluUV E{(bf16_t*)(ws + WS_UV), RSS, (f32x2*)(ws + WS_VST), TAB};
        gemm_phase<EpiGeluUV, DenseOrder>(ring, DM, DM, DM, S, E);)
    PHASE(11, spatial_phase(F);)
    PHASE(12, DenseOrder S; S.init(ws + WS_US, ws + WS_WSO, NTOK, DM, DM, DM, G, c); EpiResid<false> E{HB, HB, RSS, TAB};
        gemm_phase<EpiResid<false>, DenseOrder>(ring, DM, DM, DM, S, E);)
    PHASE(13, DenseOrder S; S.init(HB, ws + WS_MK + (size_t)4 * DM * DM * 2, NTOK, DM, DM, DM, G, c, 32, (size_t)DM * DM * 2); EpiSoftmax E{(bf16_t*)(ws + WS_PB), RSS, TAB};
        gemm_phase<EpiSoftmax, DenseOrder>(ring, DM, DM, DM, S, E);)
    PHASE(14, DenseOrder S; S.init(ws + WS_PB, ws + WS_MK + (size_t)12 * DM * DM * 2, NTOK, DM, DM, DM, G, c, 32, (size_t)DM * DM * 2); EpiResid<false> E{HB, HB, RSS, TAB};
        gemm_phase<EpiResid<false>, DenseOrder>(ring, DM, DM, DM, S, E);)
    PHASE(15, router_phase(F);)
    if (hi > 16) moe_tables(F);
    const LAS int* MT = (const LAS int*)(F.lds + MT_OFF);
    PHASE(16, MoeOrder S{(const char*)(ws + WS_HB8), (const char*)(ws + WS_WGU1), (size_t)2 * DFF * DM, DM, DM, 22, G, c, MT, 1, (const int*)(ws + WS_STOK), 0}; EpiSwiGLU8 E{(unsigned char*)(ws + WS_ACT8)};
        gemm_phase<EpiSwiGLU8, MoeOrder, true, true>(ring, DM, DM, DM, S, E);)
    PHASE(17, MoeOrder S{(const char*)(ws + WS_ACT8), (const char*)(ws + WS_WD1), (size_t)DM * DFF, DFF, DFF, 4, G, c, MT, 0, nullptr, 0}; EpiMoeDown8 E{(bf16_t*)(ws + WS_Y), (const float*)(ws + WS_SGW)};
        gemm_phase<EpiMoeDown8, MoeOrder, false, true>(ring, DFF, DFF, DFF, S, E);)
    if (IN(18)) { final_phase(F); }
#undef IN
#undef SEAM
}

static int fk_grid = 0;
static bool fk_setup() {
    if (fk_grid == 0) {
        int dev = 0, cus = 0, per_cu = 0;
        if (hipGetDevice(&dev) != hipSuccess || hipDeviceGetAttribute(&cus, hipDeviceAttributeMultiprocessorCount, dev) != hipSuccess) { fk_grid = -1; return false; }
        if (hipFuncSetAttribute((const void*)mega, hipFuncAttributeMaxDynamicSharedMemorySize, LDS_BYTES) != hipSuccess) { fprintf(stderr, "hipFuncSetAttribute failed\n"); fk_grid = -1; return false; }
        if (hipOccupancyMaxActiveBlocksPerMultiprocessor(&per_cu, (const void*)mega, 512, LDS_BYTES) != hipSuccess || per_cu < 1) fprintf(stderr, "note: occupancy query says %d\n", per_cu);
        (void)hipGetLastError();
        fk_grid = 256;
        if (cus != 256) fprintf(stderr, "note: %d CUs reported; this kernel is built for 256\n", cus);
    }
    return fk_grid > 0;
}
static void fk_run(hipStream_t stream, void* const* d_in, void* d_out, void* d_ws, int lo, int hi, bool per_phase) {
    if (!fk_setup()) return;
    Args a{};
    for (int i = 0; i < 31; ++i) a.in[i] = (const float*)d_in[i];
    a.out = (float*)d_out; a.ws = (unsigned char*)d_ws;
#ifndef FK_HOST_REPEAT_MASK
#define FK_HOST_REPEAT_MASK 0
#endif
    if (per_phase) { for (int p = lo; p < hi; ++p) { a.ph_lo = p; a.ph_hi = p + 1; const int reps = ((FK_HOST_REPEAT_MASK >> p) & 1) ? 2 : 1;
        for (int q = 0; q < reps; ++q) hipLaunchKernelGGL(mega, dim3(fk_grid), dim3(512), LDS_BYTES, stream, a); } }
    else { a.ph_lo = lo; a.ph_hi = hi; hipLaunchKernelGGL(mega, dim3(fk_grid), dim3(512), LDS_BYTES, stream, a); }
    const hipError_t le = hipPeekAtLastError();
    if (le != hipSuccess) fprintf(stderr, "kernel_launch: launch failed: %s\n", hipGetErrorName(le));
}
}

#ifndef FK_MODE
#define FK_MODE 1
#endif
#ifndef FK_NSUB
#define FK_NSUB 1
#endif
extern "C" void kernel_launch(void* const* d_in, const int* in_sizes, int n_in, void* d_out, int out_size, void* d_ws, size_t ws_size, hipStream_t stream) {
    if (n_in != 31 || out_size != fk::NTOK * fk::DM || ws_size < fk::WS_END) { fprintf(stderr, "kernel_launch: unexpected shapes (n_in %d out %d ws %zu)\n", n_in, out_size, ws_size); return; }
    (void)hipMemsetAsync((char*)d_ws + fk::WS_CTL, 0, fk::CTL_ZERO_BYTES, stream);
#if FK_MODE == 1
    fk::fk_run(stream, d_in, d_out, d_ws, 0, fk::NPHASE, false);
#elif FK_MODE == 2
    fk::fk_run(stream, d_in, d_out, d_ws, 0, fk::NPHASE, true);
#elif FK_MODE == 3
    { constexpr int endph[7] = {0, 6, 8, 10, 13, 15, 18};
      float* h = (float*)d_out;
      if (FK_NSUB == 0) (void)hipMemcpyAsync(h, d_in[0], (size_t)nv::NTOK * nv::DM * 4, hipMemcpyDeviceToDevice, stream);
      else fk::fk_run(stream, d_in, d_out, d_ws, 0, endph[FK_NSUB], true);
      const nv::Bufs B = nv::carve(d_ws);
      for (int s = FK_NSUB; s < 6; ++s) nv::sublayer(stream, s, h, d_in, B);
      nv::final_norm(stream, h, d_in); }
#else
    { float* h = (float*)d_out;
      (void)hipMemcpyAsync(h, d_in[0], (size_t)nv::NTOK * nv::DM * 4, hipMemcpyDeviceToDevice, stream);
      const nv::Bufs B = nv::carve(d_ws);
      for (int s = 0; s < 6; ++s) nv::sublayer(stream, s, h, d_in, B);
      nv::final_norm(stream, h, d_in); }
#endif
}
```

```cpp
#include <hip/hip_runtime.h>
#include <cstdio>
#include <cstdint>
#define FK_MODE 1
#define FK_NSUB 0
namespace fk {
#define LAS __attribute__((address_space(3)))
#define GAS __attribute__((address_space(1)))
typedef unsigned short bf16_t;
typedef short bf16x8 __attribute__((ext_vector_type(8)));
typedef float f32x4 __attribute__((ext_vector_type(4)));
typedef float f32x2 __attribute__((ext_vector_type(2)));
typedef unsigned u32x4 __attribute__((ext_vector_type(4)));
typedef unsigned u32x2 __attribute__((ext_vector_type(2)));
typedef int i32x4 __attribute__((ext_vector_type(4)));
typedef GAS unsigned gu32;

constexpr int NTOK = 32768, DM = 1024, SEQL = 8192, MEML = 256, DFF = 2816, NEXP = 8;
constexpr int ZW = 1536;
constexpr int HALF_TILES = 136, HALF_ROWS = HALF_TILES * 256;
constexpr int BM = 256, BK = 64, HALF = 128, HTB = HALF * BK * 2, NXCD = 8, WGM = 8;

constexpr int RING_OFF = 0, RING_BYTES = 131072;
constexpr int LDSCTL_OFF = RING_BYTES, MISC_OFF = LDSCTL_OFF + 320;
constexpr int TAB_OFF = LDSCTL_OFF + 512;
constexpr int MT_OFF = TAB_OFF + 8192;
constexpr int RSCR_OFF = MT_OFF + 256;
constexpr int LDS_BYTES = 147456;
static_assert(RSCR_OFF + 4096 <= LDS_BYTES, "LDS map");

constexpr size_t MiB = 1u << 20;
constexpr size_t WS_CTL = 0, CTL_ZERO_BYTES = 64 * 1024;
constexpr size_t WS_RSS = 1 * MiB;
constexpr size_t WS_VST = 2 * MiB;
constexpr size_t WS_TSL = 3 * MiB;
constexpr size_t WS_STOK = 4 * MiB;
constexpr size_t WS_SGW = 6 * MiB;
constexpr size_t WS_MEMN = 8 * MiB;
constexpr size_t WS_KP = 12 * MiB;
constexpr size_t WS_WGU1 = 20 * MiB;
constexpr size_t WS_WD1 = 64 * MiB;
constexpr size_t WS_HB = 86 * MiB;
constexpr size_t WS_HB8 = 150 * MiB;
constexpr size_t WS_WIN0 = 182 * MiB;
constexpr size_t WS_WOUT0 = 187 * MiB;
constexpr size_t WS_WGU0 = 189 * MiB;
constexpr size_t WS_WD0 = 200 * MiB;
constexpr size_t WS_WQS = 206 * MiB;
constexpr size_t WS_WOT = 210 * MiB;
constexpr size_t WS_WKT = 214 * MiB;
constexpr size_t WS_MK = 222 * MiB;
constexpr size_t WS_WSG = 254 * MiB;
constexpr size_t WS_WSO = 258 * MiB;
constexpr size_t WS_R = 262 * MiB;
constexpr size_t WS_ZB = WS_R, WS_MIX = WS_R + 96 * MiB, WS_PB = WS_R, WS_ACT0 = WS_R, WS_UV = WS_R, WS_US = WS_R + 128 * MiB;
constexpr int SEGCAP = 32768;
constexpr int MOE_TILES = 2 * HALF_TILES;
constexpr size_t WS_ACT8 = 182 * MiB;
constexpr size_t WS_Y = 369 * MiB;
constexpr size_t WS_END = 512 * MiB;
static_assert(WS_ACT8 + (size_t)MOE_TILES * 256 * DFF <= WS_Y && WS_Y + (size_t)MOE_TILES * 256 * DM * 2 <= WS_END && WS_R + 216 * MiB <= WS_END, "ws map");
constexpr int CW_SEG = 512;
constexpr int CW_BAR = 1024;

#define RLX_AGENT __ATOMIC_RELAXED, __HIP_MEMORY_SCOPE_AGENT
#define LDS_WAIT() asm volatile("s_waitcnt lgkmcnt(0)" ::: "memory")
#define VM_WAIT() asm volatile("s_waitcnt vmcnt(0)" ::: "memory")
__device__ __forceinline__ unsigned cvt_pk_bf16(float lo, float hi) { unsigned r; asm volatile("v_cvt_pk_bf16_f32 %0, %1, %2" : "=v"(r) : "v"(lo), "v"(hi)); return r; }
__device__ __forceinline__ float bf_lo(unsigned w) { return __uint_as_float(w << 16); }
__device__ __forceinline__ float bf_hi(unsigned w) { return __uint_as_float(w & 0xffff0000u); }
__device__ __forceinline__ float fast_sigmoid(float x) { return __builtin_amdgcn_rcpf(1.0f + __builtin_amdgcn_exp2f(-1.4426950408889634f * x)); }
__device__ __forceinline__ float fast_exp(float x) { return __builtin_amdgcn_exp2f(1.4426950408889634f * x); }
__device__ __forceinline__ float gelu_tanh_f(float x) { const float y = 1.5957691216057308f * (x + 0.044715f * x * x * x); return x * fast_sigmoid(y); }
__device__ __forceinline__ float wave_sum(float v) {
#pragma unroll
    for (int o = 1; o < 64; o <<= 1) v += __shfl_xor(v, o);
    return v;
}
__device__ __forceinline__ float rstd_from_rss(const float* RSS4, int row) { const f32x4 s = *(const f32x4*)(RSS4 + (size_t)row * 4); return rsqrtf(((s.x + s.y) + (s.z + s.w)) * (1.0f / DM) + 1e-6f); }

__host__ __device__ __forceinline__ int lds_byte(int r, int c) { const int st = (r >> 4) * 2 + (c >> 5), rr = r & 15, cc = c & 31, ob = rr * 64 + cc * 2; return st * 1024 + (ob ^ (((ob >> 9) & 1) << 5)); }
__host__ __device__ __forceinline__ void stage_rc(int b, int& R, int& C) { const int st = b / 1024, sb = b % 1024, swz = sb ^ (((sb >> 9) & 1) << 5); R = (st >> 1) * 16 + swz / 64; C = (st & 1) * 32 + (swz % 64) / 2; }
__host__ __device__ __forceinline__ int perm32(int rho) { const int n = rho >> 4, i = rho & 15; return 8 * (i >> 2) + 4 * n + (i & 3); }

struct Unit { const char* A; const char* B; int pm, pn, aux, aux2; };

__device__ __forceinline__ bool tile_order(int i, int G, int c, int nM, int nN, int& pm, int& pn, const int WGM = 8) {
    const int nwg = nM * nN; const long L = (long)i * G + c; if (L >= nwg) return false;
    int wgid = (int)L; { const int q = nwg / NXCD, r = nwg % NXCD, xcd = wgid % NXCD, off = wgid / NXCD; wgid = (xcd < r ? xcd * (q + 1) : r * (q + 1) + (xcd - r) * q) + off; }
    const int nig = WGM * nN, gid = wgid / nig, fm = gid * WGM, gsz = (nM - fm) < WGM ? (nM - fm) : WGM;
    pm = fm + ((wgid % nig) % gsz); pn = (wgid % nig) / gsz; return true;
}
struct DenseOrder {
    const char* A; const char* Bt; int lda, ldb, nM, nN, G, c, pm_per_b; size_t bstride; int rev;
    __device__ __forceinline__ void init(const void* A_, const void* Bt_, int M, int N, int lda_, int ldb_, int G_, int c_, int pmb = 0, size_t bs = 0) {
        A = (const char*)A_; Bt = (const char*)Bt_; lda = lda_; ldb = ldb_; nM = M / BM; nN = N / BM; G = G_; c = c_; pm_per_b = pmb; bstride = bs; rev = 0; }
    __device__ __forceinline__ bool next(int i, Unit& u) const {
        int pm, pn; if (!tile_order(i, G, c, nM, nN, pm, pn)) return false;
        if (rev) pm = nM - 1 - pm;
        u.pm = pm; u.pn = pn; u.aux = 0; u.aux2 = 0; u.A = A + (size_t)pm * BM * lda * 2; u.B = Bt + (size_t)pn * BM * ldb * 2 + (pm_per_b ? (size_t)(pm / pm_per_b) * bstride : 0); return true; }
};

typedef int v4i_t __attribute__((ext_vector_type(4)));
typedef int v8i_t __attribute__((ext_vector_type(8)));
__device__ __forceinline__ v8i_t lds_ld32(const LAS unsigned char* p) { const v4i_t a = *(const LAS v4i_t*)p, b = *(const LAS v4i_t*)(p + 1024); return __builtin_shufflevector(a, b, 0, 1, 2, 3, 4, 5, 6, 7); }
template <class Epi, class Sched, bool GATHER = false, bool FP8 = false, bool ALIGN_EPI = true, bool SP2 = true>
__device__ __forceinline__ void gemm_phase(LAS unsigned char* lds, const int K, const int lda, const int ldb, const Sched& S, const Epi& E) {
    int tid_ = threadIdx.x; asm volatile("" : "+v"(tid_));
    const int tid = tid_, wid = __builtin_amdgcn_readfirstlane(tid >> 6), lane = tid & 63, wr = wid >> 2, wc = wid & 3, fr = lane & 15, fq = lane >> 4;
    int K_ = K; asm volatile("" : "+s"(K_));
    constexpr int ES = FP8 ? 1 : 2;
    const int nt = K_ * ES / 128;
    unsigned voffA[2][2], voffB[2];
#pragma unroll
    for (int i = 0; i < 2; ++i) { int R, C; stage_rc(tid * 16 + i * 8192, R, C); const int Rb = Epi::PERM ? ((R & ~31) + perm32(R & 31)) : R;
        voffA[0][i] = (unsigned)(R * lda * ES + C * 2); voffA[1][i] = (unsigned)((R + HALF) * lda * ES + C * 2); voffB[i] = (unsigned)(Rb * ldb * ES + C * 2); }
#define PG8_GIDX(dst, un) do { _Pragma("unroll") for (int _h = 0; _h < 2; ++_h) _Pragma("unroll") for (int _i = 0; _i < 2; ++_i) { int _R0, _C0; stage_rc(tid * 16 + _i * 8192, _R0, _C0); const int _R = _R0 + HALF * _h, _m = (un).aux2 - 1; \
        dst[_h][_i] = S.stok[(un).pm + (_R < _m ? _R : _m)]; } } while (0)
#define PG8_GOFF(dst, src) do { _Pragma("unroll") for (int _h = 0; _h < 2; ++_h) _Pragma("unroll") for (int _i = 0; _i < 2; ++_i) { int _R0, _C0; stage_rc(tid * 16 + _i * 8192, _R0, _C0); dst[_h][_i] = (unsigned)(src[_h][_i] * lda * ES + _C0 * 2); } } while (0)
    const size_t kstep = (size_t)(BK * 2);
    const size_t hstepB = (size_t)HALF * ldb * ES;
    const unsigned ldsw = (unsigned)wid * 1024u;
    const int aoff = lds_byte(wr * 64 + fr, fq * 8), boff = lds_byte(wc * 32 + fr, fq * 8);
#define PG8_SA(b, h) (((b) * 2 + (h)) * HTB)
#define PG8_SB(b, h) ((4 + (b) * 2 + (h)) * HTB)
#define PG8_STAGE(bufoff, gbase, voff) do { _Pragma("unroll") for (int _i = 0; _i < 2; ++_i) { unsigned _o = (voff)[_i]; asm volatile("" : "+v"(_o));     \
        __builtin_amdgcn_global_load_lds((const unsigned*)((const char*)(gbase) + _o), (LAS unsigned*)(lds + (bufoff) + ldsw + _i * 8192), 16, 0, 0); } } while (0)
#define PG8_LDA(dst, b, h) do { if constexpr (FP8) { _Pragma("unroll") for (int m = 0; m < 4; ++m) dst##8[m] = lds_ld32(lds + PG8_SA(b, h) + aoff + m * 2048); } else { \
        _Pragma("unroll") for (int m = 0; m < 4; ++m) _Pragma("unroll") for (int k = 0; k < 2; ++k) dst[m][k] = *(const LAS bf16x8*)(lds + PG8_SA(b, h) + aoff + m * 2048 + k * 1024); } } while (0)
#define PG8_LDB(dst, b, h) do { if constexpr (FP8) { _Pragma("unroll") for (int n = 0; n < 2; ++n) dst##8[n] = lds_ld32(lds + PG8_SB(b, h) + boff + n * 2048); } else { \
        _Pragma("unroll") for (int n = 0; n < 2; ++n) _Pragma("unroll") for (int k = 0; k < 2; ++k) dst[n][k] = *(const LAS bf16x8*)(lds + PG8_SB(b, h) + boff + n * 2048 + k * 1024); } } while (0)
#define PG8_MMA8(ai, bj, At8, Bt8) asm volatile("s_nop 1\n\t" \
        "v_mfma_f32_16x16x128_f8f6f4 %0, %12, %8, %0\n\tv_mfma_f32_16x16x128_f8f6f4 %1, %13, %8, %1\n\t" \
        "v_mfma_f32_16x16x128_f8f6f4 %2, %12, %9, %2\n\tv_mfma_f32_16x16x128_f8f6f4 %3, %13, %9, %3\n\t" \
        "v_mfma_f32_16x16x128_f8f6f4 %4, %12, %10, %4\n\tv_mfma_f32_16x16x128_f8f6f4 %5, %13, %10, %5\n\t" \
        "v_mfma_f32_16x16x128_f8f6f4 %6, %12, %11, %6\n\tv_mfma_f32_16x16x128_f8f6f4 %7, %13, %11, %7" \
        : "+v"(acc[ai][bj][0][0]), "+v"(acc[ai][bj][0][1]), "+v"(acc[ai][bj][1][0]), "+v"(acc[ai][bj][1][1]), "+v"(acc[ai][bj][2][0]), "+v"(acc[ai][bj][2][1]), "+v"(acc[ai][bj][3][0]), "+v"(acc[ai][bj][3][1]) \
        : "v"(At8[0]), "v"(At8[1]), "v"(At8[2]), "v"(At8[3]), "v"(Bt8[0]), "v"(Bt8[1]))
#define PG8_MMA8Z(ai, bj, At8, Bt8) asm volatile("s_nop 1\n\t" \
        "v_mfma_f32_16x16x128_f8f6f4 %0, %12, %8, 0\n\tv_mfma_f32_16x16x128_f8f6f4 %1, %13, %8, 0\n\t" \
        "v_mfma_f32_16x16x128_f8f6f4 %2, %12, %9, 0\n\tv_mfma_f32_16x16x128_f8f6f4 %3, %13, %9, 0\n\t" \
        "v_mfma_f32_16x16x128_f8f6f4 %4, %12, %10, 0\n\tv_mfma_f32_16x16x128_f8f6f4 %5, %13, %10, 0\n\t" \
        "v_mfma_f32_16x16x128_f8f6f4 %6, %12, %11, 0\n\tv_mfma_f32_16x16x128_f8f6f4 %7, %13, %11, 0" \
        : "=&v"(acc[ai][bj][0][0]), "=&v"(acc[ai][bj][0][1]), "=&v"(acc[ai][bj][1][0]), "=&v"(acc[ai][bj][1][1]), "=&v"(acc[ai][bj][2][0]), "=&v"(acc[ai][bj][2][1]), "=&v"(acc[ai][bj][3][0]), "=&v"(acc[ai][bj][3][1]) \
        : "v"(At8[0]), "v"(At8[1]), "v"(At8[2]), "v"(At8[3]), "v"(Bt8[0]), "v"(Bt8[1]))
#define PG8_MMAZ(ai, bj, At, Bt, z) do { if constexpr (FP8) { if (z) { __builtin_amdgcn_s_setprio(1); PG8_MMA8Z(ai, bj, At##8, Bt##8); __builtin_amdgcn_s_setprio(0); } else PG8_MMA(ai, bj, At, Bt); } else PG8_MMA(ai, bj, At, Bt); } while (0)
#define PG8_MMA(ai, bj, At, Bt) do { __builtin_amdgcn_s_setprio(1); if constexpr (FP8) { PG8_MMA8(ai, bj, At##8, Bt##8); } else { \
        _Pragma("unroll") for (int m = 0; m < 4; ++m) _Pragma("unroll") for (int n = 0; n < 2; ++n) _Pragma("unroll") for (int k = 0; k < 2; ++k) \
        acc[ai][bj][m][n] = __builtin_amdgcn_mfma_f32_16x16x32_bf16(Bt[n][k], At[m][k], acc[ai][bj][m][n], 0, 0, 0); } __builtin_amdgcn_s_setprio(0); } while (0)
#define PG8_WAIT_V(n) asm volatile("s_waitcnt vmcnt(" #n ")" ::: "memory")
#define PG8_WAIT_L(n) asm volatile("s_waitcnt lgkmcnt(" #n ")" ::: "memory")
#define PG8_BAR __builtin_amdgcn_s_barrier()
#define PG8_SCHED __builtin_amdgcn_sched_barrier(0)
    Unit cur, nxt; int ui = 0;
    if (!S.next(0, cur)) return;
    f32x4 acc[2][2][4][2];
#pragma unroll
    for (int a = 0; a < 2; ++a)
#pragma unroll
        for (int b = 0; b < 2; ++b)
#pragma unroll
            for (int m = 0; m < 4; ++m)
#pragma unroll
                for (int n = 0; n < 2; ++n) acc[a][b][m][n] = (f32x4){0.f, 0.f, 0.f, 0.f};
    bf16x8 At[4][2], B0[2][2], B1[2][2]; v8i_t At8[4], B08[2], B18[2];
    const char* cA = cur.A; const char* cB = cur.B;
    int ntok[2][2] = {{0, 0}, {0, 0}}, ntok2[2][2] = {{0, 0}, {0, 0}};
    if constexpr (GATHER) { PG8_GIDX(ntok, cur); PG8_GOFF(voffA, ntok); Unit u1; if (S.next(1, u1)) PG8_GIDX(ntok, u1); }
    if constexpr (SP2) {
        PG8_STAGE(PG8_SB(0, 0), cB, voffB); PG8_STAGE(PG8_SB(0, 1), cB + hstepB, voffB); PG8_STAGE(PG8_SA(0, 0), cA, voffA[0]); PG8_STAGE(PG8_SA(0, 1), cA, voffA[1]);
        if (wr == 1) PG8_BAR;
        PG8_WAIT_V(2); PG8_BAR;
        PG8_STAGE(PG8_SB(1, 0), cB + kstep, voffB); PG8_STAGE(PG8_SA(1, 0), cA + kstep, voffA[0]); PG8_STAGE(PG8_SB(1, 1), cB + hstepB + kstep, voffB);
        PG8_WAIT_V(6); PG8_BAR;
    } else {
        PG8_STAGE(PG8_SB(0, 0), cB, voffB); PG8_STAGE(PG8_SA(0, 0), cA, voffA[0]); PG8_STAGE(PG8_SB(0, 1), cB + hstepB, voffB); PG8_STAGE(PG8_SA(0, 1), cA, voffA[1]);
        if (wr == 1) PG8_BAR;
        PG8_WAIT_V(4); PG8_BAR;
        PG8_STAGE(PG8_SB(1, 0), cB + kstep, voffB); PG8_STAGE(PG8_SA(1, 0), cA + kstep, voffA[0]); PG8_STAGE(PG8_SB(1, 1), cB + hstepB + kstep, voffB);
        PG8_WAIT_V(6); PG8_BAR;
    }
    for (;;) {
        const bool has_next = S.next(ui + 1, nxt);
        const char* nA = has_next ? nxt.A : cA; const char* nB = has_next ? nxt.B : cB;
        Unit u2; const bool has_next2 = GATHER ? S.next(ui + 2, u2) : false;
        for (int t = 0; t < nt; t += 2) {
            const bool last = (t == nt - 2);
            unsigned v2A[2][2];
#pragma unroll
            for (int _h = 0; _h < 2; ++_h)
#pragma unroll
                for (int _i = 0; _i < 2; ++_i) v2A[_h][_i] = voffA[_h][_i];
            if constexpr (GATHER) { if (t == 0 && has_next2) PG8_GIDX(ntok2, u2);
                if (last && has_next) PG8_GOFF(v2A, ntok); }
            const char* a1 = cA + (size_t)(t + 1) * kstep;
            const char* a2 = last ? nA : cA + (size_t)(t + 2) * kstep; const char* b2 = last ? nB : cB + (size_t)(t + 2) * kstep;
            const char* a3 = a2 + kstep; const char* b3 = b2 + kstep;
            if constexpr (SP2) {
            PG8_LDB(B0, 0, 0); PG8_LDB(B1, 0, 1); PG8_SCHED; PG8_LDA(At, 0, 0); PG8_STAGE(PG8_SA(1, 1), a1, voffA[1]);
            PG8_WAIT_V(8); PG8_WAIT_L(0); PG8_BAR; PG8_MMAZ(0, 0, At, B0, t == 0); PG8_MMAZ(0, 1, At, B1, t == 0); PG8_BAR; PG8_SCHED;
            PG8_LDA(At, 0, 1); PG8_STAGE(PG8_SB(0, 0), b2, voffB); PG8_STAGE(PG8_SB(0, 1), b2 + hstepB, voffB); PG8_STAGE(PG8_SA(0, 0), a2, v2A[0]);
            PG8_WAIT_V(8); PG8_WAIT_L(0); PG8_BAR; PG8_MMAZ(1, 0, At, B0, t == 0); PG8_MMAZ(1, 1, At, B1, t == 0); PG8_BAR; PG8_SCHED;
            PG8_LDB(B0, 1, 0); PG8_LDB(B1, 1, 1); PG8_SCHED; PG8_LDA(At, 1, 0); PG8_STAGE(PG8_SA(0, 1), a2, v2A[1]);
            PG8_WAIT_V(8); PG8_WAIT_L(0); PG8_BAR; PG8_MMA(0, 0, At, B0); PG8_MMA(0, 1, At, B1); PG8_BAR; PG8_SCHED;
            PG8_LDA(At, 1, 1); PG8_STAGE(PG8_SB(1, 0), b3, voffB); PG8_STAGE(PG8_SB(1, 1), b3 + hstepB, voffB); PG8_STAGE(PG8_SA(1, 0), a3, v2A[0]);
            PG8_WAIT_V(8); PG8_WAIT_L(0); PG8_BAR; PG8_MMA(1, 0, At, B0); PG8_MMA(1, 1, At, B1); PG8_BAR; PG8_SCHED;
            } else {
            PG8_LDB(B0, 0, 0); PG8_SCHED; PG8_LDA(At, 0, 0); PG8_STAGE(PG8_SA(1, 1), a1, voffA[1]);
            PG8_WAIT_L(8); PG8_BAR; PG8_WAIT_L(0); PG8_MMA(0, 0, At, B0); PG8_BAR; PG8_SCHED;
            PG8_LDB(B1, 0, 1); PG8_STAGE(PG8_SB(0, 0), b2, voffB);
            PG8_BAR; PG8_WAIT_L(0); PG8_MMA(0, 1, At, B1); PG8_BAR;
            PG8_LDA(At, 0, 1); PG8_STAGE(PG8_SA(0, 0), a2, v2A[0]);
            PG8_BAR; PG8_WAIT_L(0); PG8_MMA(1, 0, At, B0); PG8_BAR; PG8_SCHED;
            PG8_STAGE(PG8_SB(0, 1), b2 + hstepB, voffB);
            PG8_WAIT_V(6); PG8_BAR; PG8_MMA(1, 1, At, B1); PG8_BAR;
            PG8_LDB(B0, 1, 0); PG8_SCHED; PG8_LDA(At, 1, 0); PG8_STAGE(PG8_SA(0, 1), a2, v2A[1]);
            PG8_WAIT_L(8); PG8_BAR; PG8_WAIT_L(0); PG8_MMA(0, 0, At, B0); PG8_BAR; PG8_SCHED;
            PG8_LDB(B1, 1, 1); PG8_STAGE(PG8_SB(1, 0), b3, voffB);
            PG8_BAR; PG8_WAIT_L(0); PG8_MMA(0, 1, At, B1); PG8_BAR;
            PG8_LDA(At, 1, 1); PG8_STAGE(PG8_SA(1, 0), a3, v2A[0]);
            PG8_BAR; PG8_WAIT_L(0); PG8_MMA(1, 0, At, B0); PG8_BAR; PG8_SCHED;
            PG8_STAGE(PG8_SB(1, 1), b3 + hstepB, voffB);
            PG8_WAIT_V(6); PG8_BAR; PG8_MMA(1, 1, At, B1); PG8_BAR;
            }
        }
        if constexpr (ALIGN_EPI) { if (wr == 0) PG8_BAR; }
        if constexpr (FP8) asm volatile("s_nop 15\n\ts_nop 15" ::: "memory");
        E(acc, cur, wr, wc, fr, fq, tid);
        if (!has_next) break;
        if constexpr (!FP8) {
#pragma unroll
        for (int a = 0; a < 2; ++a)
#pragma unroll
            for (int b = 0; b < 2; ++b)
#pragma unroll
                for (int m = 0; m < 4; ++m)
#pragma unroll
                    for (int n = 0; n < 2; ++n) acc[a][b][m][n] = (f32x4){0.f, 0.f, 0.f, 0.f}; }
        cur = nxt; cA = nA; cB = nB; ++ui;
        if constexpr (GATHER) { PG8_GOFF(voffA, ntok);
#pragma unroll
            for (int _h = 0; _h < 2; ++_h)
#pragma unroll
                for (int _i = 0; _i < 2; ++_i) ntok[_h][_i] = ntok2[_h][_i]; }
        if constexpr (ALIGN_EPI) { if (wr == 1) PG8_BAR; }
    }
    PG8_WAIT_V(0);
    if constexpr (!ALIGN_EPI) { if (wr == 0) PG8_BAR; }
    PG8_BAR;
#undef PG8_SA
#undef PG8_SB
#undef PG8_STAGE
#undef PG8_LDA
#undef PG8_LDB
#undef PG8_MMA
#undef PG8_MMAZ
#undef PG8_MMA8Z
#undef PG8_MMA8
#undef PG8_WAIT_V
#undef PG8_WAIT_L
#undef PG8_BAR
#undef PG8_SCHED
#undef PG8_GOFF
#undef PG8_GIDX
}

#define EPI_BAR() do { asm volatile("s_waitcnt lgkmcnt(0)" ::: "memory"); __builtin_amdgcn_s_barrier(); asm volatile("" ::: "memory"); } while (0)
typedef f32x4 acc_t[2][2][4][2];

struct EpiPlain {
    static constexpr bool PERM = true;
    bf16_t* O; int ldc; size_t aux_stride;
    __device__ __forceinline__ void operator()(acc_t& acc, const Unit& u, int wr, int wc, int fr, int fq, int tid) const {
        bf16_t* base = O + (size_t)u.aux * aux_stride + (size_t)(u.pm * BM + wr * 64 + fr) * ldc + u.pn * BM + wc * 32 + 8 * fq;
#pragma unroll
        for (int ai = 0; ai < 2; ++ai)
#pragma unroll
            for (int m = 0; m < 4; ++m) { bf16_t* rowp = base + (size_t)(ai * HALF + m * 16) * ldc;
#pragma unroll
                for (int bj = 0; bj < 2; ++bj) { const f32x4 v0 = acc[ai][bj][m][0], v1 = acc[ai][bj][m][1];
                    u32x4 w; w.x = cvt_pk_bf16(v0[0], v0[1]); w.y = cvt_pk_bf16(v0[2], v0[3]); w.z = cvt_pk_bf16(v1[0], v1[1]); w.w = cvt_pk_bf16(v1[2], v1[3]);
                    *(u32x4*)(rowp + bj * HALF) = w; } }
    }
};

__device__ __forceinline__ f32x2 silu_mul_pk(f32x2 g, f32x2 up) {
    const f32x2 t = g * (-1.4426950408889634f); f32x2 e; e.x = __builtin_amdgcn_exp2f(t.x); e.y = __builtin_amdgcn_exp2f(t.y);
    const f32x2 d = e + 1.0f; f32x2 r; r.x = __builtin_amdgcn_rcpf(d.x); r.y = __builtin_amdgcn_rcpf(d.y);
    return (g * r) * up;
}
__device__ __forceinline__ f32x2 gelu_tanh_pk(f32x2 x) {
    const f32x2 x2 = x * x, p = x2 * 0.044715f + 1.0f, t = (x * p) * (-1.5957691216057308f * 1.4426950408889634f);
    f32x2 e; e.x = __builtin_amdgcn_exp2f(t.x); e.y = __builtin_amdgcn_exp2f(t.y);
    const f32x2 d = e + 1.0f; f32x2 r; r.x = __builtin_amdgcn_rcpf(d.x); r.y = __builtin_amdgcn_rcpf(d.y);
    return x * r;
}
struct EpiGluZ {
    static constexpr bool PERM = true;
    bf16_t* ZB; const float* RSS4;
    __device__ __forceinline__ void operator()(acc_t& acc, const Unit& u, int wr, int wc, int fr, int fq, int tid) const {
        const int pn = u.pn;
#pragma unroll
        for (int ai = 0; ai < 2; ++ai)
#pragma unroll
            for (int m = 0; m < 4; ++m) {
                const int r = u.pm * BM + ai * HALF + wr * 64 + m * 16 + fr; const float rs = rstd_from_rss(RSS4, r);
                bf16_t* rowp = ZB + (size_t)r * ZW + wc * 32 + 8 * fq;
                if (pn < 4 || pn >= 6) {
                    float o[8];
#pragma unroll
                    for (int n = 0; n < 2; ++n)
#pragma unroll
                        for (int e = 0; e < 4; e += 2) { const f32x2 a = (f32x2){acc[ai][0][m][n][e], acc[ai][0][m][n][e + 1]} * rs, b = (f32x2){acc[ai][1][m][n][e], acc[ai][1][m][n][e + 1]} * rs; f32x2 r;
                            if (pn < 4) { const f32x2 t = b * (-1.4426950408889634f); f32x2 ex; ex.x = __builtin_amdgcn_exp2f(t.x); ex.y = __builtin_amdgcn_exp2f(t.y); const f32x2 d = ex + 1.0f; f32x2 q; q.x = __builtin_amdgcn_rcpf(d.x); q.y = __builtin_amdgcn_rcpf(d.y); r = a * q; }
                            else r = a * b;
                            o[n * 4 + e] = r.x; o[n * 4 + e + 1] = r.y; }
                    u32x4 w; w.x = cvt_pk_bf16(o[0], o[1]); w.y = cvt_pk_bf16(o[2], o[3]); w.z = cvt_pk_bf16(o[4], o[5]); w.w = cvt_pk_bf16(o[6], o[7]);
                    *(u32x4*)(rowp + (pn < 4 ? 128 * pn : 1024 + 128 * (pn - 6))) = w;
                } else {
#pragma unroll
                    for (int bj = 0; bj < 2; ++bj) { const f32x4 v0 = acc[ai][bj][m][0] * rs, v1 = acc[ai][bj][m][1] * rs;
                        u32x4 w; w.x = cvt_pk_bf16(v0[0], v0[1]); w.y = cvt_pk_bf16(v0[2], v0[3]); w.z = cvt_pk_bf16(v1[0], v1[1]); w.w = cvt_pk_bf16(v1[2], v1[3]);
                        *(u32x4*)(rowp + 512 + 256 * (pn - 4) + bj * HALF) = w; }
                }
            }
    }
};

template <bool MOE> struct EpiSwiGLU {
    static constexpr bool PERM = true;
    bf16_t* ACT; int ldc; const float* RSx;
    __device__ __forceinline__ void operator()(acc_t& acc, const Unit& u, int wr, int wc, int fr, int fq, int tid) const {
#pragma unroll
        for (int ai = 0; ai < 2; ++ai)
#pragma unroll
            for (int m = 0; m < 4; ++m) {
                const int rl = ai * HALF + wr * 64 + m * 16 + fr;
                float rs; if (MOE) { const int mx = u.aux2 - 1; rs = RSx[u.pm + (rl < mx ? rl : mx)]; rs = rl < u.aux2 ? rs : 0.f; } else rs = rstd_from_rss(RSx, u.pm * BM + rl);
                const int orow = (MOE ? u.aux : u.pm) * BM + rl;
                bf16_t* AO = ACT;
                float o[8];
#pragma unroll
                for (int n = 0; n < 2; ++n)
#pragma unroll
                    for (int e = 0; e < 4; e += 2) { const f32x2 g = (f32x2){acc[ai][0][m][n][e], acc[ai][0][m][n][e + 1]} * rs, up = (f32x2){acc[ai][1][m][n][e], acc[ai][1][m][n][e + 1]} * rs;
                        const f32x2 r = silu_mul_pk(g, up); o[n * 4 + e] = r.x; o[n * 4 + e + 1] = r.y; }
                u32x4 w; w.x = cvt_pk_bf16(o[0], o[1]); w.y = cvt_pk_bf16(o[2], o[3]); w.z = cvt_pk_bf16(o[4], o[5]); w.w = cvt_pk_bf16(o[6], o[7]);
                __builtin_nontemporal_store(w, (u32x4*)(AO + (size_t)orow * ldc + 128 * u.pn + wc * 32 + 8 * fq));
            }
    }
};

template <bool BASE_F32> struct EpiResid {
    static constexpr bool PERM = true;
    const void* base; bf16_t* HB; float* RSS4; LAS float* T;
    __device__ __forceinline__ void operator()(acc_t& acc, const Unit& u, int wr, int wc, int fr, int fq, int tid) const {
        const int col0 = u.pn * BM + wc * 32 + 8 * fq;
#pragma unroll
        for (int ai = 0; ai < 2; ++ai)
#pragma unroll
            for (int m = 0; m < 4; ++m) {
                const int rl = ai * HALF + wr * 64 + m * 16 + fr; const size_t off = (size_t)(u.pm * BM + rl) * DM + col0; float ss = 0.f;
#pragma unroll
                for (int bj = 0; bj < 2; ++bj) {
                    f32x4 b0, b1;
                    if (BASE_F32) { b0 = *(const f32x4*)((const float*)base + off + bj * HALF); b1 = *(const f32x4*)((const float*)base + off + bj * HALF + 4); }
                    else { const u32x4 w = *(const u32x4*)((const bf16_t*)base + off + bj * HALF); b0 = (f32x4){bf_lo(w.x), bf_hi(w.x), bf_lo(w.y), bf_hi(w.y)}; b1 = (f32x4){bf_lo(w.z), bf_hi(w.z), bf_lo(w.w), bf_hi(w.w)}; }
                    const f32x4 v0 = b0 + acc[ai][bj][m][0], v1 = b1 + acc[ai][bj][m][1];
                    ss += ((v0[0] * v0[0] + v0[1] * v0[1]) + (v0[2] * v0[2] + v0[3] * v0[3])) + ((v1[0] * v1[0] + v1[1] * v1[1]) + (v1[2] * v1[2] + v1[3] * v1[3]));
                    u32x4 o; o.x = cvt_pk_bf16(v0[0], v0[1]); o.y = cvt_pk_bf16(v0[2], v0[3]); o.z = cvt_pk_bf16(v1[0], v1[1]); o.w = cvt_pk_bf16(v1[2], v1[3]);
                    *(u32x4*)(HB + off + bj * HALF) = o; }
                ss += __shfl_xor(ss, 16); ss += __shfl_xor(ss, 32);
                if (fq == 0) T[rl * 4 + wc] = ss;
            }
        EPI_BAR();
        if (tid < 256) { const f32x4 p = *(const LAS f32x4*)(T + tid * 4); RSS4[(size_t)(u.pm * BM + tid) * 4 + u.pn] = (p.x + p.y) + (p.z + p.w); }
    }
};

struct EpiSoftmax {
    static constexpr bool PERM = true;
    bf16_t* PB; const float* RSS4; LAS float* T;
    __device__ __forceinline__ void operator()(acc_t& acc, const Unit& u, int wr, int wc, int fr, int fq, int tid) const {
        LAS f32x2* T2 = (LAS f32x2*)T;
        float mw[2][4];
#pragma unroll
        for (int ai = 0; ai < 2; ++ai)
#pragma unroll
            for (int m = 0; m < 4; ++m) {
                const int rl = ai * HALF + wr * 64 + m * 16 + fr; const float rs = rstd_from_rss(RSS4, u.pm * BM + rl);
                float mx = -3.0e38f;
#pragma unroll
                for (int bj = 0; bj < 2; ++bj)
#pragma unroll
                    for (int n = 0; n < 2; ++n) { f32x4 v = acc[ai][bj][m][n] * rs; acc[ai][bj][m][n] = v; mx = fmaxf(fmaxf(mx, fmaxf(v[0], v[1])), fmaxf(v[2], v[3])); }
                mx = fmaxf(mx, __shfl_xor(mx, 16)); mx = fmaxf(mx, __shfl_xor(mx, 32));
                float l = 0.f;
#pragma unroll
                for (int bj = 0; bj < 2; ++bj)
#pragma unroll
                    for (int n = 0; n < 2; ++n) { f32x4 v = (acc[ai][bj][m][n] - mx) * 1.4426950408889634f; v[0] = __builtin_amdgcn_exp2f(v[0]); v[1] = __builtin_amdgcn_exp2f(v[1]); v[2] = __builtin_amdgcn_exp2f(v[2]); v[3] = __builtin_amdgcn_exp2f(v[3]); acc[ai][bj][m][n] = v; l += (v[0] + v[1]) + (v[2] + v[3]); }
                l += __shfl_xor(l, 16); l += __shfl_xor(l, 32);
                if (fq == 0) T2[rl * 4 + wc] = (f32x2){mx, l};
                mw[ai][m] = mx;
            }
        EPI_BAR();
#pragma unroll
        for (int ai = 0; ai < 2; ++ai)
#pragma unroll
            for (int m = 0; m < 4; ++m) {
                const int rl = ai * HALF + wr * 64 + m * 16 + fr;
                const f32x2 p0 = T2[rl * 4 + 0], p1 = T2[rl * 4 + 1], p2 = T2[rl * 4 + 2], p3 = T2[rl * 4 + 3];
                const float M = fmaxf(fmaxf(p0.x, p1.x), fmaxf(p2.x, p3.x));
                const float L = (p0.y * fast_exp(p0.x - M) + p1.y * fast_exp(p1.x - M)) + (p2.y * fast_exp(p2.x - M) + p3.y * fast_exp(p3.x - M));
                const float f = fast_exp(mw[ai][m] - M) / L;
                bf16_t* rowp = PB + (size_t)(u.pm * BM + rl) * DM + u.pn * BM + wc * 32 + 8 * fq;
#pragma unroll
                for (int bj = 0; bj < 2; ++bj) { const f32x4 v0 = acc[ai][bj][m][0] * f, v1 = acc[ai][bj][m][1] * f;
                    u32x4 w; w.x = cvt_pk_bf16(v0[0], v0[1]); w.y = cvt_pk_bf16(v0[2], v0[3]); w.z = cvt_pk_bf16(v1[0], v1[1]); w.w = cvt_pk_bf16(v1[2], v1[3]);
                    *(u32x4*)(rowp + bj * HALF) = w; }
            }
    }
};

struct EpiGeluUV {
    static constexpr bool PERM = true;
    bf16_t* UV; const float* RSS4; f32x2* VST; LAS float* T;
    __device__ __forceinline__ void operator()(acc_t& acc, const Unit& u, int wr, int wc, int fr, int fq, int tid) const {
        LAS f32x2* T2 = (LAS f32x2*)T;
#pragma unroll
        for (int ai = 0; ai < 2; ++ai)
#pragma unroll
            for (int m = 0; m < 4; ++m) {
                const int rl = ai * HALF + wr * 64 + m * 16 + fr; const float rs = rstd_from_rss(RSS4, u.pm * BM + rl);
                bf16_t* rowp = UV + (size_t)(u.pm * BM + rl) * 2048 + u.pn * BM + wc * 32 + 8 * fq; float s1 = 0.f, s2 = 0.f;
#pragma unroll
                for (int bj = 0; bj < 2; ++bj) { f32x4 v0 = acc[ai][bj][m][0] * rs, v1 = acc[ai][bj][m][1] * rs;
#pragma unroll
                    for (int e = 0; e < 4; e += 2) { const f32x2 a = gelu_tanh_pk((f32x2){v0[e], v0[e + 1]}), b = gelu_tanh_pk((f32x2){v1[e], v1[e + 1]}); v0[e] = a.x; v0[e + 1] = a.y; v1[e] = b.x; v1[e + 1] = b.y;
                        const f32x2 sm = a + b, sq = a * a + b * b; s1 += sm.x + sm.y; s2 += sq.x + sq.y; }
                    u32x4 w; w.x = cvt_pk_bf16(v0[0], v0[1]); w.y = cvt_pk_bf16(v0[2], v0[3]); w.z = cvt_pk_bf16(v1[0], v1[1]); w.w = cvt_pk_bf16(v1[2], v1[3]);
                    *(u32x4*)(rowp + bj * HALF) = w; }
                s1 += __shfl_xor(s1, 16); s1 += __shfl_xor(s1, 32); s2 += __shfl_xor(s2, 16); s2 += __shfl_xor(s2, 32);
                if (fq == 0) T2[rl * 4 + wc] = (f32x2){s1, s2};
            }
        EPI_BAR();
        if (u.pn >= 4 && tid < 256) { const f32x2 p0 = T2[tid * 4 + 0], p1 = T2[tid * 4 + 1], p2 = T2[tid * 4 + 2], p3 = T2[tid * 4 + 3];
            VST[(size_t)(u.pm * BM + tid) * 4 + (u.pn - 4)] = (f32x2){(p0.x + p1.x) + (p2.x + p3.x), (p0.y + p1.y) + (p2.y + p3.y)}; }
    }
};

__device__ __forceinline__ float clamp448(float x) { return fminf(fmaxf(x, -448.f), 448.f); }
__device__ __forceinline__ unsigned pk4_fp8(float a, float b, float c, float d) { unsigned w = 0u; w = __builtin_amdgcn_cvt_pk_fp8_f32(clamp448(a), clamp448(b), w, false); w = __builtin_amdgcn_cvt_pk_fp8_f32(clamp448(c), clamp448(d), w, true); return w; }
constexpr float W8_SCALE = 64.0f, W8_INV = 1.0f / 64.0f;

struct EpiSwiGLU8 {
    static constexpr bool PERM = true;
    unsigned char* ACT8;
    __device__ __forceinline__ void operator()(acc_t& acc, const Unit& u, int wr, int wc, int fr, int fq, int tid) const {
#pragma unroll
        for (int ai = 0; ai < 2; ++ai)
#pragma unroll
            for (int m = 0; m < 4; ++m) {
                const int rl = ai * HALF + wr * 64 + m * 16 + fr; float o[8];
#pragma unroll
                for (int n = 0; n < 2; ++n)
#pragma unroll
                    for (int e = 0; e < 4; e += 2) { const f32x2 g = (f32x2){acc[ai][0][m][n][e], acc[ai][0][m][n][e + 1]} * W8_INV, up = (f32x2){acc[ai][1][m][n][e], acc[ai][1][m][n][e + 1]} * W8_INV;
                        const f32x2 r = silu_mul_pk(g, up); o[n * 4 + e] = r.x; o[n * 4 + e + 1] = r.y; }
                u32x2 w; w.x = pk4_fp8(o[0], o[1], o[2], o[3]); w.y = pk4_fp8(o[4], o[5], o[6], o[7]);
                __builtin_nontemporal_store(w, (u32x2*)(ACT8 + (size_t)(u.aux * BM + rl) * DFF + 128 * u.pn + wc * 32 + 8 * fq));
            }
    }
};
struct EpiMoeDown8 {
    static constexpr bool PERM = true;
    bf16_t* Y; const float* SGW;
    __device__ __forceinline__ void operator()(acc_t& acc, const Unit& u, int wr, int wc, int fr, int fq, int tid) const {
        const int col0 = u.pn * BM + wc * 32 + 8 * fq;
#pragma unroll
        for (int ai = 0; ai < 2; ++ai)
#pragma unroll
            for (int m = 0; m < 4; ++m) {
                const int rl = ai * HALF + wr * 64 + m * 16 + fr, mx = u.aux2 - 1; const float gw = SGW[u.pm + (rl < mx ? rl : mx)] * W8_INV;
                bf16_t* rowp = Y + (size_t)(u.aux * BM + rl) * DM + col0;
#pragma unroll
                for (int bj = 0; bj < 2; ++bj) { const f32x4 v0 = acc[ai][bj][m][0] * gw, v1 = acc[ai][bj][m][1] * gw;
                    u32x4 o; o.x = cvt_pk_bf16(v0[0], v0[1]); o.y = cvt_pk_bf16(v0[2], v0[3]); o.z = cvt_pk_bf16(v1[0], v1[1]); o.w = cvt_pk_bf16(v1[2], v1[3]);
                    *(u32x4*)(rowp + bj * HALF) = o; }
            }
    }
};
#define XB_TMO      128
#define XB_XCNT(j)  (256  + 64 * (j))
#define XB_XSUB(j)  (1280 + 64 * (j))
#define XB_XGEN(j)  (2304 + 64 * (j))
#define XB_TOP      3328
#define XB_TOPGEN   3392
#define XCD_BAR_WORDS 3456
#define XB_SPIN_CAP (1u << 18)
__device__ __forceinline__ unsigned xb_ld(unsigned* p)              { return __hip_atomic_load(p, __ATOMIC_RELAXED, __HIP_MEMORY_SCOPE_AGENT); }
__device__ __forceinline__ unsigned xb_add(unsigned* p, unsigned v) { return __hip_atomic_fetch_add(p, v, __ATOMIC_RELAXED, __HIP_MEMORY_SCOPE_AGENT); }
__device__ __forceinline__ unsigned xb_xcc_id() { return (unsigned)__builtin_amdgcn_s_getreg((3 << 11) | 20) & 0xFu; }
#define XB_SPIN(cond, bar) do { unsigned _sp = 0; while (cond) { __builtin_amdgcn_s_sleep(1); \
    if ((++_sp & 255u) == 0u) { if (xb_ld(&(bar)[XB_TMO])) break; if (_sp > XB_SPIN_CAP) { atomicAdd(&(bar)[XB_TMO], 1u); break; } } } } while (0)
struct XcdBarrier { unsigned* bar; unsigned x; volatile LAS unsigned* st; };
__device__ __forceinline__ XcdBarrier xcd_barrier_post(unsigned* bar, volatile LAS unsigned* st) {
    XcdBarrier b; b.bar = bar; b.x = xb_xcc_id(); b.st = st;
    if (threadIdx.x == 0) (void)xb_add(&bar[XB_XCNT(b.x)], 1u);
    return b;
}
__device__ __forceinline__ void xcd_barrier_complete(unsigned* bar, unsigned x, unsigned& nloc, unsigned& nx) {
    const unsigned G = gridDim.x * gridDim.y * gridDim.z;
    unsigned sum, cnt, mine, sp = 0u;
    for (;;) {
        sum = 0u; cnt = 0u; mine = 0u;
#pragma unroll
        for (unsigned j = 0; j < 16; ++j) { const unsigned c = xb_ld(&bar[XB_XCNT(j)]); sum += c; cnt += (c > 0u) ? 1u : 0u; mine = (j == x) ? c : mine; }
        if (sum == G) break;
        __builtin_amdgcn_s_sleep(1);
        if ((++sp & 255u) == 0u) { if (xb_ld(&bar[XB_TMO])) break; if (sp > XB_SPIN_CAP) { atomicAdd(&bar[XB_TMO], 1u); break; } }
    }
    nloc = mine > 0u ? mine : 1u; nx = cnt > 0u ? cnt : 1u;
}
__device__ __forceinline__ void xcd_barrier(const XcdBarrier& b) {
    asm volatile("s_waitcnt vmcnt(0)" ::: "memory");
    __syncthreads();
    if (threadIdx.x == 0) {
        unsigned* bar = b.bar;
        __builtin_amdgcn_s_waitcnt(0);
        unsigned nloc = b.st[0], nx = b.st[1];
        if (nloc == 0u) { xcd_barrier_complete(bar, b.x, nloc, nx); b.st[0] = nloc; b.st[1] = nx; }
        const unsigned old = xb_add(&bar[XB_XSUB(b.x)], 1u);
        const unsigned gen = old / nloc;
        if (old + 1u == (gen + 1u) * nloc) {
            __builtin_amdgcn_fence(__ATOMIC_RELEASE, "agent");
            asm volatile("s_waitcnt vmcnt(0)" ::: "memory");
            const unsigned og = xb_add(&bar[XB_TOP], 1u);
            const unsigned tg = og / nx;
            if (og + 1u == (tg + 1u) * nx) xb_add(&bar[XB_TOPGEN], 1u);
            else XB_SPIN(xb_ld(&bar[XB_TOPGEN]) == tg, bar);
            __builtin_amdgcn_fence(__ATOMIC_ACQUIRE, "agent");
            xb_add(&bar[XB_XGEN(b.x)], 1u);
            asm volatile("s_waitcnt vmcnt(0)" ::: "memory");
        } else {
            XB_SPIN(xb_ld(&bar[XB_XGEN(b.x)]) == gen, bar);
            __builtin_amdgcn_fence(__ATOMIC_ACQUIRE, "agent");
            asm volatile("s_waitcnt vmcnt(0)" ::: "memory");
        }
    }
    __syncthreads();
}

struct Args { const float* in[31]; float* out; unsigned char* ws; int ph_lo, ph_hi; };
struct Frame { LAS unsigned char* lds; int tid, lane, wave, G, bx; float* H; unsigned char* ws; };
__device__ __forceinline__ const float* karg_in(int k) { typedef const float* __attribute__((address_space(4))) const* kp_t; return ((kp_t)__builtin_amdgcn_kernarg_segment_ptr())[k]; }

__device__ __forceinline__ void transpose_item(const float* W, int ldw, int k0, int n0, bf16_t* WT, int K, int dst_row0, const float* gk, LAS float* scr, int lane) {
    float tv[64];
#pragma unroll
    for (int i = 0; i < 64; ++i) tv[i] = W[(size_t)(k0 + i) * ldw + n0 + lane];
#pragma unroll
    for (int i = 0; i < 64; ++i) { const float g = gk ? gk[k0 + i] : 1.0f; scr[i * 64 + (lane ^ (((i >> 3) & 7) << 3))] = tv[i] * g; }
    LDS_WAIT(); asm volatile("" ::: "memory");
    const int c = lane & 7;
#pragma unroll
    for (int j = 0; j < 8; ++j) { const int n = (lane >> 3) + 8 * j; const LAS float* s = scr + (8 * c) * 64 + (n ^ (c << 3));
        u32x4 o; o.x = cvt_pk_bf16(s[0 * 64], s[1 * 64]); o.y = cvt_pk_bf16(s[2 * 64], s[3 * 64]); o.z = cvt_pk_bf16(s[4 * 64], s[5 * 64]); o.w = cvt_pk_bf16(s[6 * 64], s[7 * 64]);
        *(u32x4*)(WT + (size_t)(dst_row0 + n) * K + k0 + 8 * c) = o; }
    LDS_WAIT(); asm volatile("" ::: "memory");
}
__device__ __forceinline__ void transpose_item_fp8(const float* W, int ldw, int k0, int n0, unsigned char* WT8, int K, int dst_row0, const float* gk, float scale, LAS float* scr, int lane) {
    float tv[64];
#pragma unroll
    for (int i = 0; i < 64; ++i) tv[i] = W[(size_t)(k0 + i) * ldw + n0 + lane];
#pragma unroll
    for (int i = 0; i < 64; ++i) { const float g = (gk ? gk[k0 + i] : 1.0f) * scale; scr[i * 64 + (lane ^ (((i >> 3) & 7) << 3))] = tv[i] * g; }
    LDS_WAIT(); asm volatile("" ::: "memory");
    const int c = lane & 3;
#pragma unroll
    for (int j = 0; j < 4; ++j) { const int n = (lane >> 2) + 16 * j; float v[16];
#pragma unroll
        for (int e = 0; e < 16; ++e) v[e] = scr[(16 * c + e) * 64 + (n ^ (((2 * c + (e >> 3)) & 7) << 3))];
        u32x4 o; o.x = pk4_fp8(v[0], v[1], v[2], v[3]); o.y = pk4_fp8(v[4], v[5], v[6], v[7]); o.z = pk4_fp8(v[8], v[9], v[10], v[11]); o.w = pk4_fp8(v[12], v[13], v[14], v[15]);
        *(u32x4*)(WT8 + (size_t)(dst_row0 + n) * K + k0 + 16 * c) = o; }
    LDS_WAIT(); asm volatile("" ::: "memory");
}
__device__ __forceinline__ int glu5_map(int n0) {
    if (n0 < 512) return 256 * (n0 >> 7) + (n0 & 127);
    if (n0 < 1024) { const int c = n0 - 512; return 256 * (c >> 7) + 128 + (c & 127); }
    if (n0 < 1536) return n0;
    if (n0 < 2048) { const int c = n0 - 1536; return 1536 + 256 * (c >> 7) + (c & 127); }
    const int c = n0 - 2048; return 1536 + 256 * (c >> 7) + 128 + (c & 127);
}
__device__ __forceinline__ int gu_map(int n0, int up) { return 256 * (n0 >> 7) + 128 * up + (n0 & 127); }

template <int MAP  >
__device__ __forceinline__ void conv_matrix(const float* W, int ldw, int nkb, int nnb, bf16_t* WT, int K, int up, const float* gk, int item0, int gw, int NGW, LAS float* scr, int lane) {
    const int n = nkb * nnb; int first = (gw - item0) % NGW; if (first < 0) first += NGW;
    for (int r = first; r < n; r += NGW) { const int kb = r / nnb, nb = r % nnb;
        const int dst = MAP == 0 ? 64 * nb : (MAP == 1 ? glu5_map(64 * nb) : gu_map(64 * nb, up));
        transpose_item(W, ldw, 64 * kb, 64 * nb, WT, K, dst, gk, scr, lane); }
}
template <int MAP>
__device__ __forceinline__ void conv_matrix8(const float* W, int ldw, int nkb, int nnb, unsigned char* WT8, int K, int up, const float* gk, float scale, int item0, int gw, int NGW, LAS float* scr, int lane) {
    const int n = nkb * nnb; int first = (gw - item0) % NGW; if (first < 0) first += NGW;
    for (int r = first; r < n; r += NGW) { const int kb = r / nnb, nb = r % nnb;
        const int dst = MAP == 0 ? 64 * nb : gu_map(64 * nb, up);
        transpose_item_fp8(W, ldw, 64 * kb, 64 * nb, WT8, K, dst, gk, scale, scr, lane); }
}
#ifdef FK_TPROBE
#define P0_TP_BEGIN(k) do { if ((k) == FK_TPROBE && blockIdx.x == 0 && threadIdx.x == 0) *(volatile unsigned long long*)(F.ws + 32768) = __builtin_amdgcn_s_memrealtime(); } while (0)
#define P0_TP_END(k) do { if ((k) == FK_TPROBE && blockIdx.x == 0 && threadIdx.x == 0) *(volatile unsigned long long*)(F.ws + 32776) = __builtin_amdgcn_s_memrealtime() - *(volatile unsigned long long*)(F.ws + 32768); } while (0)
#else
#define P0_TP_BEGIN(k) do { } while (0)
#define P0_TP_END(k) do { } while (0)
#endif
__device__ __forceinline__ void p0_prologue(Frame& F) {
    LAS float* scr = (LAS float*)(F.lds + RING_OFF + F.wave * 16384);
    const int gw = F.bx * 8 + F.wave, NGW = F.G * 8, lane = F.lane;
    unsigned char* ws = F.ws;
    constexpr int I_SQ = 256, I_WIN = 16 * 40, I_GU = 16 * 44, I_DN = 44 * 16, I_SG = 16 * 32;
    int o = 0;
    conv_matrix<1>(karg_in(11), 2560, 16, 40, (bf16_t*)(ws + WS_WIN0), 1024, 0, karg_in(2), o, gw, NGW, scr, lane); o += I_WIN;
    conv_matrix<0>(karg_in(17), 1024, 16, 16, (bf16_t*)(ws + WS_WOUT0), 1024, 0, nullptr, o, gw, NGW, scr, lane); o += I_SQ;
    conv_matrix<2>(karg_in(18), 2816, 16, 44, (bf16_t*)(ws + WS_WGU0), 1024, 0, karg_in(5), o, gw, NGW, scr, lane); o += I_GU;
    conv_matrix<2>(karg_in(19), 2816, 16, 44, (bf16_t*)(ws + WS_WGU0), 1024, 1, karg_in(5), o, gw, NGW, scr, lane); o += I_GU;
    conv_matrix<0>(karg_in(20), 1024, 44, 16, (bf16_t*)(ws + WS_WD0), 2816, 0, nullptr, o, gw, NGW, scr, lane); o += I_DN;
    for (int l = 0; l < 2; ++l) {
        conv_matrix<0>(karg_in(10) + (size_t)l * DM * DM, 1024, 16, 16, (bf16_t*)(ws + WS_WOT) + (size_t)l * DM * DM, 1024, 0, nullptr, o, gw, NGW, scr, lane); o += I_SQ;
        conv_matrix<0>(karg_in(8) + (size_t)l * DM * DM, 1024, 16, 16, (bf16_t*)(ws + WS_WKT) + (size_t)l * DM * DM, 1024, 0, nullptr, o, gw, NGW, scr, lane); o += I_SQ;
        conv_matrix<0>(karg_in(9) + (size_t)l * DM * DM, 1024, 16, 16, (bf16_t*)(ws + WS_WKT) + (size_t)(2 + l) * DM * DM, 1024, 0, nullptr, o, gw, NGW, scr, lane); o += I_SQ;
    }
    conv_matrix<0>(karg_in(21), 2048, 16, 32, (bf16_t*)(ws + WS_WSG), 1024, 0, karg_in(2) + DM, o, gw, NGW, scr, lane); o += I_SG;
    conv_matrix<0>(karg_in(26), 1024, 16, 16, (bf16_t*)(ws + WS_WSO), 1024, 0, nullptr, o, gw, NGW, scr, lane); o += I_SQ;
    for (int e = 0; e < NEXP; ++e) {
        conv_matrix8<2>(karg_in(28) + (size_t)e * DM * DFF, 2816, 16, 44, (unsigned char*)(ws + WS_WGU1) + (size_t)e * 5632 * DM, 1024, 0, karg_in(5) + DM, W8_SCALE, o, gw, NGW, scr, lane); o += I_GU;
        conv_matrix8<2>(karg_in(29) + (size_t)e * DM * DFF, 2816, 16, 44, (unsigned char*)(ws + WS_WGU1) + (size_t)e * 5632 * DM, 1024, 1, karg_in(5) + DM, W8_SCALE, o, gw, NGW, scr, lane); o += I_GU;
        conv_matrix8<0>(karg_in(30) + (size_t)e * DFF * DM, 1024, 44, 16, (unsigned char*)(ws + WS_WD1) + (size_t)e * DM * DFF, 2816, 0, nullptr, W8_SCALE, o, gw, NGW, scr, lane); o += I_DN;
    }
    for (int r = gw; r < 2 * DM; r += NGW) { const int l = r >> 10, k = r & 1023; const float g = karg_in(3)[l * DM + k] * 0.0625f;
        const f32x4* src = (const f32x4*)(karg_in(7) + (size_t)r * DM) + lane; u32x2* dst = (u32x2*)((bf16_t*)(ws + WS_WQS) + (size_t)r * DM) + lane;
#pragma unroll
        for (int j = 0; j < 4; ++j) { const f32x4 v = src[64 * j] * g; u32x2 w; w.x = cvt_pk_bf16(v[0], v[1]); w.y = cvt_pk_bf16(v[2], v[3]); dst[64 * j] = w; } }
    for (int r = gw; r < 2 * 4 * MEML; r += NGW) { const int l = r >> 10, mr = r & 1023;
        const f32x4* src = (const f32x4*)(karg_in(1) + (size_t)mr * DM) + lane; const f32x4* gg = (const f32x4*)(karg_in(4) + l * DM) + lane;
        u32x2* dst = (u32x2*)((bf16_t*)(ws + WS_MEMN) + (size_t)r * DM) + lane; f32x4 v[4]; float s = 0.f;
#pragma unroll
        for (int j = 0; j < 4; ++j) { v[j] = src[64 * j]; s += (v[j][0] * v[j][0] + v[j][1] * v[j][1]) + (v[j][2] * v[j][2] + v[j][3] * v[j][3]); }
        const float rs = rsqrtf(wave_sum(s) * (1.0f / DM) + 1e-6f);
#pragma unroll
        for (int j = 0; j < 4; ++j) { const f32x4 o = v[j] * rs * gg[64 * j]; u32x2 w; w.x = cvt_pk_bf16(o[0], o[1]); w.y = cvt_pk_bf16(o[2], o[3]); dst[64 * j] = w; } }
    for (int r = gw; r < NTOK; r += NGW) {
        const f32x4* src = (const f32x4*)(karg_in(0) + (size_t)r * DM) + lane; u32x2* dst = (u32x2*)((bf16_t*)(ws + WS_HB) + (size_t)r * DM) + lane; f32x4 v[4]; float s = 0.f;
#pragma unroll
        for (int j = 0; j < 4; ++j) { v[j] = src[64 * j]; s += (v[j][0] * v[j][0] + v[j][1] * v[j][1]) + (v[j][2] * v[j][2] + v[j][3] * v[j][3]); }
        s = wave_sum(s);
#pragma unroll
        for (int j = 0; j < 4; ++j) { u32x2 w; w.x = cvt_pk_bf16(v[j][0], v[j][1]); w.y = cvt_pk_bf16(v[j][2], v[j][3]); dst[64 * j] = w; }
        if (lane == 0) *(f32x4*)((float*)(ws + WS_RSS) + (size_t)r * 4) = (f32x4){s, 0.f, 0.f, 0.f}; }
}

struct KvOrder {
    const char* memn; const char* wkt; int G, c;
    __device__ __forceinline__ bool next(int i, Unit& u) const { const int L = i * G + c; if (L >= 64) return false;
        const int which = L >> 4, t = L & 15, l = which & 1; u.pm = t >> 2; u.pn = t & 3; u.aux = which;
        u.A = memn + ((size_t)l * DM * DM + (size_t)u.pm * BM * DM) * 2; u.B = wkt + ((size_t)which * DM * DM + (size_t)u.pn * BM * DM) * 2; return true; }
};
struct MkVwOrder {
    const char* kp; const char* wqs; const char* wot; int G, c;
    __device__ __forceinline__ bool next(int i, Unit& u) const { const int L = i * G + c; if (L >= 256) return false;
        const int vw = L >> 7, q = L & 127, l = q >> 6, b = (q >> 4) & 3, hd = (q >> 2) & 3, t = q & 3;
        if (!vw) { u.pm = hd; u.pn = t; u.aux = l * 4 + b;
            u.A = kp + ((size_t)l * DM * DM + (size_t)(b * MEML) * DM + hd * 256) * 2; u.B = wqs + ((size_t)l * DM * DM + (size_t)(t * BM) * DM + hd * 256) * 2; }
        else { u.pm = t; u.pn = hd; u.aux = 8 + l * 4 + b;
            u.A = wot + ((size_t)l * DM * DM + (size_t)(t * BM) * DM + hd * 256) * 2; u.B = kp + ((size_t)(2 + l) * DM * DM + (size_t)(b * MEML) * DM + hd * 256) * 2; }
        return true; }
};

__device__ __forceinline__ void conv_phase(Frame& F) {
    const int tid = F.tid, half = tid >> 8, t2 = tid & 255, c0 = 2 * t2, wih = (tid >> 6) & 3, lane = F.lane;
    const bf16_t* ZB = (const bf16_t*)(F.ws + WS_ZB); bf16_t* MIX = (bf16_t*)(F.ws + WS_MIX);
    LAS float* RED = (LAS float*)(F.lds + RING_OFF);
    f32x2 wa[31], wb[3];
#pragma unroll
    for (int k = 0; k < 31; ++k) wa[k] = *(const f32x2*)(karg_in(12) + k * 512 + c0);
#pragma unroll
    for (int k = 0; k < 3; ++k) wb[k] = *(const f32x2*)(karg_in(16) + k * 512 + c0);
    const f32x2 bias = *(const f32x2*)(karg_in(13) + c0), lg = *(const f32x2*)(karg_in(14) + c0), lb = *(const f32x2*)(karg_in(15) + c0);
    unsigned xin[38], gb[8], gh[10];
#define CONV_LOAD(it_) do { const int blk_ = (F.bx * 8 + (it_)) * 2 + half, tk_ = blk_ * 8, tp_ = tk_ & (SEQL - 1); \
        _Pragma("unroll") for (int j = 0; j < 38; ++j) { const int pos = tp_ - 30 + j; xin[j] = (pos >= 0) ? *(const unsigned*)(ZB + (size_t)(tk_ - 30 + j) * ZW + c0) : 0u; } \
        _Pragma("unroll") for (int j = 0; j < 8; ++j) gb[j] = *(const unsigned*)(ZB + (size_t)(tk_ + j) * ZW + 512 + c0); \
        _Pragma("unroll") for (int j = 0; j < 10; ++j) { const int pos = tp_ - 2 + j; gh[j] = (pos >= 0) ? *(const unsigned*)(ZB + (size_t)(tk_ - 2 + j) * ZW + 1024 + c0) : 0u; } } while (0)
    CONV_LOAD(0);
    for (int it = 0; it < 8; ++it) {
        const int blk = (F.bx * 8 + it) * 2 + half, tok0 = blk * 8;
        f32x2 a[8], bo[8];
#pragma unroll
        for (int o = 0; o < 8; ++o) a[o] = bias;
#pragma unroll
        for (int j = 0; j < 38; ++j) { const f32x2 x = (f32x2){bf_lo(xin[j]), bf_hi(xin[j])};
#pragma unroll
            for (int o = 0; o < 8; ++o) { const int k = j - o; if (k >= 0 && k < 31) a[o] = __builtin_elementwise_fma(wa[k], x, a[o]); } }
#pragma unroll
        for (int o = 0; o < 8; ++o) { f32x2 b = (f32x2){0.f, 0.f};
#pragma unroll
            for (int k = 0; k < 3; ++k) b = __builtin_elementwise_fma(wb[k], (f32x2){bf_lo(gh[o + k]), bf_hi(gh[o + k])}, b);
            bo[o] = b * (f32x2){bf_lo(gb[o]), bf_hi(gb[o])}; }
        if (it < 7) CONV_LOAD(it + 1);
        {
          float v16[16];
#pragma unroll
          for (int o = 0; o < 8; ++o) { const f32x2 sq = a[o] * a[o]; v16[2 * o] = a[o].x + a[o].y; v16[2 * o + 1] = sq.x + sq.y; }
          float v8[8], v4[4], v2[2], v1;
#pragma unroll
          for (int i = 0; i < 8; ++i) { const float keep = (lane & 32) ? v16[i + 8] : v16[i], send = (lane & 32) ? v16[i] : v16[i + 8]; v8[i] = keep + __shfl_xor(send, 32); }
#pragma unroll
          for (int i = 0; i < 4; ++i) { const float keep = (lane & 16) ? v8[i + 4] : v8[i], send = (lane & 16) ? v8[i] : v8[i + 4]; v4[i] = keep + __shfl_xor(send, 16); }
#pragma unroll
          for (int i = 0; i < 2; ++i) { const float keep = (lane & 8) ? v4[i + 2] : v4[i], send = (lane & 8) ? v4[i] : v4[i + 2]; v2[i] = keep + __shfl_xor(send, 8); }
          { const float keep = (lane & 4) ? v2[1] : v2[0], send = (lane & 4) ? v2[0] : v2[1]; v1 = keep + __shfl_xor(send, 4); }
          v1 += __shfl_xor(v1, 2); v1 += __shfl_xor(v1, 1);
          if ((lane & 3) == 0) RED[(half * 4 + wih) * 16 + ((lane >> 2) & 15)] = v1; }
        LDS_WAIT(); __syncthreads();
#pragma unroll
        for (int o = 0; o < 8; ++o) { float s1 = 0.f, s2 = 0.f;
#pragma unroll
            for (int w = 0; w < 4; ++w) { s1 += RED[((half * 4 + w) * 8 + o) * 2 + 0]; s2 += RED[((half * 4 + w) * 8 + o) * 2 + 1]; }
            const float mu = s1 * (1.0f / 512.f), var = s2 * (1.0f / 512.f) - mu * mu, rstd = rsqrtf(fmaxf(var, 0.f) + 1e-5f);
            const f32x2 y = (a[o] - mu) * rstd * lg + lb;
            *(unsigned*)(MIX + (size_t)(tok0 + o) * DM + c0) = cvt_pk_bf16(y.x * fast_sigmoid(y.x), y.y * fast_sigmoid(y.y));
            *(unsigned*)(MIX + (size_t)(tok0 + o) * DM + 512 + c0) = cvt_pk_bf16(bo[o].x, bo[o].y); }
        LDS_WAIT(); __syncthreads();
    }
#undef CONV_LOAD
}

__device__ __forceinline__ void spatial_phase(Frame& F) {
    const int tid = F.tid, lane = F.lane, wv = F.wave, fr = lane & 15, fq = lane >> 4, g = F.bx & 7;
    constexpr int RS = 272;
    LAS unsigned char* WL = F.lds + RING_OFF;
    LAS unsigned char* VT = F.lds + RING_OFF + 128 * RS;
    const bf16_t* UV = (const bf16_t*)(F.ws + WS_UV); bf16_t* US = (bf16_t*)(F.ws + WS_US); const f32x4* VST = (const f32x4*)(F.ws + WS_VST);
    { const int i = tid >> 2, jq = (tid & 3) * 32; const float* src = karg_in(24) + ((size_t)g * 128 + i) * 128 + jq;
#pragma unroll
        for (int q = 0; q < 4; ++q) { const f32x4 a = *(const f32x4*)(src + 8 * q), b = *(const f32x4*)(src + 8 * q + 4); const bool ok = ((jq + 8 * q) >> 6) <= (i >> 6);
            u32x4 w; w.x = cvt_pk_bf16(a[0], a[1]); w.y = cvt_pk_bf16(a[2], a[3]); w.z = cvt_pk_bf16(b[0], b[1]); w.w = cvt_pk_bf16(b[2], b[3]);
            if (!ok) w = (u32x4){0u, 0u, 0u, 0u}; *(LAS u32x4*)(WL + i * RS + (jq + 8 * q) * 2) = w; } }
    const int j = tid >> 2, cq = (tid & 3) * 8;
    f32x4 lgv[8], lbv[8];
#pragma unroll
    for (int q = 0; q < 8; ++q) { lgv[q] = *(const f32x4*)(karg_in(22) + g * 128 + cq + 32 * (q >> 1) + 4 * (q & 1)); lbv[q] = *(const f32x4*)(karg_in(23) + g * 128 + cq + 32 * (q >> 1) + 4 * (q & 1)); }
    u32x4 vw[4]; f32x4 st0, st1;
#define SP_LOADV(r_) do { const size_t tk_ = (size_t)((F.bx >> 3) + 32 * (r_)) * 128 + j; st0 = VST[tk_ * 2]; st1 = VST[tk_ * 2 + 1]; const bf16_t* vr_ = UV + tk_ * 2048 + 1024 + g * 128 + cq; \
        _Pragma("unroll") for (int q = 0; q < 4; ++q) vw[q] = *(const u32x4*)(vr_ + 32 * q); } while (0)
#define SP_NORM(vb) do { LAS unsigned char* VTw = VT + (vb) * (128 * RS); \
        const float s1 = (st0[0] + st0[2]) + (st1[0] + st1[2]), s2 = (st0[1] + st0[3]) + (st1[1] + st1[3]); \
        const float mu = s1 * (1.0f / 1024.f), var = s2 * (1.0f / 1024.f) - mu * mu, rstd = rsqrtf(fmaxf(var, 0.f) + 1e-5f); \
        _Pragma("unroll") for (int q = 0; q < 4; ++q) { const u32x4 w = vw[q]; \
            const float v[8] = {bf_lo(w.x), bf_hi(w.x), bf_lo(w.y), bf_hi(w.y), bf_lo(w.z), bf_hi(w.z), bf_lo(w.w), bf_hi(w.w)}; \
            const float gg[8] = {lgv[2 * q][0], lgv[2 * q][1], lgv[2 * q][2], lgv[2 * q][3], lgv[2 * q + 1][0], lgv[2 * q + 1][1], lgv[2 * q + 1][2], lgv[2 * q + 1][3]}; \
            const float bbv[8] = {lbv[2 * q][0], lbv[2 * q][1], lbv[2 * q][2], lbv[2 * q][3], lbv[2 * q + 1][0], lbv[2 * q + 1][1], lbv[2 * q + 1][2], lbv[2 * q + 1][3]}; \
            _Pragma("unroll") for (int e = 0; e < 8; e += 2) { const unsigned pk = cvt_pk_bf16((v[e] - mu) * rstd * gg[e] + bbv[e], (v[e + 1] - mu) * rstd * gg[e + 1] + bbv[e + 1]); \
                *(LAS unsigned short*)(VTw + (cq + 32 * q + e) * RS + j * 2) = (unsigned short)(pk & 0xffffu); \
                *(LAS unsigned short*)(VTw + (cq + 32 * q + e + 1) * RS + j * 2) = (unsigned short)(pk >> 16); } } } while (0)
    SP_LOADV(0); SP_NORM(0);
    LDS_WAIT(); __syncthreads();
    for (int r = 0; r < 8; ++r) {
        const int nb = (F.bx >> 3) + 32 * r; const LAS unsigned char* VTr = VT + (r & 1) * (128 * RS);
        u32x4 uu[4];
#pragma unroll
        for (int b = 0; b < 4; ++b) { const size_t tok = (size_t)nb * 128 + (4 * (wv >> 2) + b) * 16 + fr; uu[b] = *(const u32x4*)(UV + tok * 2048 + g * 128 + 32 * (wv & 3) + 8 * fq); }
        if (r < 7) SP_LOADV(r + 1);
        f32x4 acc[2][4];
#pragma unroll
        for (int a = 0; a < 2; ++a)
#pragma unroll
            for (int b = 0; b < 4; ++b) acc[a][b] = (f32x4){0.f, 0.f, 0.f, 0.f};
#pragma unroll
        for (int ks = 0; ks < 4; ++ks) {
            bf16x8 xf[2], yf[4];
#pragma unroll
            for (int a = 0; a < 2; ++a) xf[a] = *(const LAS bf16x8*)(VTr + (32 * (wv & 3) + 8 * (fr >> 2) + 4 * a + (fr & 3)) * RS + (ks * 32 + fq * 8) * 2);
#pragma unroll
            for (int b = 0; b < 4; ++b) yf[b] = *(const LAS bf16x8*)(WL + ((4 * (wv >> 2) + b) * 16 + fr) * RS + (ks * 32 + fq * 8) * 2);
#pragma unroll
            for (int a = 0; a < 2; ++a)
#pragma unroll
                for (int b = 0; b < 4; ++b) acc[a][b] = __builtin_amdgcn_mfma_f32_16x16x32_bf16(xf[a], yf[b], acc[a][b], 0, 0, 0);
        }
        if (r < 7) SP_NORM((r + 1) & 1);
#pragma unroll
        for (int b = 0; b < 4; ++b) { const int i = (4 * (wv >> 2) + b) * 16 + fr; const size_t tok = (size_t)nb * 128 + i; const float bs = karg_in(25)[g * 128 + i]; const u32x4 u4 = uu[b];
            u32x4 o; o.x = cvt_pk_bf16(bf_lo(u4.x) * (acc[0][b][0] + bs), bf_hi(u4.x) * (acc[0][b][1] + bs)); o.y = cvt_pk_bf16(bf_lo(u4.y) * (acc[0][b][2] + bs), bf_hi(u4.y) * (acc[0][b][3] + bs));
            o.z = cvt_pk_bf16(bf_lo(u4.z) * (acc[1][b][0] + bs), bf_hi(u4.z) * (acc[1][b][1] + bs)); o.w = cvt_pk_bf16(bf_lo(u4.w) * (acc[1][b][2] + bs), bf_hi(u4.w) * (acc[1][b][3] + bs));
            *(u32x4*)(US + tok * DM + g * 128 + 32 * (wv & 3) + 8 * fq) = o; }
        LDS_WAIT(); __syncthreads();
    }
#undef SP_NORM
#undef SP_LOADV
}

__device__ __forceinline__ void router_phase(Frame& F) {
    const int lane = F.lane, wv = F.wave, tid = F.tid;
    LAS int* CL = (LAS int*)(F.lds + RSCR_OFF); LAS int* BASE = CL + 16; LAS unsigned* TE = (LAS unsigned*)(CL + 32);
    LAS int* TR1 = (LAS int*)(TE + 128); LAS int* TR2 = TR1 + 128; LAS float* TW1 = (LAS float*)(TR2 + 128); LAS float* TW2 = TW1 + 128; LAS float* TRS = TW2 + 128;
    if (tid < 16) CL[tid] = 0;
    float wr[16][8];
#pragma unroll
    for (int j = 0; j < 2; ++j)
#pragma unroll
        for (int e8 = 0; e8 < 8; ++e8) { const int k = 8 * lane + 512 * j + e8; const float g = karg_in(5)[DM + k]; const f32x4 a = *(const f32x4*)(karg_in(27) + k * 8), b = *(const f32x4*)(karg_in(27) + k * 8 + 4);
            wr[j * 8 + e8][0] = a[0] * g; wr[j * 8 + e8][1] = a[1] * g; wr[j * 8 + e8][2] = a[2] * g; wr[j * 8 + e8][3] = a[3] * g; wr[j * 8 + e8][4] = b[0] * g; wr[j * 8 + e8][5] = b[1] * g; wr[j * 8 + e8][6] = b[2] * g; wr[j * 8 + e8][7] = b[3] * g; }
    __syncthreads();
    const bf16_t* HBr = (const bf16_t*)(F.ws + WS_HB);
    u32x4 hw[2]; { const u32x4* hr = (const u32x4*)(HBr + (size_t)(F.bx * 128 + wv * 16) * DM) + lane; hw[0] = hr[0]; hw[1] = hr[64]; }
#pragma unroll 2
    for (int q = 0; q < 16; ++q) {
        const int il = wv * 16 + q, t = F.bx * 128 + il;
        const u32x4 w0 = hw[0], w1v = hw[1];
        if (q < 15) { const u32x4* hr = (const u32x4*)(HBr + (size_t)(t + 1) * DM) + lane; hw[0] = hr[0]; hw[1] = hr[64]; }
        float lg[8];
#pragma unroll
        for (int e = 0; e < 8; ++e) lg[e] = 0.f;
#pragma unroll
        for (int j = 0; j < 2; ++j) { const u32x4 w = j ? w1v : w0; const float x[8] = {bf_lo(w.x), bf_hi(w.x), bf_lo(w.y), bf_hi(w.y), bf_lo(w.z), bf_hi(w.z), bf_lo(w.w), bf_hi(w.w)};
#pragma unroll
            for (int e8 = 0; e8 < 8; ++e8)
#pragma unroll
                for (int e = 0; e < 8; ++e) lg[e] += x[e8] * wr[j * 8 + e8][e]; }
        const float rs = rstd_from_rss((const float*)(F.ws + WS_RSS), t);
        { u32x2 q0, q1;
          q0.x = pk4_fp8(bf_lo(w0.x) * rs, bf_hi(w0.x) * rs, bf_lo(w0.y) * rs, bf_hi(w0.y) * rs); q0.y = pk4_fp8(bf_lo(w0.z) * rs, bf_hi(w0.z) * rs, bf_lo(w0.w) * rs, bf_hi(w0.w) * rs);
          q1.x = pk4_fp8(bf_lo(w1v.x) * rs, bf_hi(w1v.x) * rs, bf_lo(w1v.y) * rs, bf_hi(w1v.y) * rs); q1.y = pk4_fp8(bf_lo(w1v.z) * rs, bf_hi(w1v.z) * rs, bf_lo(w1v.w) * rs, bf_hi(w1v.w) * rs);
          u32x2* h8 = (u32x2*)(F.ws + WS_HB8 + (size_t)t * DM) + lane; h8[0] = q0; h8[64] = q1; }
        { float k4[4], k2[2], k1;
#pragma unroll
          for (int i = 0; i < 4; ++i) { const float keep = (lane & 32) ? lg[i + 4] : lg[i], send = (lane & 32) ? lg[i] : lg[i + 4]; k4[i] = keep + __shfl_xor(send, 32); }
#pragma unroll
          for (int i = 0; i < 2; ++i) { const float keep = (lane & 16) ? k4[i + 2] : k4[i], send = (lane & 16) ? k4[i] : k4[i + 2]; k2[i] = keep + __shfl_xor(send, 16); }
          { const float keep = (lane & 8) ? k2[1] : k2[0], send = (lane & 8) ? k2[0] : k2[1]; k1 = keep + __shfl_xor(send, 8); }
          k1 += __shfl_xor(k1, 4); k1 += __shfl_xor(k1, 2); k1 += __shfl_xor(k1, 1);
#pragma unroll
          for (int e = 0; e < 8; ++e) lg[e] = __int_as_float(__builtin_amdgcn_readlane(__float_as_int(k1), 8 * e)) * rs; }
        int i1 = 0; float v1 = lg[0];
#pragma unroll
        for (int e = 1; e < 8; ++e) if (lg[e] > v1) { v1 = lg[e]; i1 = e; }
        int i2 = 0; float v2 = -3.0e38f;
#pragma unroll
        for (int e = 0; e < 8; ++e) if (e != i1 && lg[e] > v2) { v2 = lg[e]; i2 = e; }
        const float e2 = __expf(v2 - v1), w1 = 1.0f / (1.0f + e2), w2 = e2 / (1.0f + e2);
        if (lane == 0) { TE[il] = (unsigned)i1 | ((unsigned)i2 << 8); TW1[il] = w1; TW2[il] = w2;
            TR1[il] = __hip_atomic_fetch_add(&CL[i1], 1, __ATOMIC_RELAXED, __HIP_MEMORY_SCOPE_WORKGROUP); TR2[il] = __hip_atomic_fetch_add(&CL[8 + i2], 1, __ATOMIC_RELAXED, __HIP_MEMORY_SCOPE_WORKGROUP); }
    }
    LDS_WAIT(); __syncthreads();
    if (tid < 16) BASE[tid] = (int)__hip_atomic_fetch_add((unsigned*)(F.ws + WS_CTL) + CW_SEG + 16 * tid, (unsigned)CL[tid], __ATOMIC_RELAXED, __HIP_MEMORY_SCOPE_AGENT);
    LDS_WAIT(); __syncthreads();
    if (tid < 128) { const unsigned te = TE[tid]; const int e1 = (int)(te & 0xffu), e2 = (int)(te >> 8), t = F.bx * 128 + tid;
        const int s1 = e1 * SEGCAP + BASE[e1] + TR1[tid], s2 = (8 + e2) * SEGCAP + BASE[8 + e2] + TR2[tid];
        int* STOK = (int*)(F.ws + WS_STOK); float* SGW = (float*)(F.ws + WS_SGW);
        STOK[s1] = t; SGW[s1] = TW1[tid]; STOK[s2] = t; SGW[s2] = TW2[tid]; ((int*)(F.ws + WS_TSL))[2 * t] = s1; ((int*)(F.ws + WS_TSL))[2 * t + 1] = s2; }
}
__device__ __forceinline__ void moe_tables(Frame& F) {
    LAS int* MT = (LAS int*)(F.lds + MT_OFF); LAS int* CN = MT + 32;
    if (F.tid < 16) CN[F.tid] = (int)__hip_atomic_load((unsigned*)(F.ws + WS_CTL) + CW_SEG + 16 * F.tid, __ATOMIC_RELAXED, __HIP_MEMORY_SCOPE_AGENT);
    LDS_WAIT(); __syncthreads();
    if (F.tid == 0) { int a = 0; for (int s = 0; s < 16; ++s) { MT[s] = a; a += (CN[s] + 255) >> 8; } MT[16] = a; }
    LDS_WAIT(); __syncthreads();
}
#ifndef FK_MOE_WGM
#define FK_MOE_WGM 8
#endif
struct MoeOrder {
    const char* A; const char* W; size_t wstride; int lda_b, ldb_b, nN, G, c; const LAS int* MT; int gather_a; const int* stok; int rev;
    __device__ __forceinline__ bool next(int i, Unit& u) const {
        const int nM = MT[16]; int pm, pn; if (!tile_order(i, G, c, nM, nN, pm, pn, FK_MOE_WGM)) return false;
        if (rev) pm = nM - 1 - pm;
        int s = 0;
#pragma unroll
        for (int q = 1; q < 16; ++q) s += (pm >= MT[q]) ? 1 : 0;
        const int tis = pm - MT[s], cnt = MT[32 + s];
        u.pm = s * SEGCAP + tis * BM; u.aux2 = cnt - tis * BM; u.pn = pn; u.aux = pm;
        u.A = gather_a ? A : A + (size_t)pm * BM * lda_b; u.B = W + (size_t)(s & 7) * wstride + (size_t)pn * BM * ldb_b; return true; }
};

__device__ __forceinline__ f32x4 bfx4_lo(const u32x4 a) { return (f32x4){bf_lo(a.x), bf_hi(a.x), bf_lo(a.y), bf_hi(a.y)}; }
__device__ __forceinline__ f32x4 bfx4_hi(const u32x4 a) { return (f32x4){bf_lo(a.z), bf_hi(a.z), bf_lo(a.w), bf_hi(a.w)}; }
__device__ __forceinline__ void final_phase(Frame& F) {
    const int gw = F.bx * 8 + F.wave, lane = F.lane;
    const LAS int* MT = (const LAS int*)(F.lds + MT_OFF);
    const f32x4 g0 = ((const f32x4*)karg_in(6))[2 * lane], g1 = ((const f32x4*)karg_in(6))[2 * lane + 1], g2 = ((const f32x4*)karg_in(6))[128 + 2 * lane], g3 = ((const f32x4*)karg_in(6))[128 + 2 * lane + 1];
    const bf16_t* HB = (const bf16_t*)(F.ws + WS_HB); const bf16_t* Y = (const bf16_t*)(F.ws + WS_Y); const int* TSL = (const int*)(F.ws + WS_TSL);
    for (int r0 = gw * 16; r0 < NTOK; r0 += F.G * 8 * 16) {
        const int sl = TSL[2 * r0 + (lane & 31)];
        const int cm = MT[sl >> 15] * BM + (sl & (SEGCAP - 1));
        u32x4 a[2], b[2], a1[2], b1[2], a2[2], b2[2];
#define FIN_LOAD(buf, i) do { const int c1 = __shfl(cm, 2 * (i)), c2 = __shfl(cm, 2 * (i) + 1); \
            const u32x4* p = (const u32x4*)(HB + (size_t)(r0 + (i)) * DM) + lane; const u32x4* y1 = (const u32x4*)(Y + (size_t)c1 * DM) + lane; const u32x4* y2 = (const u32x4*)(Y + (size_t)c2 * DM) + lane; \
            a[buf] = p[0]; b[buf] = p[64]; a1[buf] = y1[0]; b1[buf] = y1[64]; a2[buf] = y2[0]; b2[buf] = y2[64]; } while (0)
        FIN_LOAD(0, 0);
#pragma unroll
        for (int i = 0; i < 16; ++i) {
            const int cb = i & 1;
            if (i < 15) FIN_LOAD(cb ^ 1, i + 1);
            const f32x4 v0 = bfx4_lo(a[cb]) + bfx4_lo(a1[cb]) + bfx4_lo(a2[cb]), v1 = bfx4_hi(a[cb]) + bfx4_hi(a1[cb]) + bfx4_hi(a2[cb]), v2 = bfx4_lo(b[cb]) + bfx4_lo(b1[cb]) + bfx4_lo(b2[cb]), v3 = bfx4_hi(b[cb]) + bfx4_hi(b1[cb]) + bfx4_hi(b2[cb]);
            float s = ((v0[0] * v0[0] + v0[1] * v0[1]) + (v0[2] * v0[2] + v0[3] * v0[3])) + ((v1[0] * v1[0] + v1[1] * v1[1]) + (v1[2] * v1[2] + v1[3] * v1[3]));
            s += ((v2[0] * v2[0] + v2[1] * v2[1]) + (v2[2] * v2[2] + v2[3] * v2[3])) + ((v3[0] * v3[0] + v3[1] * v3[1]) + (v3[2] * v3[2] + v3[3] * v3[3]));
            const float rs = rsqrtf(wave_sum(s) * (1.0f / DM) + 1e-6f);
            f32x4* o = (f32x4*)(F.H + (size_t)(r0 + i) * DM) + 2 * lane;
            o[0] = v0 * rs * g0; o[1] = v1 * rs * g1; o[128] = v2 * rs * g2; o[129] = v3 * rs * g3; }
#undef FIN_LOAD
    }
}
constexpr int NPHASE = 19;
__global__ void __launch_bounds__(512, 2) mega(Args args) {
    extern __shared__ __attribute__((aligned(16))) unsigned char lds_raw[];
    Frame F;
    F.lds = (LAS unsigned char*)lds_raw;
    F.tid = threadIdx.x; F.lane = F.tid & 63; F.wave = __builtin_amdgcn_readfirstlane(F.tid >> 6); F.G = gridDim.x; F.bx = blockIdx.x;
    F.H = args.out; F.ws = args.ws;
    unsigned char* ws = args.ws;
    volatile LAS unsigned* MISC = (volatile LAS unsigned*)(F.lds + MISC_OFF);
    for (int u = F.tid; u < (LDS_BYTES - LDSCTL_OFF) / 4; u += 512) ((LAS unsigned*)(F.lds + LDSCTL_OFF))[u] = 0u;
    __syncthreads();
    const int lo = args.ph_lo, hi = args.ph_hi;
    const bool use_bar = (hi - lo) > 1;
    XcdBarrier bar; bar.bar = (unsigned*)(ws + WS_CTL) + CW_BAR; bar.x = 0; bar.st = nullptr;
    if (use_bar) bar = xcd_barrier_post((unsigned*)(ws + WS_CTL) + CW_BAR, MISC + 8);
#ifndef FK_PHASE_MASK
#define FK_PHASE_MASK 0x7ffff
#endif
#define IN(k) (((FK_PHASE_MASK >> (k)) & 1) && lo <= (k) && (k) < hi)
#define SEAM(k) do { if (IN((k) + 1)) xcd_barrier(bar); } while (0)
#ifndef FK_REV3
#define FK_REV3 0
#endif
#ifndef FK_REV8
#define FK_REV8 0
#endif
#ifndef FK_REV12
#define FK_REV12 0
#endif
#ifndef FK_REPEAT_MASK
#define FK_REPEAT_MASK 0
#endif
#define REP(k) ((FK_REPEAT_MASK >> (k)) & 1)
#ifdef FK_TPROBE
#define TP_BEGIN(k) do { if ((k) == FK_TPROBE && blockIdx.x == 0 && F.tid == 0) *(volatile unsigned long long*)(ws + 32768) = __builtin_amdgcn_s_memrealtime(); } while (0)
#define TP_END(k) do { if ((k) == FK_TPROBE && blockIdx.x == 0 && F.tid == 0) *(volatile unsigned long long*)(ws + 32776) = __builtin_amdgcn_s_memrealtime() - *(volatile unsigned long long*)(ws + 32768); } while (0)
#else
#define TP_BEGIN(k) do { } while (0)
#define TP_END(k) do { } while (0)
#endif
#ifdef FK_TPROBE2
#define TP2_FLAG(k) do { if (F.tid == 0) MISC[20] = ((k) == FK_TPROBE2) ? 1u : 0u; LDS_WAIT(); __syncthreads(); } while (0)
#define TP2_OUT(k) do { if ((k) == FK_TPROBE2 && blockIdx.x == 0 && F.tid == 0) *(volatile unsigned long long*)(ws + 32776) = *(volatile LAS unsigned long long*)(F.lds + MISC_OFF + 96); } while (0)
#else
#define TP2_FLAG(k) do { } while (0)
#define TP2_OUT(k) do { } while (0)
#endif
#define PHASE(k, ...) if (IN(k)) { TP2_FLAG(k); TP_BEGIN(k); { __VA_ARGS__ } if (REP(k)) { if (use_bar) xcd_barrier(bar); { __VA_ARGS__ } } SEAM(k); TP_END(k); TP2_OUT(k); }
    LAS unsigned char* ring = F.lds + RING_OFF; LAS float* TAB = (LAS float*)(F.lds + TAB_OFF);
    float* RSS = (float*)(ws + WS_RSS); bf16_t* HB = (bf16_t*)(ws + WS_HB);
    const int c = (int)blockIdx.x, G = (int)gridDim.x;

    PHASE(0, p0_prologue(F);)
    PHASE(1, KvOrder S{(const char*)(ws + WS_MEMN), (const char*)(ws + WS_WKT), G, c}; EpiPlain E{(bf16_t*)(ws + WS_KP), DM, (size_t)DM * DM};
        gemm_phase<EpiPlain, KvOrder>(ring, DM, DM, DM, S, E);)
    PHASE(2, MkVwOrder S{(const char*)(ws + WS_KP), (const char*)(ws + WS_WQS), (const char*)(ws + WS_WOT), G, c}; EpiPlain E{(bf16_t*)(ws + WS_MK), DM, (size_t)DM * DM};
        gemm_phase<EpiPlain, MkVwOrder>(ring, 256, DM, DM, S, E);)
    PHASE(3, DenseOrder S; S.init(HB, ws + WS_WIN0, NTOK, 2560, DM, DM, G, c); S.rev = FK_REV3; EpiGluZ E{(bf16_t*)(ws + WS_ZB), RSS};
        gemm_phase<EpiGluZ, DenseOrder>(ring, DM, DM, DM, S, E);)
    PHASE(4, conv_phase(F);)
    PHASE(5, DenseOrder S; S.init(ws + WS_MIX, ws + WS_WOUT0, NTOK, DM, DM, DM, G, c); EpiResid<false> E{HB, HB, RSS, TAB};
        gemm_phase<EpiResid<false>, DenseOrder>(ring, DM, DM, DM, S, E);)
    PHASE(6, DenseOrder S; S.init(HB, ws + WS_MK, NTOK, DM, DM, DM, G, c, 32, (size_t)DM * DM * 2); EpiSoftmax E{(bf16_t*)(ws + WS_PB), RSS, TAB};
        gemm_phase<EpiSoftmax, DenseOrder>(ring, DM, DM, DM, S, E);)
    PHASE(7, DenseOrder S; S.init(ws + WS_PB, ws + WS_MK + (size_t)8 * DM * DM * 2, NTOK, DM, DM, DM, G, c, 32, (size_t)DM * DM * 2); EpiResid<false> E{HB, HB, RSS, TAB};
        gemm_phase<EpiResid<false>, DenseOrder>(ring, DM, DM, DM, S, E);)
    PHASE(8, DenseOrder S; S.init(HB, ws + WS_WGU0, NTOK, 2 * DFF, DM, DM, G, c); S.rev = FK_REV8; EpiSwiGLU<false> E{(bf16_t*)(ws + WS_ACT0), DFF, RSS};
        gemm_phase<EpiSwiGLU<false>, DenseOrder>(ring, DM, DM, DM, S, E);)
    PHASE(9, DenseOrder S; S.init(ws + WS_ACT0, ws + WS_WD0, NTOK, DM, DFF, DFF, G, c); S.rev = 1; EpiResid<false> E{HB, HB, RSS, TAB};
        gemm_phase<EpiResid<false>, DenseOrder>(ring, DFF, DFF, DFF, S, E);)
    PHASE(10, DenseOrder S; S.init(HB, ws + WS_WSG, NTOK, 2048, DM, DM, G, c); EpiGeluUV E{(bf16_t*)(ws + WS_UV), RSS, (f32x2*)(ws + WS_VST), TAB};
        gemm_phase<EpiGeluUV, DenseOrder>(ring, DM, DM, DM, S, E);)
    PHASE(11, spatial_phase(F);)
    PHASE(12, DenseOrder S; S.init(ws + WS_US, ws + WS_WSO, NTOK, DM, DM, DM, G, c); S.rev = FK_REV12; EpiResid<false> E{HB, HB, RSS, TAB};
        gemm_phase<EpiResid<false>, DenseOrder>(ring, DM, DM, DM, S, E);)
    PHASE(13, DenseOrder S; S.init(HB, ws + WS_MK + (size_t)4 * DM * DM * 2, NTOK, DM, DM, DM, G, c, 32, (size_t)DM * DM * 2); EpiSoftmax E{(bf16_t*)(ws + WS_PB), RSS, TAB};
        gemm_phase<EpiSoftmax, DenseOrder>(ring, DM, DM, DM, S, E);)
    PHASE(14, DenseOrder S; S.init(ws + WS_PB, ws + WS_MK + (size_t)12 * DM * DM * 2, NTOK, DM, DM, DM, G, c, 32, (size_t)DM * DM * 2); EpiResid<false> E{HB, HB, RSS, TAB};
        gemm_phase<EpiResid<false>, DenseOrder>(ring, DM, DM, DM, S, E);)
    PHASE(15, router_phase(F);)
    if (hi > 16) moe_tables(F);
    const LAS int* MT = (const LAS int*)(F.lds + MT_OFF);
    PHASE(16, MoeOrder S{(const char*)(ws + WS_HB8), (const char*)(ws + WS_WGU1), (size_t)2 * DFF * DM, DM, DM, 22, G, c, MT, 1, (const int*)(ws + WS_STOK), 0}; EpiSwiGLU8 E{(unsigned char*)(ws + WS_ACT8)};
        gemm_phase<EpiSwiGLU8, MoeOrder, true, true>(ring, DM, DM, DM, S, E);)
    PHASE(17, MoeOrder S{(const char*)(ws + WS_ACT8), (const char*)(ws + WS_WD1), (size_t)DM * DFF, DFF, DFF, 4, G, c, MT, 0, nullptr, 0}; EpiMoeDown8 E{(bf16_t*)(ws + WS_Y), (const float*)(ws + WS_SGW)};
        gemm_phase<EpiMoeDown8, MoeOrder, false, true>(ring, DFF, DFF, DFF, S, E);)
    if (IN(18)) { TP_BEGIN(18); final_phase(F); TP_END(18); }
#undef IN
#undef SEAM
}

#if defined(FK_TPROBE) || defined(FK_TPROBE2)
#ifdef FK_TPROBE2
#define FK_TPAMP 64ull
#else
#define FK_TPAMP 8ull
#endif
__global__ void k_tprobe_spin(const unsigned char* ws) { const unsigned long long d = *(const volatile unsigned long long*)(ws + 32776), te = __builtin_amdgcn_s_memrealtime(); while (__builtin_amdgcn_s_memrealtime() - te < FK_TPAMP * d) __builtin_amdgcn_s_sleep(32); }
#endif
static int fk_grid = 0;
static bool fk_setup() {
    if (fk_grid == 0) {
        int dev = 0, cus = 0, per_cu = 0;
        if (hipGetDevice(&dev) != hipSuccess || hipDeviceGetAttribute(&cus, hipDeviceAttributeMultiprocessorCount, dev) != hipSuccess) { fk_grid = -1; return false; }
        if (hipFuncSetAttribute((const void*)mega, hipFuncAttributeMaxDynamicSharedMemorySize, LDS_BYTES) != hipSuccess) { fprintf(stderr, "hipFuncSetAttribute failed\n"); fk_grid = -1; return false; }
        if (hipOccupancyMaxActiveBlocksPerMultiprocessor(&per_cu, (const void*)mega, 512, LDS_BYTES) != hipSuccess || per_cu < 1) fprintf(stderr, "note: occupancy query says %d\n", per_cu);
        (void)hipGetLastError();
        fk_grid = 256;
        if (cus != 256) fprintf(stderr, "note: %d CUs reported; this kernel is built for 256\n", cus);
    }
    return fk_grid > 0;
}
static void fk_run(hipStream_t stream, void* const* d_in, void* d_out, void* d_ws, int lo, int hi, bool per_phase) {
    if (!fk_setup()) return;
    Args a{};
    for (int i = 0; i < 31; ++i) a.in[i] = (const float*)d_in[i];
    a.out = (float*)d_out; a.ws = (unsigned char*)d_ws;
#ifndef FK_HOST_REPEAT_MASK
#define FK_HOST_REPEAT_MASK 0
#endif
    if (per_phase) { for (int p = lo; p < hi; ++p) { a.ph_lo = p; a.ph_hi = p + 1; const int reps = ((FK_HOST_REPEAT_MASK >> p) & 1) ? 2 : 1;
        for (int q = 0; q < reps; ++q) hipLaunchKernelGGL(mega, dim3(fk_grid), dim3(512), LDS_BYTES, stream, a); } }
    else { a.ph_lo = lo; a.ph_hi = hi; hipLaunchKernelGGL(mega, dim3(fk_grid), dim3(512), LDS_BYTES, stream, a); }
#if defined(FK_TPROBE) || defined(FK_TPROBE2)
    hipLaunchKernelGGL(k_tprobe_spin, dim3(1), dim3(1), 0, stream, (const unsigned char*)d_ws);
#endif
    const hipError_t le = hipPeekAtLastError();
    if (le != hipSuccess) fprintf(stderr, "kernel_launch: launch failed: %s\n", hipGetErrorName(le));
}
}

#ifndef FK_MODE
#define FK_MODE 1
#endif
#ifndef FK_NSUB
#define FK_NSUB 1
#endif
extern "C" void kernel_launch(void* const* d_in, const int* in_sizes, int n_in, void* d_out, int out_size, void* d_ws, size_t ws_size, hipStream_t stream) {
    if (n_in != 31 || out_size != fk::NTOK * fk::DM || ws_size < fk::WS_END) { fprintf(stderr, "kernel_launch: unexpected shapes (n_in %d out %d ws %zu)\n", n_in, out_size, ws_size); return; }
    (void)hipMemsetAsync((char*)d_ws + fk::WS_CTL, 0, fk::CTL_ZERO_BYTES, stream);
#if FK_MODE == 1
    fk::fk_run(stream, d_in, d_out, d_ws, 0, fk::NPHASE, false);
#elif FK_MODE == 2
    fk::fk_run(stream, d_in, d_out, d_ws, 0, fk::NPHASE, true);
#elif FK_MODE == 3
    { constexpr int endph[7] = {0, 6, 8, 10, 13, 15, 18};
      float* h = (float*)d_out;
      if (FK_NSUB == 0) (void)hipMemcpyAsync(h, d_in[0], (size_t)nv::NTOK * nv::DM * 4, hipMemcpyDeviceToDevice, stream);
      else fk::fk_run(stream, d_in, d_out, d_ws, 0, endph[FK_NSUB], true);
      const nv::Bufs B = nv::carve(d_ws);
      for (int s = FK_NSUB; s < 6; ++s) nv::sublayer(stream, s, h, d_in, B);
      nv::final_norm(stream, h, d_in); }
#else
    { float* h = (float*)d_out;
      (void)hipMemcpyAsync(h, d_in[0], (size_t)nv::NTOK * nv::DM * 4, hipMemcpyDeviceToDevice, stream);
      const nv::Bufs B = nv::carve(d_ws);
      for (int s = 0; s < 6; ++s) nv::sublayer(stream, s, h, d_in, B);
      nv::final_norm(stream, h, d_in); }
#endif
}
```

```cpp
#include <hip/hip_runtime.h>
#include <cstdio>
#include <cstdint>
#define FK_MODE 1
#define FK_NSUB 0
namespace fk {
#define LAS __attribute__((address_space(3)))
#define GAS __attribute__((address_space(1)))
typedef unsigned short bf16_t;
typedef short bf16x8 __attribute__((ext_vector_type(8)));
typedef float f32x4 __attribute__((ext_vector_type(4)));
typedef float f32x2 __attribute__((ext_vector_type(2)));
typedef unsigned u32x4 __attribute__((ext_vector_type(4)));
typedef unsigned u32x2 __attribute__((ext_vector_type(2)));
typedef int i32x4 __attribute__((ext_vector_type(4)));
typedef GAS unsigned gu32;

constexpr int NTOK = 32768, DM = 1024, SEQL = 8192, MEML = 256, DFF = 2816, NEXP = 8;
constexpr int ZW = 1536;
constexpr int HALF_TILES = 136, HALF_ROWS = HALF_TILES * 256;
constexpr int BM = 256, BK = 64, HALF = 128, HTB = HALF * BK * 2, NXCD = 8, WGM = 8;

constexpr int RING_OFF = 0, RING_BYTES = 131072;
constexpr int LDSCTL_OFF = RING_BYTES, MISC_OFF = LDSCTL_OFF + 320;
constexpr int TAB_OFF = LDSCTL_OFF + 512;
constexpr int MT_OFF = TAB_OFF + 8192;
constexpr int RSCR_OFF = MT_OFF + 256;
constexpr int LDS_BYTES = 147456;
static_assert(RSCR_OFF + 4096 <= LDS_BYTES, "LDS map");

constexpr size_t MiB = 1u << 20;
constexpr size_t WS_CTL = 0, CTL_ZERO_BYTES = 64 * 1024;
constexpr size_t WS_RSS = 1 * MiB;
constexpr size_t WS_VST = 2 * MiB;
constexpr size_t WS_TSL = 3 * MiB;
constexpr size_t WS_STOK = 4 * MiB;
constexpr size_t WS_SGW = 6 * MiB;
constexpr size_t WS_MEMN = 8 * MiB;
constexpr size_t WS_KP = 12 * MiB;
constexpr size_t WS_WGU1 = 20 * MiB;
constexpr size_t WS_WD1 = 64 * MiB;
constexpr size_t WS_HB = 86 * MiB;
constexpr size_t WS_HB8 = 150 * MiB;
constexpr size_t WS_WIN0 = 182 * MiB;
constexpr size_t WS_WOUT0 = 187 * MiB;
constexpr size_t WS_WGU0 = 189 * MiB;
constexpr size_t WS_WD0 = 200 * MiB;
constexpr size_t WS_WQS = 206 * MiB;
constexpr size_t WS_WOT = 210 * MiB;
constexpr size_t WS_WKT = 214 * MiB;
constexpr size_t WS_MK = 222 * MiB;
constexpr size_t WS_WSG = 254 * MiB;
constexpr size_t WS_WSO = 258 * MiB;
constexpr size_t WS_R = 262 * MiB;
constexpr size_t WS_ZB = WS_R, WS_MIX = WS_R + 96 * MiB, WS_PB = WS_R, WS_ACT0 = WS_R, WS_UV = WS_R, WS_US = WS_R + 128 * MiB;
constexpr int SEGCAP = 32768;
constexpr int MOE_TILES = 2 * HALF_TILES;
constexpr size_t WS_ACT8 = 182 * MiB;
constexpr size_t WS_Y = 369 * MiB;
constexpr size_t WS_END = 512 * MiB;
static_assert(WS_ACT8 + (size_t)MOE_TILES * 256 * DFF <= WS_Y && WS_Y + (size_t)MOE_TILES * 256 * DM * 2 <= WS_END && WS_R + 216 * MiB <= WS_END, "ws map");
constexpr int CW_SEG = 512;
constexpr int CW_BAR = 1024;

#define RLX_AGENT __ATOMIC_RELAXED, __HIP_MEMORY_SCOPE_AGENT
#define LDS_WAIT() asm volatile("s_waitcnt lgkmcnt(0)" ::: "memory")
#define VM_WAIT() asm volatile("s_waitcnt vmcnt(0)" ::: "memory")
__device__ __forceinline__ unsigned cvt_pk_bf16(float lo, float hi) { unsigned r; asm volatile("v_cvt_pk_bf16_f32 %0, %1, %2" : "=v"(r) : "v"(lo), "v"(hi)); return r; }
__device__ __forceinline__ float bf_lo(unsigned w) { return __uint_as_float(w << 16); }
__device__ __forceinline__ float bf_hi(unsigned w) { return __uint_as_float(w & 0xffff0000u); }
__device__ __forceinline__ float fast_sigmoid(float x) { return __builtin_amdgcn_rcpf(1.0f + __builtin_amdgcn_exp2f(-1.4426950408889634f * x)); }
__device__ __forceinline__ float fast_exp(float x) { return __builtin_amdgcn_exp2f(1.4426950408889634f * x); }
__device__ __forceinline__ float gelu_tanh_f(float x) { const float y = 1.5957691216057308f * (x + 0.044715f * x * x * x); return x * fast_sigmoid(y); }
__device__ __forceinline__ float wave_sum(float v) {
#pragma unroll
    for (int o = 1; o < 64; o <<= 1) v += __shfl_xor(v, o);
    return v;
}
__device__ __forceinline__ float rstd_from_rss(const float* RSS4, int row) { const f32x4 s = *(const f32x4*)(RSS4 + (size_t)row * 4); return rsqrtf(((s.x + s.y) + (s.z + s.w)) * (1.0f / DM) + 1e-6f); }

__host__ __device__ __forceinline__ int lds_byte(int r, int c) { const int st = (r >> 4) * 2 + (c >> 5), rr = r & 15, cc = c & 31, ob = rr * 64 + cc * 2; return st * 1024 + (ob ^ (((ob >> 9) & 1) << 5)); }
__host__ __device__ __forceinline__ void stage_rc(int b, int& R, int& C) { const int st = b / 1024, sb = b % 1024, swz = sb ^ (((sb >> 9) & 1) << 5); R = (st >> 1) * 16 + swz / 64; C = (st & 1) * 32 + (swz % 64) / 2; }
__host__ __device__ __forceinline__ int perm32(int rho) { const int n = rho >> 4, i = rho & 15; return 8 * (i >> 2) + 4 * n + (i & 3); }

struct Unit { const char* A; const char* B; int pm, pn, aux, aux2; };

__device__ __forceinline__ bool tile_order(int i, int G, int c, int nM, int nN, int& pm, int& pn, const int WGM = 8) {
    const int nwg = nM * nN; const long L = (long)i * G + c; if (L >= nwg) return false;
    int wgid = (int)L; { const int q = nwg / NXCD, r = nwg % NXCD, xcd = wgid % NXCD, off = wgid / NXCD; wgid = (xcd < r ? xcd * (q + 1) : r * (q + 1) + (xcd - r) * q) + off; }
    const int nig = WGM * nN, gid = wgid / nig, fm = gid * WGM, gsz = (nM - fm) < WGM ? (nM - fm) : WGM;
    pm = fm + ((wgid % nig) % gsz); pn = (wgid % nig) / gsz; return true;
}
struct DenseOrder {
    const char* A; const char* Bt; int lda, ldb, nM, nN, G, c, pm_per_b; size_t bstride; int rev;
    __device__ __forceinline__ void init(const void* A_, const void* Bt_, int M, int N, int lda_, int ldb_, int G_, int c_, int pmb = 0, size_t bs = 0) {
        A = (const char*)A_; Bt = (const char*)Bt_; lda = lda_; ldb = ldb_; nM = M / BM; nN = N / BM; G = G_; c = c_; pm_per_b = pmb; bstride = bs; rev = 0; }
    __device__ __forceinline__ bool next(int i, Unit& u) const {
        int pm, pn; if (!tile_order(i, G, c, nM, nN, pm, pn)) return false;
        if (rev) pm = nM - 1 - pm;
        u.pm = pm; u.pn = pn; u.aux = 0; u.aux2 = 0; u.A = A + (size_t)pm * BM * lda * 2; u.B = Bt + (size_t)pn * BM * ldb * 2 + (pm_per_b ? (size_t)(pm / pm_per_b) * bstride : 0); return true; }
};

typedef int v4i_t __attribute__((ext_vector_type(4)));
typedef int v8i_t __attribute__((ext_vector_type(8)));
__device__ __forceinline__ v8i_t lds_ld32(const LAS unsigned char* p) { const v4i_t a = *(const LAS v4i_t*)p, b = *(const LAS v4i_t*)(p + 1024); return __builtin_shufflevector(a, b, 0, 1, 2, 3, 4, 5, 6, 7); }
template <class Epi, class Sched, bool GATHER = false, bool FP8 = false, bool ALIGN_EPI = true, bool SP2 = true>
__device__ __forceinline__ void gemm_phase(LAS unsigned char* lds, const int K, const int lda, const int ldb, const Sched& S, const Epi& E) {
    int tid_ = threadIdx.x; asm volatile("" : "+v"(tid_));
    const int tid = tid_, wid = __builtin_amdgcn_readfirstlane(tid >> 6), lane = tid & 63, wr = wid >> 2, wc = wid & 3, fr = lane & 15, fq = lane >> 4;
    int K_ = K; asm volatile("" : "+s"(K_));
    constexpr int ES = FP8 ? 1 : 2;
    const int nt = K_ * ES / 128;
    unsigned voffA[2][2], voffB[2];
#pragma unroll
    for (int i = 0; i < 2; ++i) { int R, C; stage_rc(tid * 16 + i * 8192, R, C); const int Rb = Epi::PERM ? ((R & ~31) + perm32(R & 31)) : R;
        voffA[0][i] = (unsigned)(R * lda * ES + C * 2); voffA[1][i] = (unsigned)((R + HALF) * lda * ES + C * 2); voffB[i] = (unsigned)(Rb * ldb * ES + C * 2); }
#define PG8_GIDX(dst, un) do { _Pragma("unroll") for (int _h = 0; _h < 2; ++_h) _Pragma("unroll") for (int _i = 0; _i < 2; ++_i) { int _R0, _C0; stage_rc(tid * 16 + _i * 8192, _R0, _C0); const int _R = _R0 + HALF * _h, _m = (un).aux2 - 1; \
        dst[_h][_i] = S.stok[(un).pm + (_R < _m ? _R : _m)]; } } while (0)
#define PG8_GOFF(dst, src) do { _Pragma("unroll") for (int _h = 0; _h < 2; ++_h) _Pragma("unroll") for (int _i = 0; _i < 2; ++_i) { int _R0, _C0; stage_rc(tid * 16 + _i * 8192, _R0, _C0); dst[_h][_i] = (unsigned)(src[_h][_i] * lda * ES + _C0 * 2); } } while (0)
    const size_t kstep = (size_t)(BK * 2);
    const size_t hstepB = (size_t)HALF * ldb * ES;
    const unsigned ldsw = (unsigned)wid * 1024u;
    const int aoff = lds_byte(wr * 64 + fr, fq * 8), boff = lds_byte(wc * 32 + fr, fq * 8);
#define PG8_SA(b, h) (((b) * 2 + (h)) * HTB)
#define PG8_SB(b, h) ((4 + (b) * 2 + (h)) * HTB)
#define PG8_STAGE(bufoff, gbase, voff) do { _Pragma("unroll") for (int _i = 0; _i < 2; ++_i) { unsigned _o = (voff)[_i]; asm volatile("" : "+v"(_o));     \
        __builtin_amdgcn_global_load_lds((const unsigned*)((const char*)(gbase) + _o), (LAS unsigned*)(lds + (bufoff) + ldsw + _i * 8192), 16, 0, 0); } } while (0)
#define PG8_LDA(dst, b, h) do { if constexpr (FP8) { _Pragma("unroll") for (int m = 0; m < 4; ++m) dst##8[m] = lds_ld32(lds + PG8_SA(b, h) + aoff + m * 2048); } else { \
        _Pragma("unroll") for (int m = 0; m < 4; ++m) _Pragma("unroll") for (int k = 0; k < 2; ++k) dst[m][k] = *(const LAS bf16x8*)(lds + PG8_SA(b, h) + aoff + m * 2048 + k * 1024); } } while (0)
#define PG8_LDB(dst, b, h) do { if constexpr (FP8) { _Pragma("unroll") for (int n = 0; n < 2; ++n) dst##8[n] = lds_ld32(lds + PG8_SB(b, h) + boff + n * 2048); } else { \
        _Pragma("unroll") for (int n = 0; n < 2; ++n) _Pragma("unroll") for (int k = 0; k < 2; ++k) dst[n][k] = *(const LAS bf16x8*)(lds + PG8_SB(b, h) + boff + n * 2048 + k * 1024); } } while (0)
#define PG8_MMA8(ai, bj, At8, Bt8) asm volatile("s_nop 1\n\t" \
        "v_mfma_f32_16x16x128_f8f6f4 %0, %12, %8, %0\n\tv_mfma_f32_16x16x128_f8f6f4 %1, %13, %8, %1\n\t" \
        "v_mfma_f32_16x16x128_f8f6f4 %2, %12, %9, %2\n\tv_mfma_f32_16x16x128_f8f6f4 %3, %13, %9, %3\n\t" \
        "v_mfma_f32_16x16x128_f8f6f4 %4, %12, %10, %4\n\tv_mfma_f32_16x16x128_f8f6f4 %5, %13, %10, %5\n\t" \
        "v_mfma_f32_16x16x128_f8f6f4 %6, %12, %11, %6\n\tv_mfma_f32_16x16x128_f8f6f4 %7, %13, %11, %7" \
        : "+v"(acc[ai][bj][0][0]), "+v"(acc[ai][bj][0][1]), "+v"(acc[ai][bj][1][0]), "+v"(acc[ai][bj][1][1]), "+v"(acc[ai][bj][2][0]), "+v"(acc[ai][bj][2][1]), "+v"(acc[ai][bj][3][0]), "+v"(acc[ai][bj][3][1]) \
        : "v"(At8[0]), "v"(At8[1]), "v"(At8[2]), "v"(At8[3]), "v"(Bt8[0]), "v"(Bt8[1]))
#define PG8_MMA(ai, bj, At, Bt) do { __builtin_amdgcn_s_setprio(1); if constexpr (FP8) { PG8_MMA8(ai, bj, At##8, Bt##8); } else { \
        _Pragma("unroll") for (int m = 0; m < 4; ++m) _Pragma("unroll") for (int n = 0; n < 2; ++n) _Pragma("unroll") for (int k = 0; k < 2; ++k) \
        acc[ai][bj][m][n] = __builtin_amdgcn_mfma_f32_16x16x32_bf16(Bt[n][k], At[m][k], acc[ai][bj][m][n], 0, 0, 0); } __builtin_amdgcn_s_setprio(0); } while (0)
#define PG8_WAIT_V(n) asm volatile("s_waitcnt vmcnt(" #n ")" ::: "memory")
#define PG8_WAIT_L(n) asm volatile("s_waitcnt lgkmcnt(" #n ")" ::: "memory")
#define PG8_BAR __builtin_amdgcn_s_barrier()
#define PG8_SCHED __builtin_amdgcn_sched_barrier(0)
    Unit cur, nxt; int ui = 0;
    if (!S.next(0, cur)) return;
    f32x4 acc[2][2][4][2];
#pragma unroll
    for (int a = 0; a < 2; ++a)
#pragma unroll
        for (int b = 0; b < 2; ++b)
#pragma unroll
            for (int m = 0; m < 4; ++m)
#pragma unroll
                for (int n = 0; n < 2; ++n) acc[a][b][m][n] = (f32x4){0.f, 0.f, 0.f, 0.f};
    bf16x8 At[4][2], B0[2][2], B1[2][2]; v8i_t At8[4], B08[2], B18[2];
    const char* cA = cur.A; const char* cB = cur.B;
    int ntok[2][2] = {{0, 0}, {0, 0}}, ntok2[2][2] = {{0, 0}, {0, 0}};
    if constexpr (GATHER) { PG8_GIDX(ntok, cur); PG8_GOFF(voffA, ntok); Unit u1; if (S.next(1, u1)) PG8_GIDX(ntok, u1); }
    if constexpr (SP2) {
        PG8_STAGE(PG8_SB(0, 0), cB, voffB); PG8_STAGE(PG8_SB(0, 1), cB + hstepB, voffB); PG8_STAGE(PG8_SA(0, 0), cA, voffA[0]); PG8_STAGE(PG8_SA(0, 1), cA, voffA[1]);
        if (wr == 1) PG8_BAR;
        PG8_WAIT_V(2); PG8_BAR;
        PG8_STAGE(PG8_SB(1, 0), cB + kstep, voffB); PG8_STAGE(PG8_SA(1, 0), cA + kstep, voffA[0]); PG8_STAGE(PG8_SB(1, 1), cB + hstepB + kstep, voffB);
        PG8_WAIT_V(6); PG8_BAR;
    } else {
        PG8_STAGE(PG8_SB(0, 0), cB, voffB); PG8_STAGE(PG8_SA(0, 0), cA, voffA[0]); PG8_STAGE(PG8_SB(0, 1), cB + hstepB, voffB); PG8_STAGE(PG8_SA(0, 1), cA, voffA[1]);
        if (wr == 1) PG8_BAR;
        PG8_WAIT_V(4); PG8_BAR;
        PG8_STAGE(PG8_SB(1, 0), cB + kstep, voffB); PG8_STAGE(PG8_SA(1, 0), cA + kstep, voffA[0]); PG8_STAGE(PG8_SB(1, 1), cB + hstepB + kstep, voffB);
        PG8_WAIT_V(6); PG8_BAR;
    }
    for (;;) {
        const bool has_next = S.next(ui + 1, nxt);
        const char* nA = has_next ? nxt.A : cA; const char* nB = has_next ? nxt.B : cB;
        Unit u2; const bool has_next2 = GATHER ? S.next(ui + 2, u2) : false;
        for (int t = 0; t < nt; t += 2) {
            const bool last = (t == nt - 2);
            unsigned v2A[2][2];
#pragma unroll
            for (int _h = 0; _h < 2; ++_h)
#pragma unroll
                for (int _i = 0; _i < 2; ++_i) v2A[_h][_i] = voffA[_h][_i];
            if constexpr (GATHER) { if (t == 0 && has_next2) PG8_GIDX(ntok2, u2);
                if (last && has_next) PG8_GOFF(v2A, ntok); }
            const char* a1 = cA + (size_t)(t + 1) * kstep;
            const char* a2 = last ? nA : cA + (size_t)(t + 2) * kstep; const char* b2 = last ? nB : cB + (size_t)(t + 2) * kstep;
            const char* a3 = a2 + kstep; const char* b3 = b2 + kstep;
            if constexpr (SP2) {
            PG8_LDB(B0, 0, 0); PG8_LDB(B1, 0, 1); PG8_SCHED; PG8_LDA(At, 0, 0); PG8_STAGE(PG8_SA(1, 1), a1, voffA[1]);
            PG8_WAIT_V(8); PG8_WAIT_L(0); PG8_BAR; PG8_MMA(0, 0, At, B0); PG8_MMA(0, 1, At, B1); PG8_BAR; PG8_SCHED;
            PG8_LDA(At, 0, 1); PG8_STAGE(PG8_SB(0, 0), b2, voffB); PG8_STAGE(PG8_SB(0, 1), b2 + hstepB, voffB); PG8_STAGE(PG8_SA(0, 0), a2, v2A[0]);
            PG8_WAIT_V(8); PG8_WAIT_L(0); PG8_BAR; PG8_MMA(1, 0, At, B0); PG8_MMA(1, 1, At, B1); PG8_BAR; PG8_SCHED;
            PG8_LDB(B0, 1, 0); PG8_LDB(B1, 1, 1); PG8_SCHED; PG8_LDA(At, 1, 0); PG8_STAGE(PG8_SA(0, 1), a2, v2A[1]);
            PG8_WAIT_V(8); PG8_WAIT_L(0); PG8_BAR; PG8_MMA(0, 0, At, B0); PG8_MMA(0, 1, At, B1); PG8_BAR; PG8_SCHED;
            PG8_LDA(At, 1, 1); PG8_STAGE(PG8_SB(1, 0), b3, voffB); PG8_STAGE(PG8_SB(1, 1), b3 + hstepB, voffB); PG8_STAGE(PG8_SA(1, 0), a3, v2A[0]);
            PG8_WAIT_V(8); PG8_WAIT_L(0); PG8_BAR; PG8_MMA(1, 0, At, B0); PG8_MMA(1, 1, At, B1); PG8_BAR; PG8_SCHED;
            } else {
            PG8_LDB(B0, 0, 0); PG8_SCHED; PG8_LDA(At, 0, 0); PG8_STAGE(PG8_SA(1, 1), a1, voffA[1]);
            PG8_WAIT_L(8); PG8_BAR; PG8_WAIT_L(0); PG8_MMA(0, 0, At, B0); PG8_BAR; PG8_SCHED;
            PG8_LDB(B1, 0, 1); PG8_STAGE(PG8_SB(0, 0), b2, voffB);
            PG8_BAR; PG8_WAIT_L(0); PG8_MMA(0, 1, At, B1); PG8_BAR;
            PG8_LDA(At, 0, 1); PG8_STAGE(PG8_SA(0, 0), a2, v2A[0]);
            PG8_BAR; PG8_WAIT_L(0); PG8_MMA(1, 0, At, B0); PG8_BAR; PG8_SCHED;
            PG8_STAGE(PG8_SB(0, 1), b2 + hstepB, voffB);
            PG8_WAIT_V(6); PG8_BAR; PG8_MMA(1, 1, At, B1); PG8_BAR;
            PG8_LDB(B0, 1, 0); PG8_SCHED; PG8_LDA(At, 1, 0); PG8_STAGE(PG8_SA(0, 1), a2, v2A[1]);
            PG8_WAIT_L(8); PG8_BAR; PG8_WAIT_L(0); PG8_MMA(0, 0, At, B0); PG8_BAR; PG8_SCHED;
            PG8_LDB(B1, 1, 1); PG8_STAGE(PG8_SB(1, 0), b3, voffB);
            PG8_BAR; PG8_WAIT_L(0); PG8_MMA(0, 1, At, B1); PG8_BAR;
            PG8_LDA(At, 1, 1); PG8_STAGE(PG8_SA(1, 0), a3, v2A[0]);
            PG8_BAR; PG8_WAIT_L(0); PG8_MMA(1, 0, At, B0); PG8_BAR; PG8_SCHED;
            PG8_STAGE(PG8_SB(1, 1), b3 + hstepB, voffB);
            PG8_WAIT_V(6); PG8_BAR; PG8_MMA(1, 1, At, B1); PG8_BAR;
            }
        }
        if constexpr (ALIGN_EPI) { if (wr == 0) PG8_BAR; }
        if constexpr (FP8) asm volatile("s_nop 15\n\ts_nop 15" ::: "memory");
        E(acc, cur, wr, wc, fr, fq, tid);
        if (!has_next) break;
#pragma unroll
        for (int a = 0; a < 2; ++a)
#pragma unroll
            for (int b = 0; b < 2; ++b)
#pragma unroll
                for (int m = 0; m < 4; ++m)
#pragma unroll
                    for (int n = 0; n < 2; ++n) acc[a][b][m][n] = (f32x4){0.f, 0.f, 0.f, 0.f};
        cur = nxt; cA = nA; cB = nB; ++ui;
        if constexpr (GATHER) { PG8_GOFF(voffA, ntok);
#pragma unroll
            for (int _h = 0; _h < 2; ++_h)
#pragma unroll
                for (int _i = 0; _i < 2; ++_i) ntok[_h][_i] = ntok2[_h][_i]; }
        if constexpr (ALIGN_EPI) { if (wr == 1) PG8_BAR; }
    }
    PG8_WAIT_V(0);
    if constexpr (!ALIGN_EPI) { if (wr == 0) PG8_BAR; }
    PG8_BAR;
#undef PG8_SA
#undef PG8_SB
#undef PG8_STAGE
#undef PG8_LDA
#undef PG8_LDB
#undef PG8_MMA
#undef PG8_MMA8
#undef PG8_WAIT_V
#undef PG8_WAIT_L
#undef PG8_BAR
#undef PG8_SCHED
#undef PG8_GOFF
#undef PG8_GIDX
}

#define EPI_BAR() do { asm volatile("s_waitcnt lgkmcnt(0)" ::: "memory"); __builtin_amdgcn_s_barrier(); asm volatile("" ::: "memory"); } while (0)
typedef f32x4 acc_t[2][2][4][2];

struct EpiPlain {
    static constexpr bool PERM = true;
    bf16_t* O; int ldc; size_t aux_stride;
    __device__ __forceinline__ void operator()(acc_t& acc, const Unit& u, int wr, int wc, int fr, int fq, int tid) const {
        bf16_t* base = O + (size_t)u.aux * aux_stride + (size_t)(u.pm * BM + wr * 64 + fr) * ldc + u.pn * BM + wc * 32 + 8 * fq;
#pragma unroll
        for (int ai = 0; ai < 2; ++ai)
#pragma unroll
            for (int m = 0; m < 4; ++m) { bf16_t* rowp = base + (size_t)(ai * HALF + m * 16) * ldc;
#pragma unroll
                for (int bj = 0; bj < 2; ++bj) { const f32x4 v0 = acc[ai][bj][m][0], v1 = acc[ai][bj][m][1];
                    u32x4 w; w.x = cvt_pk_bf16(v0[0], v0[1]); w.y = cvt_pk_bf16(v0[2], v0[3]); w.z = cvt_pk_bf16(v1[0], v1[1]); w.w = cvt_pk_bf16(v1[2], v1[3]);
                    *(u32x4*)(rowp + bj * HALF) = w; } }
    }
};

__device__ __forceinline__ f32x2 silu_mul_pk(f32x2 g, f32x2 up) {
    const f32x2 t = g * (-1.4426950408889634f); f32x2 e; e.x = __builtin_amdgcn_exp2f(t.x); e.y = __builtin_amdgcn_exp2f(t.y);
    const f32x2 d = e + 1.0f; f32x2 r; r.x = __builtin_amdgcn_rcpf(d.x); r.y = __builtin_amdgcn_rcpf(d.y);
    return (g * r) * up;
}
__device__ __forceinline__ f32x2 gelu_tanh_pk(f32x2 x) {
    const f32x2 x2 = x * x, p = x2 * 0.044715f + 1.0f, t = (x * p) * (-1.5957691216057308f * 1.4426950408889634f);
    f32x2 e; e.x = __builtin_amdgcn_exp2f(t.x); e.y = __builtin_amdgcn_exp2f(t.y);
    const f32x2 d = e + 1.0f; f32x2 r; r.x = __builtin_amdgcn_rcpf(d.x); r.y = __builtin_amdgcn_rcpf(d.y);
    return x * r;
}
struct EpiGluZ {
    static constexpr bool PERM = true;
    bf16_t* ZB; const float* RSS4;
    template <int KIND  >
    __device__ __forceinline__ void tile(acc_t& acc, const Unit& u, int wr, int wc, int fr, int fq, int cofs) const {
#pragma unroll
        for (int ai = 0; ai < 2; ++ai)
#pragma unroll
            for (int m = 0; m < 4; ++m) {
                const int row = u.pm * BM + ai * HALF + wr * 64 + m * 16 + fr; const float rs = rstd_from_rss(RSS4, row);
                bf16_t* rowp = ZB + (size_t)row * ZW + wc * 32 + 8 * fq + cofs;
                if (KIND != 1) {
                    float o[8];
#pragma unroll
                    for (int n = 0; n < 2; ++n)
#pragma unroll
                        for (int e = 0; e < 4; e += 2) { const f32x2 a = (f32x2){acc[ai][0][m][n][e], acc[ai][0][m][n][e + 1]} * rs, b = (f32x2){acc[ai][1][m][n][e], acc[ai][1][m][n][e + 1]} * rs; f32x2 q;
                            if (KIND == 0) { const f32x2 t = b * (-1.4426950408889634f); f32x2 ex; ex.x = __builtin_amdgcn_exp2f(t.x); ex.y = __builtin_amdgcn_exp2f(t.y); const f32x2 d = ex + 1.0f; f32x2 rc; rc.x = __builtin_amdgcn_rcpf(d.x); rc.y = __builtin_amdgcn_rcpf(d.y); q = a * rc; }
                            else q = a * b;
                            o[n * 4 + e] = q.x; o[n * 4 + e + 1] = q.y; }
                    u32x4 w; w.x = cvt_pk_bf16(o[0], o[1]); w.y = cvt_pk_bf16(o[2], o[3]); w.z = cvt_pk_bf16(o[4], o[5]); w.w = cvt_pk_bf16(o[6], o[7]);
                    *(u32x4*)rowp = w;
                } else {
#pragma unroll
                    for (int bj = 0; bj < 2; ++bj) { const f32x4 v0 = acc[ai][bj][m][0] * rs, v1 = acc[ai][bj][m][1] * rs;
                        u32x4 w; w.x = cvt_pk_bf16(v0[0], v0[1]); w.y = cvt_pk_bf16(v0[2], v0[3]); w.z = cvt_pk_bf16(v1[0], v1[1]); w.w = cvt_pk_bf16(v1[2], v1[3]);
                        *(u32x4*)(rowp + bj * HALF) = w; }
                }
            }
    }
    __device__ __forceinline__ void operator()(acc_t& acc, const Unit& u, int wr, int wc, int fr, int fq, int tid) const {
        const int pn = u.pn;
        if (pn < 4) tile<0>(acc, u, wr, wc, fr, fq, 128 * pn);
        else if (pn < 6) tile<1>(acc, u, wr, wc, fr, fq, 512 + 256 * (pn - 4));
        else tile<2>(acc, u, wr, wc, fr, fq, 1024 + 128 * (pn - 6));
    }
};

template <bool MOE> struct EpiSwiGLU {
    static constexpr bool PERM = true;
    bf16_t* ACT; int ldc; const float* RSx;
    __device__ __forceinline__ void operator()(acc_t& acc, const Unit& u, int wr, int wc, int fr, int fq, int tid) const {
#pragma unroll
        for (int ai = 0; ai < 2; ++ai)
#pragma unroll
            for (int m = 0; m < 4; ++m) {
                const int rl = ai * HALF + wr * 64 + m * 16 + fr;
                float rs; if (MOE) { const int mx = u.aux2 - 1; rs = RSx[u.pm + (rl < mx ? rl : mx)]; rs = rl < u.aux2 ? rs : 0.f; } else rs = rstd_from_rss(RSx, u.pm * BM + rl);
                const int orow = (MOE ? u.aux : u.pm) * BM + rl;
                bf16_t* AO = ACT;
                float o[8];
#pragma unroll
                for (int n = 0; n < 2; ++n)
#pragma unroll
                    for (int e = 0; e < 4; e += 2) { const f32x2 g = (f32x2){acc[ai][0][m][n][e], acc[ai][0][m][n][e + 1]} * rs, up = (f32x2){acc[ai][1][m][n][e], acc[ai][1][m][n][e + 1]} * rs;
                        const f32x2 r = silu_mul_pk(g, up); o[n * 4 + e] = r.x; o[n * 4 + e + 1] = r.y; }
                u32x4 w; w.x = cvt_pk_bf16(o[0], o[1]); w.y = cvt_pk_bf16(o[2], o[3]); w.z = cvt_pk_bf16(o[4], o[5]); w.w = cvt_pk_bf16(o[6], o[7]);
                __builtin_nontemporal_store(w, (u32x4*)(AO + (size_t)orow * ldc + 128 * u.pn + wc * 32 + 8 * fq));
            }
    }
};

template <bool BASE_F32> struct EpiResid {
    static constexpr bool PERM = true;
    const void* base; bf16_t* HB; float* RSS4; LAS float* T;
    __device__ __forceinline__ void operator()(acc_t& acc, const Unit& u, int wr, int wc, int fr, int fq, int tid) const {
        const int col0 = u.pn * BM + wc * 32 + 8 * fq;
        u32x4 bw[2][4][2];
        if (!BASE_F32) {
#pragma unroll
            for (int ai = 0; ai < 2; ++ai)
#pragma unroll
                for (int m = 0; m < 4; ++m)
#pragma unroll
                    for (int bj = 0; bj < 2; ++bj) bw[ai][m][bj] = *(const u32x4*)((const bf16_t*)base + (size_t)(u.pm * BM + ai * HALF + wr * 64 + m * 16 + fr) * DM + col0 + bj * HALF);
        }
#pragma unroll
        for (int ai = 0; ai < 2; ++ai)
#pragma unroll
            for (int m = 0; m < 4; ++m) {
                const int rl = ai * HALF + wr * 64 + m * 16 + fr; const size_t off = (size_t)(u.pm * BM + rl) * DM + col0; float ss = 0.f;
#pragma unroll
                for (int bj = 0; bj < 2; ++bj) {
                    f32x4 b0, b1;
                    if (BASE_F32) { b0 = *(const f32x4*)((const float*)base + off + bj * HALF); b1 = *(const f32x4*)((const float*)base + off + bj * HALF + 4); }
                    else { const u32x4 w = bw[ai][m][bj]; b0 = (f32x4){bf_lo(w.x), bf_hi(w.x), bf_lo(w.y), bf_hi(w.y)}; b1 = (f32x4){bf_lo(w.z), bf_hi(w.z), bf_lo(w.w), bf_hi(w.w)}; }
                    const f32x4 v0 = b0 + acc[ai][bj][m][0], v1 = b1 + acc[ai][bj][m][1];
                    const f32x4 q = v0 * v0 + v1 * v1; ss += (q[0] + q[1]) + (q[2] + q[3]);
                    u32x4 o; o.x = cvt_pk_bf16(v0[0], v0[1]); o.y = cvt_pk_bf16(v0[2], v0[3]); o.z = cvt_pk_bf16(v1[0], v1[1]); o.w = cvt_pk_bf16(v1[2], v1[3]);
                    *(u32x4*)(HB + off + bj * HALF) = o; }
                ss += __shfl_xor(ss, 16); ss += __shfl_xor(ss, 32);
                if (fq == 0) T[rl * 4 + wc] = ss;
            }
        EPI_BAR();
        if (tid < 256) { const f32x4 p = *(const LAS f32x4*)(T + tid * 4); RSS4[(size_t)(u.pm * BM + tid) * 4 + u.pn] = (p.x + p.y) + (p.z + p.w); }
    }
};

struct EpiSoftmax {
    static constexpr bool PERM = true;
    bf16_t* PB; const float* RSS4; LAS float* T;
    __device__ __forceinline__ void operator()(acc_t& acc, const Unit& u, int wr, int wc, int fr, int fq, int tid) const {
        LAS f32x2* T2 = (LAS f32x2*)T;
        float mw[2][4];
#pragma unroll
        for (int ai = 0; ai < 2; ++ai)
#pragma unroll
            for (int m = 0; m < 4; ++m) {
                const int rl = ai * HALF + wr * 64 + m * 16 + fr; const float rs = rstd_from_rss(RSS4, u.pm * BM + rl);
                float mx = -3.0e38f;
#pragma unroll
                for (int bj = 0; bj < 2; ++bj)
#pragma unroll
                    for (int n = 0; n < 2; ++n) { f32x4 v = acc[ai][bj][m][n] * rs; acc[ai][bj][m][n] = v; mx = fmaxf(fmaxf(mx, fmaxf(v[0], v[1])), fmaxf(v[2], v[3])); }
                mx = fmaxf(mx, __shfl_xor(mx, 16)); mx = fmaxf(mx, __shfl_xor(mx, 32));
                float l = 0.f;
#pragma unroll
                for (int bj = 0; bj < 2; ++bj)
#pragma unroll
                    for (int n = 0; n < 2; ++n) { f32x4 v = (acc[ai][bj][m][n] - mx) * 1.4426950408889634f; v[0] = __builtin_amdgcn_exp2f(v[0]); v[1] = __builtin_amdgcn_exp2f(v[1]); v[2] = __builtin_amdgcn_exp2f(v[2]); v[3] = __builtin_amdgcn_exp2f(v[3]); acc[ai][bj][m][n] = v; l += (v[0] + v[1]) + (v[2] + v[3]); }
                l += __shfl_xor(l, 16); l += __shfl_xor(l, 32);
                if (fq == 0) T2[rl * 4 + wc] = (f32x2){mx, l};
                mw[ai][m] = mx;
            }
        EPI_BAR();
#pragma unroll
        for (int ai = 0; ai < 2; ++ai)
#pragma unroll
            for (int m = 0; m < 4; ++m) {
                const int rl = ai * HALF + wr * 64 + m * 16 + fr;
                const f32x2 p0 = T2[rl * 4 + 0], p1 = T2[rl * 4 + 1], p2 = T2[rl * 4 + 2], p3 = T2[rl * 4 + 3];
                const float M = fmaxf(fmaxf(p0.x, p1.x), fmaxf(p2.x, p3.x));
                const float L = (p0.y * fast_exp(p0.x - M) + p1.y * fast_exp(p1.x - M)) + (p2.y * fast_exp(p2.x - M) + p3.y * fast_exp(p3.x - M));
                const float f = fast_exp(mw[ai][m] - M) / L;
                bf16_t* rowp = PB + (size_t)(u.pm * BM + rl) * DM + u.pn * BM + wc * 32 + 8 * fq;
#pragma unroll
                for (int bj = 0; bj < 2; ++bj) { const f32x4 v0 = acc[ai][bj][m][0] * f, v1 = acc[ai][bj][m][1] * f;
                    u32x4 w; w.x = cvt_pk_bf16(v0[0], v0[1]); w.y = cvt_pk_bf16(v0[2], v0[3]); w.z = cvt_pk_bf16(v1[0], v1[1]); w.w = cvt_pk_bf16(v1[2], v1[3]);
                    *(u32x4*)(rowp + bj * HALF) = w; }
            }
    }
};

struct EpiGeluUV {
    static constexpr bool PERM = true;
    bf16_t* UV; const float* RSS4; f32x2* VST; LAS float* T;
    __device__ __forceinline__ void operator()(acc_t& acc, const Unit& u, int wr, int wc, int fr, int fq, int tid) const {
        LAS f32x2* T2 = (LAS f32x2*)T;
#pragma unroll
        for (int ai = 0; ai < 2; ++ai)
#pragma unroll
            for (int m = 0; m < 4; ++m) {
                const int rl = ai * HALF + wr * 64 + m * 16 + fr; const float rs = rstd_from_rss(RSS4, u.pm * BM + rl);
                bf16_t* rowp = UV + (size_t)(u.pm * BM + rl) * 2048 + u.pn * BM + wc * 32 + 8 * fq; float s1 = 0.f, s2 = 0.f;
#pragma unroll
                for (int bj = 0; bj < 2; ++bj) { f32x4 v0 = acc[ai][bj][m][0] * rs, v1 = acc[ai][bj][m][1] * rs;
#pragma unroll
                    for (int e = 0; e < 4; e += 2) { const f32x2 a = gelu_tanh_pk((f32x2){v0[e], v0[e + 1]}), b = gelu_tanh_pk((f32x2){v1[e], v1[e + 1]}); v0[e] = a.x; v0[e + 1] = a.y; v1[e] = b.x; v1[e + 1] = b.y;
                        const f32x2 sm = a + b, sq = a * a + b * b; s1 += sm.x + sm.y; s2 += sq.x + sq.y; }
                    u32x4 w; w.x = cvt_pk_bf16(v0[0], v0[1]); w.y = cvt_pk_bf16(v0[2], v0[3]); w.z = cvt_pk_bf16(v1[0], v1[1]); w.w = cvt_pk_bf16(v1[2], v1[3]);
                    *(u32x4*)(rowp + bj * HALF) = w; }
                s1 += __shfl_xor(s1, 16); s1 += __shfl_xor(s1, 32); s2 += __shfl_xor(s2, 16); s2 += __shfl_xor(s2, 32);
                if (fq == 0) T2[rl * 4 + wc] = (f32x2){s1, s2};
            }
        EPI_BAR();
        if (u.pn >= 4 && tid < 256) { const f32x2 p0 = T2[tid * 4 + 0], p1 = T2[tid * 4 + 1], p2 = T2[tid * 4 + 2], p3 = T2[tid * 4 + 3];
            VST[(size_t)(u.pm * BM + tid) * 4 + (u.pn - 4)] = (f32x2){(p0.x + p1.x) + (p2.x + p3.x), (p0.y + p1.y) + (p2.y + p3.y)}; }
    }
};

__device__ __forceinline__ float clamp448(float x) { return fminf(fmaxf(x, -448.f), 448.f); }
__device__ __forceinline__ unsigned pk4_fp8(float a, float b, float c, float d) { unsigned w = 0u; w = __builtin_amdgcn_cvt_pk_fp8_f32(clamp448(a), clamp448(b), w, false); w = __builtin_amdgcn_cvt_pk_fp8_f32(clamp448(c), clamp448(d), w, true); return w; }
constexpr float W8_SCALE = 64.0f, W8_INV = 1.0f / 64.0f;

struct EpiSwiGLU8 {
    static constexpr bool PERM = true;
    unsigned char* ACT8;
    __device__ __forceinline__ void operator()(acc_t& acc, const Unit& u, int wr, int wc, int fr, int fq, int tid) const {
#pragma unroll
        for (int ai = 0; ai < 2; ++ai)
#pragma unroll
            for (int m = 0; m < 4; ++m) {
                const int rl = ai * HALF + wr * 64 + m * 16 + fr; float o[8];
#pragma unroll
                for (int n = 0; n < 2; ++n)
#pragma unroll
                    for (int e = 0; e < 4; e += 2) { const f32x2 g = (f32x2){acc[ai][0][m][n][e], acc[ai][0][m][n][e + 1]} * W8_INV, up = (f32x2){acc[ai][1][m][n][e], acc[ai][1][m][n][e + 1]} * W8_INV;
                        const f32x2 r = silu_mul_pk(g, up); o[n * 4 + e] = r.x; o[n * 4 + e + 1] = r.y; }
                u32x2 w; w.x = pk4_fp8(o[0], o[1], o[2], o[3]); w.y = pk4_fp8(o[4], o[5], o[6], o[7]);
                __builtin_nontemporal_store(w, (u32x2*)(ACT8 + (size_t)(u.aux * BM + rl) * DFF + 128 * u.pn + wc * 32 + 8 * fq));
            }
    }
};
struct EpiMoeDown8 {
    static constexpr bool PERM = true;
    bf16_t* Y; const float* SGW;
    __device__ __forceinline__ void operator()(acc_t& acc, const Unit& u, int wr, int wc, int fr, int fq, int tid) const {
        const int col0 = u.pn * BM + wc * 32 + 8 * fq;
#pragma unroll
        for (int ai = 0; ai < 2; ++ai)
#pragma unroll
            for (int m = 0; m < 4; ++m) {
                const int rl = ai * HALF + wr * 64 + m * 16 + fr, mx = u.aux2 - 1; const float gw = SGW[u.pm + (rl < mx ? rl : mx)] * W8_INV;
                bf16_t* rowp = Y + (size_t)(u.aux * BM + rl) * DM + col0;
#pragma unroll
                for (int bj = 0; bj < 2; ++bj) { const f32x4 v0 = acc[ai][bj][m][0] * gw, v1 = acc[ai][bj][m][1] * gw;
                    u32x4 o; o.x = cvt_pk_bf16(v0[0], v0[1]); o.y = cvt_pk_bf16(v0[2], v0[3]); o.z = cvt_pk_bf16(v1[0], v1[1]); o.w = cvt_pk_bf16(v1[2], v1[3]);
                    *(u32x4*)(rowp + bj * HALF) = o; }
            }
    }
};
#define XB_TMO      128
#define XB_XCNT(j)  (256  + 64 * (j))
#define XB_XSUB(j)  (1280 + 64 * (j))
#define XB_XGEN(j)  (2304 + 64 * (j))
#define XB_TOP      3328
#define XB_TOPGEN   3392
#define XCD_BAR_WORDS 3456
#define XB_SPIN_CAP (1u << 18)
__device__ __forceinline__ unsigned xb_ld(unsigned* p)              { return __hip_atomic_load(p, __ATOMIC_RELAXED, __HIP_MEMORY_SCOPE_AGENT); }
__device__ __forceinline__ unsigned xb_add(unsigned* p, unsigned v) { return __hip_atomic_fetch_add(p, v, __ATOMIC_RELAXED, __HIP_MEMORY_SCOPE_AGENT); }
__device__ __forceinline__ unsigned xb_xcc_id() { return (unsigned)__builtin_amdgcn_s_getreg((3 << 11) | 20) & 0xFu; }
#define XB_SPIN(cond, bar) do { unsigned _sp = 0; while (cond) { __builtin_amdgcn_s_sleep(1); \
    if ((++_sp & 255u) == 0u) { if (xb_ld(&(bar)[XB_TMO])) break; if (_sp > XB_SPIN_CAP) { atomicAdd(&(bar)[XB_TMO], 1u); break; } } } } while (0)
struct XcdBarrier { unsigned* bar; unsigned x; volatile LAS unsigned* st; };
__device__ __forceinline__ XcdBarrier xcd_barrier_post(unsigned* bar, volatile LAS unsigned* st) {
    XcdBarrier b; b.bar = bar; b.x = xb_xcc_id(); b.st = st;
    if (threadIdx.x == 0) (void)xb_add(&bar[XB_XCNT(b.x)], 1u);
    return b;
}
__device__ __forceinline__ void xcd_barrier_complete(unsigned* bar, unsigned x, unsigned& nloc, unsigned& nx) {
    const unsigned G = gridDim.x * gridDim.y * gridDim.z;
    unsigned sum, cnt, mine, sp = 0u;
    for (;;) {
        sum = 0u; cnt = 0u; mine = 0u;
#pragma unroll
        for (unsigned j = 0; j < 16; ++j) { const unsigned c = xb_ld(&bar[XB_XCNT(j)]); sum += c; cnt += (c > 0u) ? 1u : 0u; mine = (j == x) ? c : mine; }
        if (sum == G) break;
        __builtin_amdgcn_s_sleep(1);
        if ((++sp & 255u) == 0u) { if (xb_ld(&bar[XB_TMO])) break; if (sp > XB_SPIN_CAP) { atomicAdd(&bar[XB_TMO], 1u); break; } }
    }
    nloc = mine > 0u ? mine : 1u; nx = cnt > 0u ? cnt : 1u;
}
__device__ __forceinline__ void xcd_barrier(const XcdBarrier& b) {
    asm volatile("s_waitcnt vmcnt(0)" ::: "memory");
    __syncthreads();
    if (threadIdx.x == 0) {
        unsigned* bar = b.bar;
        __builtin_amdgcn_s_waitcnt(0);
        unsigned nloc = b.st[0], nx = b.st[1];
        if (nloc == 0u) { xcd_barrier_complete(bar, b.x, nloc, nx); b.st[0] = nloc; b.st[1] = nx; }
        const unsigned old = xb_add(&bar[XB_XSUB(b.x)], 1u);
        const unsigned gen = old / nloc;
        if (old + 1u == (gen + 1u) * nloc) {
            __builtin_amdgcn_fence(__ATOMIC_RELEASE, "agent");
            asm volatile("s_waitcnt vmcnt(0)" ::: "memory");
            const unsigned og = xb_add(&bar[XB_TOP], 1u);
            const unsigned tg = og / nx;
            if (og + 1u == (tg + 1u) * nx) xb_add(&bar[XB_TOPGEN], 1u);
            else XB_SPIN(xb_ld(&bar[XB_TOPGEN]) == tg, bar);
            __builtin_amdgcn_fence(__ATOMIC_ACQUIRE, "agent");
            xb_add(&bar[XB_XGEN(b.x)], 1u);
            asm volatile("s_waitcnt vmcnt(0)" ::: "memory");
        } else {
            XB_SPIN(xb_ld(&bar[XB_XGEN(b.x)]) == gen, bar);
            __builtin_amdgcn_fence(__ATOMIC_ACQUIRE, "agent");
            asm volatile("s_waitcnt vmcnt(0)" ::: "memory");
        }
    }
    __syncthreads();
}

struct Args { const float* in[31]; float* out; unsigned char* ws; int ph_lo, ph_hi; };
struct Frame { LAS unsigned char* lds; int tid, lane, wave, G, bx; float* H; unsigned char* ws; };
__device__ __forceinline__ const float* karg_in(int k) { typedef const float* __attribute__((address_space(4))) const* kp_t; return ((kp_t)__builtin_amdgcn_kernarg_segment_ptr())[k]; }

__device__ __forceinline__ void transpose_item(const float* W, int ldw, int k0, int n0, bf16_t* WT, int K, int dst_row0, const float* gk, LAS float* scr, int lane) {
    float tv[64];
#pragma unroll
    for (int i = 0; i < 64; ++i) tv[i] = W[(size_t)(k0 + i) * ldw + n0 + lane];
#pragma unroll
    for (int i = 0; i < 64; ++i) { const float g = gk ? gk[k0 + i] : 1.0f; scr[i * 64 + (lane ^ (((i >> 3) & 7) << 3))] = tv[i] * g; }
    LDS_WAIT(); asm volatile("" ::: "memory");
    const int c = lane & 7;
#pragma unroll
    for (int j = 0; j < 8; ++j) { const int n = (lane >> 3) + 8 * j; const LAS float* s = scr + (8 * c) * 64 + (n ^ (c << 3));
        u32x4 o; o.x = cvt_pk_bf16(s[0 * 64], s[1 * 64]); o.y = cvt_pk_bf16(s[2 * 64], s[3 * 64]); o.z = cvt_pk_bf16(s[4 * 64], s[5 * 64]); o.w = cvt_pk_bf16(s[6 * 64], s[7 * 64]);
        *(u32x4*)(WT + (size_t)(dst_row0 + n) * K + k0 + 8 * c) = o; }
    LDS_WAIT(); asm volatile("" ::: "memory");
}
__device__ __forceinline__ void transpose_item_fp8(const float* W, int ldw, int k0, int n0, unsigned char* WT8, int K, int dst_row0, const float* gk, float scale, LAS float* scr, int lane) {
    float tv[64];
#pragma unroll
    for (int i = 0; i < 64; ++i) tv[i] = W[(size_t)(k0 + i) * ldw + n0 + lane];
#pragma unroll
    for (int i = 0; i < 64; ++i) { const float g = (gk ? gk[k0 + i] : 1.0f) * scale; scr[i * 64 + (lane ^ (((i >> 3) & 7) << 3))] = tv[i] * g; }
    LDS_WAIT(); asm volatile("" ::: "memory");
    const int c = lane & 3;
#pragma unroll
    for (int j = 0; j < 4; ++j) { const int n = (lane >> 2) + 16 * j; float v[16];
#pragma unroll
        for (int e = 0; e < 16; ++e) v[e] = scr[(16 * c + e) * 64 + (n ^ (((2 * c + (e >> 3)) & 7) << 3))];
        u32x4 o; o.x = pk4_fp8(v[0], v[1], v[2], v[3]); o.y = pk4_fp8(v[4], v[5], v[6], v[7]); o.z = pk4_fp8(v[8], v[9], v[10], v[11]); o.w = pk4_fp8(v[12], v[13], v[14], v[15]);
        *(u32x4*)(WT8 + (size_t)(dst_row0 + n) * K + k0 + 16 * c) = o; }
    LDS_WAIT(); asm volatile("" ::: "memory");
}
__device__ __forceinline__ int glu5_map(int n0) {
    if (n0 < 512) return 256 * (n0 >> 7) + (n0 & 127);
    if (n0 < 1024) { const int c = n0 - 512; return 256 * (c >> 7) + 128 + (c & 127); }
    if (n0 < 1536) return n0;
    if (n0 < 2048) { const int c = n0 - 1536; return 1536 + 256 * (c >> 7) + (c & 127); }
    const int c = n0 - 2048; return 1536 + 256 * (c >> 7) + 128 + (c & 127);
}
__device__ __forceinline__ int gu_map(int n0, int up) { return 256 * (n0 >> 7) + 128 * up + (n0 & 127); }

template <int MAP  >
__device__ __forceinline__ void conv_matrix(const float* W, int ldw, int nkb, int nnb, bf16_t* WT, int K, int up, const float* gk, int item0, int gw, int NGW, LAS float* scr, int lane) {
    const int n = nkb * nnb; int first = (gw - item0) % NGW; if (first < 0) first += NGW;
    for (int r = first; r < n; r += NGW) { const int kb = r / nnb, nb = r % nnb;
        const int dst = MAP == 0 ? 64 * nb : (MAP == 1 ? glu5_map(64 * nb) : gu_map(64 * nb, up));
        transpose_item(W, ldw, 64 * kb, 64 * nb, WT, K, dst, gk, scr, lane); }
}
template <int MAP>
__device__ __forceinline__ void conv_matrix8(const float* W, int ldw, int nkb, int nnb, unsigned char* WT8, int K, int up, const float* gk, float scale, int item0, int gw, int NGW, LAS float* scr, int lane) {
    const int n = nkb * nnb; int first = (gw - item0) % NGW; if (first < 0) first += NGW;
    for (int r = first; r < n; r += NGW) { const int kb = r / nnb, nb = r % nnb;
        const int dst = MAP == 0 ? 64 * nb : gu_map(64 * nb, up);
        transpose_item_fp8(W, ldw, 64 * kb, 64 * nb, WT8, K, dst, gk, scale, scr, lane); }
}
#ifdef FK_TPROBE
#define P0_TP_BEGIN(k) do { if ((k) == FK_TPROBE && blockIdx.x == 0 && threadIdx.x == 0) *(volatile unsigned long long*)(F.ws + 32768) = __builtin_amdgcn_s_memrealtime(); } while (0)
#define P0_TP_END(k) do { if ((k) == FK_TPROBE && blockIdx.x == 0 && threadIdx.x == 0) *(volatile unsigned long long*)(F.ws + 32776) = __builtin_amdgcn_s_memrealtime() - *(volatile unsigned long long*)(F.ws + 32768); } while (0)
#else
#define P0_TP_BEGIN(k) do { } while (0)
#define P0_TP_END(k) do { } while (0)
#endif
__device__ __forceinline__ void p0_prologue(Frame& F) {
    LAS float* scr = (LAS float*)(F.lds + RING_OFF + F.wave * 16384);
    const int gw = F.bx * 8 + F.wave, NGW = F.G * 8, lane = F.lane;
    unsigned char* ws = F.ws;
    constexpr int I_SQ = 256, I_WIN = 16 * 40, I_GU = 16 * 44, I_DN = 44 * 16, I_SG = 16 * 32;
    int o = 0;
    conv_matrix<1>(karg_in(11), 2560, 16, 40, (bf16_t*)(ws + WS_WIN0), 1024, 0, karg_in(2), o, gw, NGW, scr, lane); o += I_WIN;
    conv_matrix<0>(karg_in(17), 1024, 16, 16, (bf16_t*)(ws + WS_WOUT0), 1024, 0, nullptr, o, gw, NGW, scr, lane); o += I_SQ;
    conv_matrix<2>(karg_in(18), 2816, 16, 44, (bf16_t*)(ws + WS_WGU0), 1024, 0, karg_in(5), o, gw, NGW, scr, lane); o += I_GU;
    conv_matrix<2>(karg_in(19), 2816, 16, 44, (bf16_t*)(ws + WS_WGU0), 1024, 1, karg_in(5), o, gw, NGW, scr, lane); o += I_GU;
    conv_matrix<0>(karg_in(20), 1024, 44, 16, (bf16_t*)(ws + WS_WD0), 2816, 0, nullptr, o, gw, NGW, scr, lane); o += I_DN;
    for (int l = 0; l < 2; ++l) {
        conv_matrix<0>(karg_in(10) + (size_t)l * DM * DM, 1024, 16, 16, (bf16_t*)(ws + WS_WOT) + (size_t)l * DM * DM, 1024, 0, nullptr, o, gw, NGW, scr, lane); o += I_SQ;
        conv_matrix<0>(karg_in(8) + (size_t)l * DM * DM, 1024, 16, 16, (bf16_t*)(ws + WS_WKT) + (size_t)l * DM * DM, 1024, 0, nullptr, o, gw, NGW, scr, lane); o += I_SQ;
        conv_matrix<0>(karg_in(9) + (size_t)l * DM * DM, 1024, 16, 16, (bf16_t*)(ws + WS_WKT) + (size_t)(2 + l) * DM * DM, 1024, 0, nullptr, o, gw, NGW, scr, lane); o += I_SQ;
    }
    conv_matrix<0>(karg_in(21), 2048, 16, 32, (bf16_t*)(ws + WS_WSG), 1024, 0, karg_in(2) + DM, o, gw, NGW, scr, lane); o += I_SG;
    conv_matrix<0>(karg_in(26), 1024, 16, 16, (bf16_t*)(ws + WS_WSO), 1024, 0, nullptr, o, gw, NGW, scr, lane); o += I_SQ;
    for (int e = 0; e < NEXP; ++e) {
        conv_matrix8<2>(karg_in(28) + (size_t)e * DM * DFF, 2816, 16, 44, (unsigned char*)(ws + WS_WGU1) + (size_t)e * 5632 * DM, 1024, 0, karg_in(5) + DM, W8_SCALE, o, gw, NGW, scr, lane); o += I_GU;
        conv_matrix8<2>(karg_in(29) + (size_t)e * DM * DFF, 2816, 16, 44, (unsigned char*)(ws + WS_WGU1) + (size_t)e * 5632 * DM, 1024, 1, karg_in(5) + DM, W8_SCALE, o, gw, NGW, scr, lane); o += I_GU;
        conv_matrix8<0>(karg_in(30) + (size_t)e * DFF * DM, 1024, 44, 16, (unsigned char*)(ws + WS_WD1) + (size_t)e * DM * DFF, 2816, 0, nullptr, W8_SCALE, o, gw, NGW, scr, lane); o += I_DN;
    }
    for (int r = gw; r < 2 * DM; r += NGW) { const int l = r >> 10, k = r & 1023; const float g = karg_in(3)[l * DM + k] * 0.0625f;
        const f32x4* src = (const f32x4*)(karg_in(7) + (size_t)r * DM) + lane; u32x2* dst = (u32x2*)((bf16_t*)(ws + WS_WQS) + (size_t)r * DM) + lane;
#pragma unroll
        for (int j = 0; j < 4; ++j) { const f32x4 v = src[64 * j] * g; u32x2 w; w.x = cvt_pk_bf16(v[0], v[1]); w.y = cvt_pk_bf16(v[2], v[3]); dst[64 * j] = w; } }
    for (int r = gw; r < 2 * 4 * MEML; r += NGW) { const int l = r >> 10, mr = r & 1023;
        const f32x4* src = (const f32x4*)(karg_in(1) + (size_t)mr * DM) + lane; const f32x4* gg = (const f32x4*)(karg_in(4) + l * DM) + lane;
        u32x2* dst = (u32x2*)((bf16_t*)(ws + WS_MEMN) + (size_t)r * DM) + lane; f32x4 v[4]; float s = 0.f;
#pragma unroll
        for (int j = 0; j < 4; ++j) { v[j] = src[64 * j]; s += (v[j][0] * v[j][0] + v[j][1] * v[j][1]) + (v[j][2] * v[j][2] + v[j][3] * v[j][3]); }
        const float rs = rsqrtf(wave_sum(s) * (1.0f / DM) + 1e-6f);
#pragma unroll
        for (int j = 0; j < 4; ++j) { const f32x4 o = v[j] * rs * gg[64 * j]; u32x2 w; w.x = cvt_pk_bf16(o[0], o[1]); w.y = cvt_pk_bf16(o[2], o[3]); dst[64 * j] = w; } }
    for (int r = gw; r < NTOK; r += NGW) {
        const f32x4* src = (const f32x4*)(karg_in(0) + (size_t)r * DM) + lane; u32x2* dst = (u32x2*)((bf16_t*)(ws + WS_HB) + (size_t)r * DM) + lane; f32x4 v[4]; float s = 0.f;
#pragma unroll
        for (int j = 0; j < 4; ++j) { v[j] = src[64 * j]; s += (v[j][0] * v[j][0] + v[j][1] * v[j][1]) + (v[j][2] * v[j][2] + v[j][3] * v[j][3]); }
        s = wave_sum(s);
#pragma unroll
        for (int j = 0; j < 4; ++j) { u32x2 w; w.x = cvt_pk_bf16(v[j][0], v[j][1]); w.y = cvt_pk_bf16(v[j][2], v[j][3]); dst[64 * j] = w; }
        if (lane == 0) *(f32x4*)((float*)(ws + WS_RSS) + (size_t)r * 4) = (f32x4){s, 0.f, 0.f, 0.f}; }
}

struct KvOrder {
    const char* memn; const char* wkt; int G, c;
    __device__ __forceinline__ bool next(int i, Unit& u) const { const int L = i * G + c; if (L >= 64) return false;
        const int which = L >> 4, t = L & 15, l = which & 1; u.pm = t >> 2; u.pn = t & 3; u.aux = which;
        u.A = memn + ((size_t)l * DM * DM + (size_t)u.pm * BM * DM) * 2; u.B = wkt + ((size_t)which * DM * DM + (size_t)u.pn * BM * DM) * 2; return true; }
};
struct MkVwOrder {
    const char* kp; const char* wqs; const char* wot; int G, c;
    __device__ __forceinline__ bool next(int i, Unit& u) const { const int L = i * G + c; if (L >= 256) return false;
        const int vw = L >> 7, q = L & 127, l = q >> 6, b = (q >> 4) & 3, hd = (q >> 2) & 3, t = q & 3;
        if (!vw) { u.pm = hd; u.pn = t; u.aux = l * 4 + b;
            u.A = kp + ((size_t)l * DM * DM + (size_t)(b * MEML) * DM + hd * 256) * 2; u.B = wqs + ((size_t)l * DM * DM + (size_t)(t * BM) * DM + hd * 256) * 2; }
        else { u.pm = t; u.pn = hd; u.aux = 8 + l * 4 + b;
            u.A = wot + ((size_t)l * DM * DM + (size_t)(t * BM) * DM + hd * 256) * 2; u.B = kp + ((size_t)(2 + l) * DM * DM + (size_t)(b * MEML) * DM + hd * 256) * 2; }
        return true; }
};

__device__ __forceinline__ void conv_phase(Frame& F) {
    const int tid = F.tid, half = tid >> 8, t2 = tid & 255, c0 = 2 * t2, wih = (tid >> 6) & 3, lane = F.lane;
    const bf16_t* ZB = (const bf16_t*)(F.ws + WS_ZB); bf16_t* MIX = (bf16_t*)(F.ws + WS_MIX);
    LAS float* RED = (LAS float*)(F.lds + RING_OFF);
    f32x2 wa[31], wb[3];
#pragma unroll
    for (int k = 0; k < 31; ++k) wa[k] = *(const f32x2*)(karg_in(12) + k * 512 + c0);
#pragma unroll
    for (int k = 0; k < 3; ++k) wb[k] = *(const f32x2*)(karg_in(16) + k * 512 + c0);
    const f32x2 bias = *(const f32x2*)(karg_in(13) + c0), lg = *(const f32x2*)(karg_in(14) + c0), lb = *(const f32x2*)(karg_in(15) + c0);
    unsigned xin[38], gb[8], gh[10];
#define CONV_LOAD(it_) do { const int blk_ = (F.bx * 8 + (it_)) * 2 + half, tk_ = blk_ * 8, tp_ = tk_ & (SEQL - 1); \
        _Pragma("unroll") for (int j = 0; j < 38; ++j) { const int pos = tp_ - 30 + j; xin[j] = (pos >= 0) ? *(const unsigned*)(ZB + (size_t)(tk_ - 30 + j) * ZW + c0) : 0u; } \
        _Pragma("unroll") for (int j = 0; j < 8; ++j) gb[j] = *(const unsigned*)(ZB + (size_t)(tk_ + j) * ZW + 512 + c0); \
        _Pragma("unroll") for (int j = 0; j < 10; ++j) { const int pos = tp_ - 2 + j; gh[j] = (pos >= 0) ? *(const unsigned*)(ZB + (size_t)(tk_ - 2 + j) * ZW + 1024 + c0) : 0u; } } while (0)
    CONV_LOAD(0);
    for (int it = 0; it < 8; ++it) {
        const int blk = (F.bx * 8 + it) * 2 + half, tok0 = blk * 8;
        f32x2 a[8], bo[8];
#pragma unroll
        for (int o = 0; o < 8; ++o) a[o] = bias;
#pragma unroll
        for (int j = 0; j < 38; ++j) { const f32x2 x = (f32x2){bf_lo(xin[j]), bf_hi(xin[j])};
#pragma unroll
            for (int o = 0; o < 8; ++o) { const int k = j - o; if (k >= 0 && k < 31) a[o] = __builtin_elementwise_fma(wa[k], x, a[o]); } }
#pragma unroll
        for (int o = 0; o < 8; ++o) { f32x2 b = (f32x2){0.f, 0.f};
#pragma unroll
            for (int k = 0; k < 3; ++k) b = __builtin_elementwise_fma(wb[k], (f32x2){bf_lo(gh[o + k]), bf_hi(gh[o + k])}, b);
            bo[o] = b * (f32x2){bf_lo(gb[o]), bf_hi(gb[o])}; }
        if (it < 7) CONV_LOAD(it + 1);
        {
          float v16[16];
#pragma unroll
          for (int o = 0; o < 8; ++o) { const f32x2 sq = a[o] * a[o]; v16[2 * o] = a[o].x + a[o].y; v16[2 * o + 1] = sq.x + sq.y; }
          float v8[8], v4[4], v2[2], v1;
#pragma unroll
          for (int i = 0; i < 8; ++i) { const float keep = (lane & 32) ? v16[i + 8] : v16[i], send = (lane & 32) ? v16[i] : v16[i + 8]; v8[i] = keep + __shfl_xor(send, 32); }
#pragma unroll
          for (int i = 0; i < 4; ++i) { const float keep = (lane & 16) ? v8[i + 4] : v8[i], send = (lane & 16) ? v8[i] : v8[i + 4]; v4[i] = keep + __shfl_xor(send, 16); }
#pragma unroll
          for (int i = 0; i < 2; ++i) { const float keep = (lane & 8) ? v4[i + 2] : v4[i], send = (lane & 8) ? v4[i] : v4[i + 2]; v2[i] = keep + __shfl_xor(send, 8); }
          { const float keep = (lane & 4) ? v2[1] : v2[0], send = (lane & 4) ? v2[0] : v2[1]; v1 = keep + __shfl_xor(send, 4); }
          v1 += __shfl_xor(v1, 2); v1 += __shfl_xor(v1, 1);
          if ((lane & 3) == 0) RED[(half * 4 + wih) * 16 + ((lane >> 2) & 15)] = v1; }
        LDS_WAIT(); __syncthreads();
#pragma unroll
        for (int o = 0; o < 8; ++o) { float s1 = 0.f, s2 = 0.f;
#pragma unroll
            for (int w = 0; w < 4; ++w) { s1 += RED[((half * 4 + w) * 8 + o) * 2 + 0]; s2 += RED[((half * 4 + w) * 8 + o) * 2 + 1]; }
            const float mu = s1 * (1.0f / 512.f), var = s2 * (1.0f / 512.f) - mu * mu, rstd = rsqrtf(fmaxf(var, 0.f) + 1e-5f);
            const f32x2 y = (a[o] - mu) * rstd * lg + lb;
            *(unsigned*)(MIX + (size_t)(tok0 + o) * DM + c0) = cvt_pk_bf16(y.x * fast_sigmoid(y.x), y.y * fast_sigmoid(y.y));
            *(unsigned*)(MIX + (size_t)(tok0 + o) * DM + 512 + c0) = cvt_pk_bf16(bo[o].x, bo[o].y); }
        LDS_WAIT(); __syncthreads();
    }
#undef CONV_LOAD
}

__device__ __forceinline__ void spatial_phase(Frame& F) {
    const int tid = F.tid, lane = F.lane, wv = F.wave, fr = lane & 15, fq = lane >> 4, g = F.bx & 7;
    constexpr int RS = 272;
    LAS unsigned char* WL = F.lds + RING_OFF;
    LAS unsigned char* VT = F.lds + RING_OFF + 128 * RS;
    const bf16_t* UV = (const bf16_t*)(F.ws + WS_UV); bf16_t* US = (bf16_t*)(F.ws + WS_US); const f32x4* VST = (const f32x4*)(F.ws + WS_VST);
    { const int i = tid >> 2, jq = (tid & 3) * 32; const float* src = karg_in(24) + ((size_t)g * 128 + i) * 128 + jq;
#pragma unroll
        for (int q = 0; q < 4; ++q) { const f32x4 a = *(const f32x4*)(src + 8 * q), b = *(const f32x4*)(src + 8 * q + 4); const bool ok = ((jq + 8 * q) >> 6) <= (i >> 6);
            u32x4 w; w.x = cvt_pk_bf16(a[0], a[1]); w.y = cvt_pk_bf16(a[2], a[3]); w.z = cvt_pk_bf16(b[0], b[1]); w.w = cvt_pk_bf16(b[2], b[3]);
            if (!ok) w = (u32x4){0u, 0u, 0u, 0u}; *(LAS u32x4*)(WL + i * RS + (jq + 8 * q) * 2) = w; } }
    const int j = tid >> 2, cq = (tid & 3) * 8;
    f32x4 lgv[8], lbv[8];
#pragma unroll
    for (int q = 0; q < 8; ++q) { lgv[q] = *(const f32x4*)(karg_in(22) + g * 128 + cq + 32 * (q >> 1) + 4 * (q & 1)); lbv[q] = *(const f32x4*)(karg_in(23) + g * 128 + cq + 32 * (q >> 1) + 4 * (q & 1)); }
    u32x4 vw[4]; f32x4 st0, st1;
#define SP_LOADV(r_) do { const size_t tk_ = (size_t)((F.bx >> 3) + 32 * (r_)) * 128 + j; st0 = VST[tk_ * 2]; st1 = VST[tk_ * 2 + 1]; const bf16_t* vr_ = UV + tk_ * 2048 + 1024 + g * 128 + cq; \
        _Pragma("unroll") for (int q = 0; q < 4; ++q) vw[q] = *(const u32x4*)(vr_ + 32 * q); } while (0)
#define SP_NORM(vb) do { LAS unsigned char* VTw = VT + (vb) * (128 * RS); \
        const float s1 = (st0[0] + st0[2]) + (st1[0] + st1[2]), s2 = (st0[1] + st0[3]) + (st1[1] + st1[3]); \
        const float mu = s1 * (1.0f / 1024.f), var = s2 * (1.0f / 1024.f) - mu * mu, rstd = rsqrtf(fmaxf(var, 0.f) + 1e-5f); \
        _Pragma("unroll") for (int q = 0; q < 4; ++q) { const u32x4 w = vw[q]; \
            const float v[8] = {bf_lo(w.x), bf_hi(w.x), bf_lo(w.y), bf_hi(w.y), bf_lo(w.z), bf_hi(w.z), bf_lo(w.w), bf_hi(w.w)}; \
            const float gg[8] = {lgv[2 * q][0], lgv[2 * q][1], lgv[2 * q][2], lgv[2 * q][3], lgv[2 * q + 1][0], lgv[2 * q + 1][1], lgv[2 * q + 1][2], lgv[2 * q + 1][3]}; \
            const float bbv[8] = {lbv[2 * q][0], lbv[2 * q][1], lbv[2 * q][2], lbv[2 * q][3], lbv[2 * q + 1][0], lbv[2 * q + 1][1], lbv[2 * q + 1][2], lbv[2 * q + 1][3]}; \
            _Pragma("unroll") for (int e = 0; e < 8; e += 2) { const unsigned pk = cvt_pk_bf16((v[e] - mu) * rstd * gg[e] + bbv[e], (v[e + 1] - mu) * rstd * gg[e + 1] + bbv[e + 1]); \
                *(LAS unsigned short*)(VTw + (cq + 32 * q + e) * RS + j * 2) = (unsigned short)(pk & 0xffffu); \
                *(LAS unsigned short*)(VTw + (cq + 32 * q + e + 1) * RS + j * 2) = (unsigned short)(pk >> 16); } } } while (0)
    SP_LOADV(0); SP_NORM(0);
    LDS_WAIT(); __syncthreads();
    for (int r = 0; r < 8; ++r) {
        const int nb = (F.bx >> 3) + 32 * r; const LAS unsigned char* VTr = VT + (r & 1) * (128 * RS);
        u32x4 uu[4];
#pragma unroll
        for (int b = 0; b < 4; ++b) { const size_t tok = (size_t)nb * 128 + (4 * (wv >> 2) + b) * 16 + fr; uu[b] = *(const u32x4*)(UV + tok * 2048 + g * 128 + 32 * (wv & 3) + 8 * fq); }
        if (r < 7) SP_LOADV(r + 1);
        f32x4 acc[2][4];
#pragma unroll
        for (int a = 0; a < 2; ++a)
#pragma unroll
            for (int b = 0; b < 4; ++b) acc[a][b] = (f32x4){0.f, 0.f, 0.f, 0.f};
#pragma unroll
        for (int ks = 0; ks < 4; ++ks) {
            bf16x8 xf[2], yf[4];
#pragma unroll
            for (int a = 0; a < 2; ++a) xf[a] = *(const LAS bf16x8*)(VTr + (32 * (wv & 3) + 8 * (fr >> 2) + 4 * a + (fr & 3)) * RS + (ks * 32 + fq * 8) * 2);
#pragma unroll
            for (int b = 0; b < 4; ++b) yf[b] = *(const LAS bf16x8*)(WL + ((4 * (wv >> 2) + b) * 16 + fr) * RS + (ks * 32 + fq * 8) * 2);
#pragma unroll
            for (int a = 0; a < 2; ++a)
#pragma unroll
                for (int b = 0; b < 4; ++b) acc[a][b] = __builtin_amdgcn_mfma_f32_16x16x32_bf16(xf[a], yf[b], acc[a][b], 0, 0, 0);
        }
        if (r < 7) SP_NORM((r + 1) & 1);
#pragma unroll
        for (int b = 0; b < 4; ++b) { const int i = (4 * (wv >> 2) + b) * 16 + fr; const size_t tok = (size_t)nb * 128 + i; const float bs = karg_in(25)[g * 128 + i]; const u32x4 u4 = uu[b];
            u32x4 o; o.x = cvt_pk_bf16(bf_lo(u4.x) * (acc[0][b][0] + bs), bf_hi(u4.x) * (acc[0][b][1] + bs)); o.y = cvt_pk_bf16(bf_lo(u4.y) * (acc[0][b][2] + bs), bf_hi(u4.y) * (acc[0][b][3] + bs));
            o.z = cvt_pk_bf16(bf_lo(u4.z) * (acc[1][b][0] + bs), bf_hi(u4.z) * (acc[1][b][1] + bs)); o.w = cvt_pk_bf16(bf_lo(u4.w) * (acc[1][b][2] + bs), bf_hi(u4.w) * (acc[1][b][3] + bs));
            *(u32x4*)(US + tok * DM + g * 128 + 32 * (wv & 3) + 8 * fq) = o; }
        LDS_WAIT(); __syncthreads();
    }
#undef SP_NORM
#undef SP_LOADV
}

__device__ __forceinline__ void router_phase(Frame& F) {
    const int lane = F.lane, wv = F.wave, tid = F.tid;
    LAS int* CL = (LAS int*)(F.lds + RSCR_OFF); LAS int* BASE = CL + 16; LAS unsigned* TE = (LAS unsigned*)(CL + 32);
    LAS int* TR1 = (LAS int*)(TE + 128); LAS int* TR2 = TR1 + 128; LAS float* TW1 = (LAS float*)(TR2 + 128); LAS float* TW2 = TW1 + 128; LAS float* TRS = TW2 + 128;
    if (tid < 16) CL[tid] = 0;
    float wr[16][8];
#pragma unroll
    for (int j = 0; j < 2; ++j)
#pragma unroll
        for (int e8 = 0; e8 < 8; ++e8) { const int k = 8 * lane + 512 * j + e8; const float g = karg_in(5)[DM + k]; const f32x4 a = *(const f32x4*)(karg_in(27) + k * 8), b = *(const f32x4*)(karg_in(27) + k * 8 + 4);
            wr[j * 8 + e8][0] = a[0] * g; wr[j * 8 + e8][1] = a[1] * g; wr[j * 8 + e8][2] = a[2] * g; wr[j * 8 + e8][3] = a[3] * g; wr[j * 8 + e8][4] = b[0] * g; wr[j * 8 + e8][5] = b[1] * g; wr[j * 8 + e8][6] = b[2] * g; wr[j * 8 + e8][7] = b[3] * g; }
    __syncthreads();
    const bf16_t* HBr = (const bf16_t*)(F.ws + WS_HB);
    u32x4 hw[2]; { const u32x4* hr = (const u32x4*)(HBr + (size_t)(F.bx * 128 + wv * 16) * DM) + lane; hw[0] = hr[0]; hw[1] = hr[64]; }
#pragma unroll 2
    for (int q = 0; q < 16; ++q) {
        const int il = wv * 16 + q, t = F.bx * 128 + il;
        const u32x4 w0 = hw[0], w1v = hw[1];
        if (q < 15) { const u32x4* hr = (const u32x4*)(HBr + (size_t)(t + 1) * DM) + lane; hw[0] = hr[0]; hw[1] = hr[64]; }
        float lg[8];
#pragma unroll
        for (int e = 0; e < 8; ++e) lg[e] = 0.f;
#pragma unroll
        for (int j = 0; j < 2; ++j) { const u32x4 w = j ? w1v : w0; const float x[8] = {bf_lo(w.x), bf_hi(w.x), bf_lo(w.y), bf_hi(w.y), bf_lo(w.z), bf_hi(w.z), bf_lo(w.w), bf_hi(w.w)};
#pragma unroll
            for (int e8 = 0; e8 < 8; ++e8)
#pragma unroll
                for (int e = 0; e < 8; ++e) lg[e] += x[e8] * wr[j * 8 + e8][e]; }
        const float rs = rstd_from_rss((const float*)(F.ws + WS_RSS), t);
        { u32x2 q0, q1;
          q0.x = pk4_fp8(bf_lo(w0.x) * rs, bf_hi(w0.x) * rs, bf_lo(w0.y) * rs, bf_hi(w0.y) * rs); q0.y = pk4_fp8(bf_lo(w0.z) * rs, bf_hi(w0.z) * rs, bf_lo(w0.w) * rs, bf_hi(w0.w) * rs);
          q1.x = pk4_fp8(bf_lo(w1v.x) * rs, bf_hi(w1v.x) * rs, bf_lo(w1v.y) * rs, bf_hi(w1v.y) * rs); q1.y = pk4_fp8(bf_lo(w1v.z) * rs, bf_hi(w1v.z) * rs, bf_lo(w1v.w) * rs, bf_hi(w1v.w) * rs);
          u32x2* h8 = (u32x2*)(F.ws + WS_HB8 + (size_t)t * DM) + lane; h8[0] = q0; h8[64] = q1; }
        { float k4[4], k2[2], k1;
#pragma unroll
          for (int i = 0; i < 4; ++i) { const float keep = (lane & 32) ? lg[i + 4] : lg[i], send = (lane & 32) ? lg[i] : lg[i + 4]; k4[i] = keep + __shfl_xor(send, 32); }
#pragma unroll
          for (int i = 0; i < 2; ++i) { const float keep = (lane & 16) ? k4[i + 2] : k4[i], send = (lane & 16) ? k4[i] : k4[i + 2]; k2[i] = keep + __shfl_xor(send, 16); }
          { const float keep = (lane & 8) ? k2[1] : k2[0], send = (lane & 8) ? k2[0] : k2[1]; k1 = keep + __shfl_xor(send, 8); }
          k1 += __shfl_xor(k1, 4); k1 += __shfl_xor(k1, 2); k1 += __shfl_xor(k1, 1);
#pragma unroll
          for (int e = 0; e < 8; ++e) lg[e] = __int_as_float(__builtin_amdgcn_readlane(__float_as_int(k1), 8 * e)) * rs; }
        int i1 = 0; float v1 = lg[0];
#pragma unroll
        for (int e = 1; e < 8; ++e) if (lg[e] > v1) { v1 = lg[e]; i1 = e; }
        int i2 = 0; float v2 = -3.0e38f;
#pragma unroll
        for (int e = 0; e < 8; ++e) if (e != i1 && lg[e] > v2) { v2 = lg[e]; i2 = e; }
        const float e2 = __expf(v2 - v1), w1 = 1.0f / (1.0f + e2), w2 = e2 / (1.0f + e2);
        if (lane == 0) { TE[il] = (unsigned)i1 | ((unsigned)i2 << 8); TW1[il] = w1; TW2[il] = w2;
            TR1[il] = __hip_atomic_fetch_add(&CL[i1], 1, __ATOMIC_RELAXED, __HIP_MEMORY_SCOPE_WORKGROUP); TR2[il] = __hip_atomic_fetch_add(&CL[8 + i2], 1, __ATOMIC_RELAXED, __HIP_MEMORY_SCOPE_WORKGROUP); }
    }
    LDS_WAIT(); __syncthreads();
    if (tid < 16) BASE[tid] = (int)__hip_atomic_fetch_add((unsigned*)(F.ws + WS_CTL) + CW_SEG + 16 * tid, (unsigned)CL[tid], __ATOMIC_RELAXED, __HIP_MEMORY_SCOPE_AGENT);
    LDS_WAIT(); __syncthreads();
    if (tid < 128) { const unsigned te = TE[tid]; const int e1 = (int)(te & 0xffu), e2 = (int)(te >> 8), t = F.bx * 128 + tid;
        const int s1 = e1 * SEGCAP + BASE[e1] + TR1[tid], s2 = (8 + e2) * SEGCAP + BASE[8 + e2] + TR2[tid];
        int* STOK = (int*)(F.ws + WS_STOK); float* SGW = (float*)(F.ws + WS_SGW);
        STOK[s1] = t; SGW[s1] = TW1[tid]; STOK[s2] = t; SGW[s2] = TW2[tid]; ((int*)(F.ws + WS_TSL))[2 * t] = s1; ((int*)(F.ws + WS_TSL))[2 * t + 1] = s2; }
}
__device__ __forceinline__ void moe_tables(Frame& F) {
    LAS int* MT = (LAS int*)(F.lds + MT_OFF); LAS int* CN = MT + 32;
    if (F.tid < 16) CN[F.tid] = (int)__hip_atomic_load((unsigned*)(F.ws + WS_CTL) + CW_SEG + 16 * F.tid, __ATOMIC_RELAXED, __HIP_MEMORY_SCOPE_AGENT);
    LDS_WAIT(); __syncthreads();
    if (F.tid == 0) { int a = 0; for (int s = 0; s < 16; ++s) { MT[s] = a; a += (CN[s] + 255) >> 8; } MT[16] = a; }
    LDS_WAIT(); __syncthreads();
}
#ifndef FK_MOE_WGM
#define FK_MOE_WGM 8
#endif
struct MoeOrder {
    const char* A; const char* W; size_t wstride; int lda_b, ldb_b, nN, G, c; const LAS int* MT; int gather_a; const int* stok; int rev;
    __device__ __forceinline__ bool next(int i, Unit& u) const {
        const int nM = MT[16]; int pm, pn; if (!tile_order(i, G, c, nM, nN, pm, pn, FK_MOE_WGM)) return false;
        if (rev) pm = nM - 1 - pm;
        int s = 0;
#pragma unroll
        for (int q = 1; q < 16; ++q) s += (pm >= MT[q]) ? 1 : 0;
        const int tis = pm - MT[s], cnt = MT[32 + s];
        u.pm = s * SEGCAP + tis * BM; u.aux2 = cnt - tis * BM; u.pn = pn; u.aux = pm;
        u.A = gather_a ? A : A + (size_t)pm * BM * lda_b; u.B = W + (size_t)(s & 7) * wstride + (size_t)pn * BM * ldb_b; return true; }
};

__device__ __forceinline__ f32x4 bfx4_lo(const u32x4 a) { return (f32x4){bf_lo(a.x), bf_hi(a.x), bf_lo(a.y), bf_hi(a.y)}; }
__device__ __forceinline__ f32x4 bfx4_hi(const u32x4 a) { return (f32x4){bf_lo(a.z), bf_hi(a.z), bf_lo(a.w), bf_hi(a.w)}; }
__device__ __forceinline__ void final_phase(Frame& F) {
    const int gw = F.bx * 8 + F.wave, lane = F.lane;
    const LAS int* MT = (const LAS int*)(F.lds + MT_OFF);
    const f32x4 g0 = ((const f32x4*)karg_in(6))[2 * lane], g1 = ((const f32x4*)karg_in(6))[2 * lane + 1], g2 = ((const f32x4*)karg_in(6))[128 + 2 * lane], g3 = ((const f32x4*)karg_in(6))[128 + 2 * lane + 1];
    const bf16_t* HB = (const bf16_t*)(F.ws + WS_HB); const bf16_t* Y = (const bf16_t*)(F.ws + WS_Y); const int* TSL = (const int*)(F.ws + WS_TSL);
    for (int r0 = gw * 16; r0 < NTOK; r0 += F.G * 8 * 16) {
        const int sl = TSL[2 * r0 + (lane & 31)];
        const int cm = MT[sl >> 15] * BM + (sl & (SEGCAP - 1));
        u32x4 a[2], b[2], a1[2], b1[2], a2[2], b2[2];
#define FIN_LOAD(buf, i) do { const int c1 = __shfl(cm, 2 * (i)), c2 = __shfl(cm, 2 * (i) + 1); \
            const u32x4* p = (const u32x4*)(HB + (size_t)(r0 + (i)) * DM) + lane; const u32x4* y1 = (const u32x4*)(Y + (size_t)c1 * DM) + lane; const u32x4* y2 = (const u32x4*)(Y + (size_t)c2 * DM) + lane; \
            a[buf] = p[0]; b[buf] = p[64]; a1[buf] = y1[0]; b1[buf] = y1[64]; a2[buf] = y2[0]; b2[buf] = y2[64]; } while (0)
        FIN_LOAD(0, 0);
#pragma unroll
        for (int i = 0; i < 16; ++i) {
            const int cb = i & 1;
            if (i < 15) FIN_LOAD(cb ^ 1, i + 1);
            const f32x4 v0 = bfx4_lo(a[cb]) + bfx4_lo(a1[cb]) + bfx4_lo(a2[cb]), v1 = bfx4_hi(a[cb]) + bfx4_hi(a1[cb]) + bfx4_hi(a2[cb]), v2 = bfx4_lo(b[cb]) + bfx4_lo(b1[cb]) + bfx4_lo(b2[cb]), v3 = bfx4_hi(b[cb]) + bfx4_hi(b1[cb]) + bfx4_hi(b2[cb]);
            float s = ((v0[0] * v0[0] + v0[1] * v0[1]) + (v0[2] * v0[2] + v0[3] * v0[3])) + ((v1[0] * v1[0] + v1[1] * v1[1]) + (v1[2] * v1[2] + v1[3] * v1[3]));
            s += ((v2[0] * v2[0] + v2[1] * v2[1]) + (v2[2] * v2[2] + v2[3] * v2[3])) + ((v3[0] * v3[0] + v3[1] * v3[1]) + (v3[2] * v3[2] + v3[3] * v3[3]));
            const float rs = rsqrtf(wave_sum(s) * (1.0f / DM) + 1e-6f);
            f32x4* o = (f32x4*)(F.H + (size_t)(r0 + i) * DM) + 2 * lane;
            o[0] = v0 * rs * g0; o[1] = v1 * rs * g1; o[128] = v2 * rs * g2; o[129] = v3 * rs * g3; }
#undef FIN_LOAD
    }
}
constexpr int NPHASE = 19;
__global__ void __launch_bounds__(512, 2) mega(Args args) {
    extern __shared__ __attribute__((aligned(16))) unsigned char lds_raw[];
    Frame F;
    F.lds = (LAS unsigned char*)lds_raw;
    F.tid = threadIdx.x; F.lane = F.tid & 63; F.wave = __builtin_amdgcn_readfirstlane(F.tid >> 6); F.G = gridDim.x; F.bx = blockIdx.x;
    F.H = args.out; F.ws = args.ws;
    unsigned char* ws = args.ws;
    volatile LAS unsigned* MISC = (volatile LAS unsigned*)(F.lds + MISC_OFF);
    for (int u = F.tid; u < (LDS_BYTES - LDSCTL_OFF) / 4; u += 512) ((LAS unsigned*)(F.lds + LDSCTL_OFF))[u] = 0u;
    __syncthreads();
    const int lo = args.ph_lo, hi = args.ph_hi;
    const bool use_bar = (hi - lo) > 1;
    XcdBarrier bar; bar.bar = (unsigned*)(ws + WS_CTL) + CW_BAR; bar.x = 0; bar.st = nullptr;
    if (use_bar) bar = xcd_barrier_post((unsigned*)(ws + WS_CTL) + CW_BAR, MISC + 8);
#ifndef FK_PHASE_MASK
#define FK_PHASE_MASK 0x7ffff
#endif
#define IN(k) (((FK_PHASE_MASK >> (k)) & 1) && lo <= (k) && (k) < hi)
#define SEAM(k) do { if (IN((k) + 1)) xcd_barrier(bar); } while (0)
#ifndef FK_REV3
#define FK_REV3 0
#endif
#ifndef FK_REV8
#define FK_REV8 0
#endif
#ifndef FK_REV12
#define FK_REV12 0
#endif
#ifndef FK_REPEAT_MASK
#define FK_REPEAT_MASK 0
#endif
#define REP(k) ((FK_REPEAT_MASK >> (k)) & 1)
#ifdef FK_TPROBE
#define TP_BEGIN(k) do { if ((k) == FK_TPROBE && blockIdx.x == 0 && F.tid == 0) *(volatile unsigned long long*)(ws + 32768) = __builtin_amdgcn_s_memrealtime(); } while (0)
#define TP_END(k) do { if ((k) == FK_TPROBE && blockIdx.x == 0 && F.tid == 0) *(volatile unsigned long long*)(ws + 32776) = __builtin_amdgcn_s_memrealtime() - *(volatile unsigned long long*)(ws + 32768); } while (0)
#else
#define TP_BEGIN(k) do { } while (0)
#define TP_END(k) do { } while (0)
#endif
#ifdef FK_TPROBE2
#define TP2_FLAG(k) do { if (F.tid == 0) MISC[20] = ((k) == FK_TPROBE2) ? 1u : 0u; LDS_WAIT(); __syncthreads(); } while (0)
#define TP2_OUT(k) do { if ((k) == FK_TPROBE2 && blockIdx.x == 0 && F.tid == 0) *(volatile unsigned long long*)(ws + 32776) = *(volatile LAS unsigned long long*)(F.lds + MISC_OFF + 96); } while (0)
#else
#define TP2_FLAG(k) do { } while (0)
#define TP2_OUT(k) do { } while (0)
#endif
#define PHASE(k, ...) if (IN(k)) { TP2_FLAG(k); TP_BEGIN(k); { __VA_ARGS__ } if (REP(k)) { if (use_bar) xcd_barrier(bar); { __VA_ARGS__ } } SEAM(k); TP_END(k); TP2_OUT(k); }
    LAS unsigned char* ring = F.lds + RING_OFF; LAS float* TAB = (LAS float*)(F.lds + TAB_OFF);
    float* RSS = (float*)(ws + WS_RSS); bf16_t* HB = (bf16_t*)(ws + WS_HB);
    const int c = (int)blockIdx.x, G = (int)gridDim.x;

    PHASE(0, p0_prologue(F);)
    PHASE(1, KvOrder S{(const char*)(ws + WS_MEMN), (const char*)(ws + WS_WKT), G, c}; EpiPlain E{(bf16_t*)(ws + WS_KP), DM, (size_t)DM * DM};
        gemm_phase<EpiPlain, KvOrder>(ring, DM, DM, DM, S, E);)
    PHASE(2, MkVwOrder S{(const char*)(ws + WS_KP), (const char*)(ws + WS_WQS), (const char*)(ws + WS_WOT), G, c}; EpiPlain E{(bf16_t*)(ws + WS_MK), DM, (size_t)DM * DM};
        gemm_phase<EpiPlain, MkVwOrder>(ring, 256, DM, DM, S, E);)
    PHASE(3, DenseOrder S; S.init(HB, ws + WS_WIN0, NTOK, 2560, DM, DM, G, c); S.rev = FK_REV3; EpiGluZ E{(bf16_t*)(ws + WS_ZB), RSS};
        gemm_phase<EpiGluZ, DenseOrder>(ring, DM, DM, DM, S, E);)
    PHASE(4, conv_phase(F);)
    PHASE(5, DenseOrder S; S.init(ws + WS_MIX, ws + WS_WOUT0, NTOK, DM, DM, DM, G, c); EpiResid<false> E{HB, HB, RSS, TAB};
        gemm_phase<EpiResid<false>, DenseOrder>(ring, DM, DM, DM, S, E);)
    PHASE(6, DenseOrder S; S.init(HB, ws + WS_MK, NTOK, DM, DM, DM, G, c, 32, (size_t)DM * DM * 2); EpiSoftmax E{(bf16_t*)(ws + WS_PB), RSS, TAB};
        gemm_phase<EpiSoftmax, DenseOrder>(ring, DM, DM, DM, S, E);)
    PHASE(7, DenseOrder S; S.init(ws + WS_PB, ws + WS_MK + (size_t)8 * DM * DM * 2, NTOK, DM, DM, DM, G, c, 32, (size_t)DM * DM * 2); EpiResid<false> E{HB, HB, RSS, TAB};
        gemm_phase<EpiResid<false>, DenseOrder>(ring, DM, DM, DM, S, E);)
    PHASE(8, DenseOrder S; S.init(HB, ws + WS_WGU0, NTOK, 2 * DFF, DM, DM, G, c); S.rev = FK_REV8; EpiSwiGLU<false> E{(bf16_t*)(ws + WS_ACT0), DFF, RSS};
        gemm_phase<EpiSwiGLU<false>, DenseOrder>(ring, DM, DM, DM, S, E);)
    PHASE(9, DenseOrder S; S.init(ws + WS_ACT0, ws + WS_WD0, NTOK, DM, DFF, DFF, G, c); S.rev = 1; EpiResid<false> E{HB, HB, RSS, TAB};
        gemm_phase<EpiResid<false>, DenseOrder>(ring, DFF, DFF, DFF, S, E);)
    PHASE(10, DenseOrder S; S.init(HB, ws + WS_WSG, NTOK, 2048, DM, DM, G, c); EpiGeluUV E{(bf16_t*)(ws + WS_UV), RSS, (f32x2*)(ws + WS_VST), TAB};
        gemm_phase<EpiGeluUV, DenseOrder>(ring, DM, DM, DM, S, E);)
    PHASE(11, spatial_phase(F);)
    PHASE(12, DenseOrder S; S.init(ws + WS_US, ws + WS_WSO, NTOK, DM, DM, DM, G, c); S.rev = FK_REV12; EpiResid<false> E{HB, HB, RSS, TAB};
        gemm_phase<EpiResid<false>, DenseOrder>(ring, DM, DM, DM, S, E);)
    PHASE(13, DenseOrder S; S.init(HB, ws + WS_MK + (size_t)4 * DM * DM * 2, NTOK, DM, DM, DM, G, c, 32, (size_t)DM * DM * 2); EpiSoftmax E{(bf16_t*)(ws + WS_PB), RSS, TAB};
        gemm_phase<EpiSoftmax, DenseOrder>(ring, DM, DM, DM, S, E);)
    PHASE(14, DenseOrder S; S.init(ws + WS_PB, ws + WS_MK + (size_t)12 * DM * DM * 2, NTOK, DM, DM, DM, G, c, 32, (size_t)DM * DM * 2); EpiResid<false> E{HB, HB, RSS, TAB};
        gemm_phase<EpiResid<false>, DenseOrder>(ring, DM, DM, DM, S, E);)
    PHASE(15, router_phase(F);)
    if (hi > 16) moe_tables(F);
    const LAS int* MT = (const LAS int*)(F.lds + MT_OFF);
    PHASE(16, MoeOrder S{(const char*)(ws + WS_HB8), (const char*)(ws + WS_WGU1), (size_t)2 * DFF * DM, DM, DM, 22, G, c, MT, 1, (const int*)(ws + WS_STOK), 0}; EpiSwiGLU8 E{(unsigned char*)(ws + WS_ACT8)};
        gemm_phase<EpiSwiGLU8, MoeOrder, true, true>(ring, DM, DM, DM, S, E);)
    PHASE(17, MoeOrder S{(const char*)(ws + WS_ACT8), (const char*)(ws + WS_WD1), (size_t)DM * DFF, DFF, DFF, 4, G, c, MT, 0, nullptr, 0}; EpiMoeDown8 E{(bf16_t*)(ws + WS_Y), (const float*)(ws + WS_SGW)};
        gemm_phase<EpiMoeDown8, MoeOrder, false, true>(ring, DFF, DFF, DFF, S, E);)
    if (IN(18)) { TP_BEGIN(18); final_phase(F); TP_END(18); }
#undef IN
#undef SEAM
}

#if defined(FK_TPROBE) || defined(FK_TPROBE2)
#ifdef FK_TPROBE2
#define FK_TPAMP 64ull
#else
#define FK_TPAMP 8ull
#endif
__global__ void k_tprobe_spin(const unsigned char* ws) { const unsigned long long d = *(const volatile unsigned long long*)(ws + 32776), te = __builtin_amdgcn_s_memrealtime(); while (__builtin_amdgcn_s_memrealtime() - te < FK_TPAMP * d) __builtin_amdgcn_s_sleep(32); }
#endif
static int fk_grid = 0;
static bool fk_setup() {
    if (fk_grid == 0) {
        int dev = 0, cus = 0, per_cu = 0;
        if (hipGetDevice(&dev) != hipSuccess || hipDeviceGetAttribute(&cus, hipDeviceAttributeMultiprocessorCount, dev) != hipSuccess) { fk_grid = -1; return false; }
        if (hipFuncSetAttribute((const void*)mega, hipFuncAttributeMaxDynamicSharedMemorySize, LDS_BYTES) != hipSuccess) { fprintf(stderr, "hipFuncSetAttribute failed\n"); fk_grid = -1; return false; }
        if (hipOccupancyMaxActiveBlocksPerMultiprocessor(&per_cu, (const void*)mega, 512, LDS_BYTES) != hipSuccess || per_cu < 1) fprintf(stderr, "note: occupancy query says %d\n", per_cu);
        (void)hipGetLastError();
        fk_grid = 256;
        if (cus != 256) fprintf(stderr, "note: %d CUs reported; this kernel is built for 256\n", cus);
    }
    return fk_grid > 0;
}
static void fk_run(hipStream_t stream, void* const* d_in, void* d_out, void* d_ws, int lo, int hi, bool per_phase) {
    if (!fk_setup()) return;
    Args a{};
    for (int i = 0; i < 31; ++i) a.in[i] = (const float*)d_in[i];
    a.out = (float*)d_out; a.ws = (unsigned char*)d_ws;
#ifndef FK_HOST_REPEAT_MASK
#define FK_HOST_REPEAT_MASK 0
#endif
    if (per_phase) { for (int p = lo; p < hi; ++p) { a.ph_lo = p; a.ph_hi = p + 1; const int reps = ((FK_HOST_REPEAT_MASK >> p) & 1) ? 2 : 1;
        for (int q = 0; q < reps; ++q) hipLaunchKernelGGL(mega, dim3(fk_grid), dim3(512), LDS_BYTES, stream, a); } }
    else { a.ph_lo = lo; a.ph_hi = hi; hipLaunchKernelGGL(mega, dim3(fk_grid), dim3(512), LDS_BYTES, stream, a); }
#if defined(FK_TPROBE) || defined(FK_TPROBE2)
    hipLaunchKernelGGL(k_tprobe_spin, dim3(1), dim3(1), 0, stream, (const unsigned char*)d_ws);
#endif
    const hipError_t le = hipPeekAtLastError();
    if (le != hipSuccess) fprintf(stderr, "kernel_launch: launch failed: %s\n", hipGetErrorName(le));
}
}

#ifndef FK_MODE
#define FK_MODE 1
#endif
#ifndef FK_NSUB
#define FK_NSUB 1
#endif
extern "C" void kernel_launch(void* const* d_in, const int* in_sizes, int n_in, void* d_out, int out_size, void* d_ws, size_t ws_size, hipStream_t stream) {
    if (n_in != 31 || out_size != fk::NTOK * fk::DM || ws_size < fk::WS_END) { fprintf(stderr, "kernel_launch: unexpected shapes (n_in %d out %d ws %zu)\n", n_in, out_size, ws_size); return; }
    (void)hipMemsetAsync((char*)d_ws + fk::WS_CTL, 0, fk::CTL_ZERO_BYTES, stream);
#if FK_MODE == 1
    fk::fk_run(stream, d_in, d_out, d_ws, 0, fk::NPHASE, false);
#elif FK_MODE == 2
    fk::fk_run(stream, d_in, d_out, d_ws, 0, fk::NPHASE, true);
#elif FK_MODE == 3
    { constexpr int endph[7] = {0, 6, 8, 10, 13, 15, 18};
      float* h = (float*)d_out;
      if (FK_NSUB == 0) (void)hipMemcpyAsync(h, d_in[0], (size_t)nv::NTOK * nv::DM * 4, hipMemcpyDeviceToDevice, stream);
      else fk::fk_run(stream, d_in, d_out, d_ws, 0, endph[FK_NSUB], true);
      const nv::Bufs B = nv::carve(d_ws);
      for (int s = FK_NSUB; s < 6; ++s) nv::sublayer(stream, s, h, d_in, B);
      nv::final_norm(stream, h, d_in); }
#else
    { float* h = (float*)d_out;
      (void)hipMemcpyAsync(h, d_in[0], (size_t)nv::NTOK * nv::DM * 4, hipMemcpyDeviceToDevice, stream);
      const nv::Bufs B = nv::carve(d_ws);
      for (int s = 0; s < 6; ++s) nv::sublayer(stream, s, h, d_in, B);
      nv::final_norm(stream, h, d_in); }
#endif
}
```

```cpp
#include <hip/hip_runtime.h>
#include <cstdio>
#include <cstdint>
#define FK_MODE 1
#define FK_NSUB 0
namespace fk {
#define LAS __attribute__((address_space(3)))
#define GAS __attribute__((address_space(1)))
typedef unsigned short bf16_t;
typedef short bf16x8 __attribute__((ext_vector_type(8)));
typedef float f32x4 __attribute__((ext_vector_type(4)));
typedef float f32x2 __attribute__((ext_vector_type(2)));
typedef unsigned u32x4 __attribute__((ext_vector_type(4)));
typedef unsigned u32x2 __attribute__((ext_vector_type(2)));
typedef int i32x4 __attribute__((ext_vector_type(4)));
typedef GAS unsigned gu32;

constexpr int NTOK = 32768, DM = 1024, SEQL = 8192, MEML = 256, DFF = 2816, NEXP = 8;
constexpr int ZW = 1536;
constexpr int HALF_TILES = 136, HALF_ROWS = HALF_TILES * 256;
constexpr int BM = 256, BK = 64, HALF = 128, HTB = HALF * BK * 2, NXCD = 8, WGM = 8;

constexpr int RING_OFF = 0, RING_BYTES = 131072;
constexpr int LDSCTL_OFF = RING_BYTES, MISC_OFF = LDSCTL_OFF + 320;
constexpr int TAB_OFF = LDSCTL_OFF + 512;
constexpr int MT_OFF = TAB_OFF + 8192;
constexpr int RSCR_OFF = MT_OFF + 256;
constexpr int LDS_BYTES = 147456;
static_assert(RSCR_OFF + 4096 <= LDS_BYTES, "LDS map");

constexpr size_t MiB = 1u << 20;
constexpr size_t WS_CTL = 0, CTL_ZERO_BYTES = 64 * 1024;
constexpr size_t WS_RSS = 1 * MiB;
constexpr size_t WS_VST = 2 * MiB;
constexpr size_t WS_TSL = 3 * MiB;
constexpr size_t WS_STOK = 4 * MiB;
constexpr size_t WS_SGW = 6 * MiB;
constexpr size_t WS_MEMN = 8 * MiB;
constexpr size_t WS_KP = 12 * MiB;
constexpr size_t WS_WGU1 = 20 * MiB;
constexpr size_t WS_WD1 = 64 * MiB;
constexpr size_t WS_HB = 86 * MiB;
constexpr size_t WS_HB8 = 150 * MiB;
constexpr size_t WS_WIN0 = 182 * MiB;
constexpr size_t WS_WOUT0 = 187 * MiB;
constexpr size_t WS_WGU0 = 189 * MiB;
constexpr size_t WS_WD0 = 200 * MiB;
constexpr size_t WS_WQS = 206 * MiB;
constexpr size_t WS_WOT = 210 * MiB;
constexpr size_t WS_WKT = 214 * MiB;
constexpr size_t WS_MK = 222 * MiB;
constexpr size_t WS_WSG = 254 * MiB;
constexpr size_t WS_WSO = 258 * MiB;
constexpr size_t WS_R = 262 * MiB;
constexpr size_t WS_ZB = WS_R, WS_MIX = WS_R + 96 * MiB, WS_PB = WS_R, WS_ACT0 = WS_R, WS_UV = WS_R, WS_US = WS_R + 128 * MiB;
constexpr int SEGCAP = 32768;
constexpr int MOE_TILES = 2 * HALF_TILES;
constexpr size_t WS_ACT8 = 182 * MiB;
constexpr size_t WS_Y = 369 * MiB;
constexpr size_t WS_END = 512 * MiB;
static_assert(WS_ACT8 + (size_t)MOE_TILES * 256 * DFF <= WS_Y && WS_Y + (size_t)MOE_TILES * 256 * DM * 2 <= WS_END && WS_R + 216 * MiB <= WS_END, "ws map");
constexpr int CW_SEG = 512;
constexpr int CW_BAR = 1024;

#ifndef FK_FFN8
#define FK_FFN8 1
#endif
#define RLX_AGENT __ATOMIC_RELAXED, __HIP_MEMORY_SCOPE_AGENT
#define LDS_WAIT() asm volatile("s_waitcnt lgkmcnt(0)" ::: "memory")
#define VM_WAIT() asm volatile("s_waitcnt vmcnt(0)" ::: "memory")
__device__ __forceinline__ unsigned cvt_pk_bf16(float lo, float hi) { unsigned r; asm volatile("v_cvt_pk_bf16_f32 %0, %1, %2" : "=v"(r) : "v"(lo), "v"(hi)); return r; }
__device__ __forceinline__ float bf_lo(unsigned w) { return __uint_as_float(w << 16); }
__device__ __forceinline__ float bf_hi(unsigned w) { return __uint_as_float(w & 0xffff0000u); }
__device__ __forceinline__ float fast_sigmoid(float x) { return __builtin_amdgcn_rcpf(1.0f + __builtin_amdgcn_exp2f(-1.4426950408889634f * x)); }
__device__ __forceinline__ float fast_exp(float x) { return __builtin_amdgcn_exp2f(1.4426950408889634f * x); }
__device__ __forceinline__ float gelu_tanh_f(float x) { const float y = 1.5957691216057308f * (x + 0.044715f * x * x * x); return x * fast_sigmoid(y); }
template <int CTRL> __device__ __forceinline__ float dpp(float x) { return __builtin_bit_cast(float, __builtin_amdgcn_mov_dpp(__builtin_bit_cast(int, x), CTRL, 0xf, 0xf, true)); }
constexpr int DPP_XOR1 = 0xB1, DPP_XOR2 = 0x4E, DPP_MIR8 = 0x141, DPP_XOR8 = 0x128;
__device__ __forceinline__ float xor4(float x) {
    const int v = __builtin_bit_cast(int, x); int t = __builtin_amdgcn_update_dpp(v, v, 0x104, 0xf, 0x5, false); t = __builtin_amdgcn_update_dpp(t, v, 0x114, 0xf, 0xa, false); return __builtin_bit_cast(float, t); }
__device__ __forceinline__ float sum16(float x) { auto s = __builtin_amdgcn_permlane16_swap(__float_as_uint(x), __float_as_uint(x), false, false); return __uint_as_float(s[0]) + __uint_as_float(s[1]); }
__device__ __forceinline__ float sum32(float x) { auto s = __builtin_amdgcn_permlane32_swap(__float_as_uint(x), __float_as_uint(x), false, false); return __uint_as_float(s[0]) + __uint_as_float(s[1]); }
__device__ __forceinline__ float max16(float x) { auto s = __builtin_amdgcn_permlane16_swap(__float_as_uint(x), __float_as_uint(x), false, false); return fmaxf(__uint_as_float(s[0]), __uint_as_float(s[1])); }
__device__ __forceinline__ float max32(float x) { auto s = __builtin_amdgcn_permlane32_swap(__float_as_uint(x), __float_as_uint(x), false, false); return fmaxf(__uint_as_float(s[0]), __uint_as_float(s[1])); }
__device__ __forceinline__ float tr32(float a, float b) { auto s = __builtin_amdgcn_permlane32_swap(__float_as_uint(a), __float_as_uint(b), false, false); return __uint_as_float(s[0]) + __uint_as_float(s[1]); }
__device__ __forceinline__ float tr16(float a, float b) { auto s = __builtin_amdgcn_permlane16_swap(__float_as_uint(a), __float_as_uint(b), false, false); return __uint_as_float(s[0]) + __uint_as_float(s[1]); }
__device__ __forceinline__ float tr8(float a, float b, int lane) { const float keep = (lane & 8) ? b : a, send = (lane & 8) ? a : b; return keep + dpp<DPP_XOR8>(send); }
__device__ __forceinline__ float tr4(float a, float b, int lane) { const float keep = (lane & 4) ? b : a, send = (lane & 4) ? a : b; return keep + xor4(send); }
__device__ __forceinline__ u32x4 pair16(u32x2 a, u32x2 b) {
    auto x = __builtin_amdgcn_permlane16_swap(a.x, b.x, false, false); auto y = __builtin_amdgcn_permlane16_swap(a.y, b.y, false, false);
    return (u32x4){x[0], y[0], x[1], y[1]}; }
__device__ __forceinline__ float wave_sum(float v) {
    v += dpp<DPP_XOR1>(v); v += dpp<DPP_XOR2>(v); v += dpp<DPP_MIR8>(v); v += dpp<DPP_XOR8>(v);
    return sum32(sum16(v));
}
__device__ __forceinline__ float rstd_from_rss(const float* RSS4, int row) { const f32x4 s = *(const f32x4*)(RSS4 + (size_t)row * 4); return rsqrtf(((s.x + s.y) + (s.z + s.w)) * (1.0f / DM) + 1e-6f); }

__host__ __device__ __forceinline__ int lds_byte(int r, int c) { const int st = (r >> 4) * 2 + (c >> 5), rr = r & 15, cc = c & 31, ob = rr * 64 + cc * 2; return st * 1024 + (ob ^ (((ob >> 9) & 1) << 5)); }
__host__ __device__ __forceinline__ void stage_rc(int b, int& R, int& C) { const int st = b / 1024, sb = b % 1024, swz = sb ^ (((sb >> 9) & 1) << 5); R = (st >> 1) * 16 + swz / 64; C = (st & 1) * 32 + (swz % 64) / 2; }
__host__ __device__ __forceinline__ int perm32(int rho) { const int n = rho >> 4, i = rho & 15; return 8 * (i >> 2) + 4 * n + (i & 3); }

struct Unit { const char* A; const char* B; int pm, pn, aux, aux2; };

__device__ __forceinline__ bool tile_order(int i, int G, int c, int nM, int nN, int& pm, int& pn, const int WGM = 8) {
    const int nwg = nM * nN; const long L = (long)i * G + c; if (L >= nwg) return false;
    int wgid = (int)L; { const int q = nwg / NXCD, r = nwg % NXCD, xcd = wgid % NXCD, off = wgid / NXCD; wgid = (xcd < r ? xcd * (q + 1) : r * (q + 1) + (xcd - r) * q) + off; }
    const int nig = WGM * nN, gid = wgid / nig, fm = gid * WGM, gsz = (nM - fm) < WGM ? (nM - fm) : WGM;
    pm = fm + ((wgid % nig) % gsz); pn = (wgid % nig) / gsz; return true;
}
struct DenseOrder {
    const char* A; const char* Bt; int lda, ldb, nM, nN, G, c, pm_per_b; size_t bstride; int rev, es;
    __device__ __forceinline__ void init(const void* A_, const void* Bt_, int M, int N, int lda_, int ldb_, int G_, int c_, int pmb = 0, size_t bs = 0) {
        A = (const char*)A_; Bt = (const char*)Bt_; lda = lda_; ldb = ldb_; nM = M / BM; nN = N / BM; G = G_; c = c_; pm_per_b = pmb; bstride = bs; rev = 0; es = 2; }
    __device__ __forceinline__ bool next(int i, Unit& u) const {
        int pm, pn; if (!tile_order(i, G, c, nM, nN, pm, pn)) return false;
        if (rev) pm = nM - 1 - pm;
        u.pm = pm; u.pn = pn; u.aux = 0; u.aux2 = 0; u.A = A + (size_t)pm * BM * lda * es; u.B = Bt + (size_t)pn * BM * ldb * es + (pm_per_b ? (size_t)(pm / pm_per_b) * bstride : 0); return true; }
};

typedef int v4i_t __attribute__((ext_vector_type(4)));
typedef int v8i_t __attribute__((ext_vector_type(8)));
__device__ __forceinline__ v8i_t lds_ld32(const LAS unsigned char* p) { const v4i_t a = *(const LAS v4i_t*)p, b = *(const LAS v4i_t*)(p + 1024); return __builtin_shufflevector(a, b, 0, 1, 2, 3, 4, 5, 6, 7); }
template <class Epi, class Sched, bool GATHER = false, bool FP8 = false, bool ALIGN_EPI = true, bool SP2 = true>
__device__ __forceinline__ void gemm_phase(LAS unsigned char* lds, const int K, const int lda, const int ldb, const Sched& S, const Epi& E) {
    int tid_ = threadIdx.x; asm volatile("" : "+v"(tid_));
    const int tid = tid_, wid = __builtin_amdgcn_readfirstlane(tid >> 6), lane = tid & 63, wr = wid >> 2, wc = wid & 3, fr = lane & 15, fq = lane >> 4;
    int K_ = K; asm volatile("" : "+s"(K_));
    constexpr int ES = FP8 ? 1 : 2;
    const int nt = K_ * ES / 128;
    unsigned voffA[2][2], voffB[2];
#pragma unroll
    for (int i = 0; i < 2; ++i) { int R, C; stage_rc(tid * 16 + i * 8192, R, C); const int Rb = Epi::PERM ? ((R & ~31) + perm32(R & 31)) : R;
        voffA[0][i] = (unsigned)(R * lda * ES + C * 2); voffA[1][i] = (unsigned)((R + HALF) * lda * ES + C * 2); voffB[i] = (unsigned)(Rb * ldb * ES + C * 2); }
#define PG8_GIDX(dst, un) do { _Pragma("unroll") for (int _h = 0; _h < 2; ++_h) _Pragma("unroll") for (int _i = 0; _i < 2; ++_i) { int _R0, _C0; stage_rc(tid * 16 + _i * 8192, _R0, _C0); const int _R = _R0 + HALF * _h, _m = (un).aux2 - 1; \
        dst[_h][_i] = S.stok[(un).pm + (_R < _m ? _R : _m)]; } } while (0)
#define PG8_GOFF(dst, src) do { _Pragma("unroll") for (int _h = 0; _h < 2; ++_h) _Pragma("unroll") for (int _i = 0; _i < 2; ++_i) { int _R0, _C0; stage_rc(tid * 16 + _i * 8192, _R0, _C0); dst[_h][_i] = (unsigned)(src[_h][_i] * lda * ES + _C0 * 2); } } while (0)
    const size_t kstep = (size_t)(BK * 2);
    const size_t hstepB = (size_t)HALF * ldb * ES;
    const unsigned ldsw = (unsigned)wid * 1024u;
    const int aoff = lds_byte(wr * 64 + fr, fq * 8), boff = lds_byte(wc * 32 + fr, fq * 8);
#define PG8_SA(b, h) (((b) * 2 + (h)) * HTB)
#define PG8_SB(b, h) ((4 + (b) * 2 + (h)) * HTB)
#define PG8_STAGE(bufoff, gbase, voff) do { _Pragma("unroll") for (int _i = 0; _i < 2; ++_i) { unsigned _o = (voff)[_i]; asm volatile("" : "+v"(_o));     \
        __builtin_amdgcn_global_load_lds((const unsigned*)((const char*)(gbase) + _o), (LAS unsigned*)(lds + (bufoff) + ldsw + _i * 8192), 16, 0, 0); } } while (0)
#define PG8_LDA(dst, b, h) do { if constexpr (FP8) { _Pragma("unroll") for (int m = 0; m < 4; ++m) dst##8[m] = lds_ld32(lds + PG8_SA(b, h) + aoff + m * 2048); } else { \
        _Pragma("unroll") for (int m = 0; m < 4; ++m) _Pragma("unroll") for (int k = 0; k < 2; ++k) dst[m][k] = *(const LAS bf16x8*)(lds + PG8_SA(b, h) + aoff + m * 2048 + k * 1024); } } while (0)
#define PG8_LDB(dst, b, h) do { if constexpr (FP8) { _Pragma("unroll") for (int n = 0; n < 2; ++n) dst##8[n] = lds_ld32(lds + PG8_SB(b, h) + boff + n * 2048); } else { \
        _Pragma("unroll") for (int n = 0; n < 2; ++n) _Pragma("unroll") for (int k = 0; k < 2; ++k) dst[n][k] = *(const LAS bf16x8*)(lds + PG8_SB(b, h) + boff + n * 2048 + k * 1024); } } while (0)
#define PG8_MMA8(ai, bj, At8, Bt8) asm volatile("s_nop 1\n\t" \
        "v_mfma_f32_16x16x128_f8f6f4 %0, %12, %8, %0\n\tv_mfma_f32_16x16x128_f8f6f4 %1, %13, %8, %1\n\t" \
        "v_mfma_f32_16x16x128_f8f6f4 %2, %12, %9, %2\n\tv_mfma_f32_16x16x128_f8f6f4 %3, %13, %9, %3\n\t" \
        "v_mfma_f32_16x16x128_f8f6f4 %4, %12, %10, %4\n\tv_mfma_f32_16x16x128_f8f6f4 %5, %13, %10, %5\n\t" \
        "v_mfma_f32_16x16x128_f8f6f4 %6, %12, %11, %6\n\tv_mfma_f32_16x16x128_f8f6f4 %7, %13, %11, %7" \
        : "+v"(acc[ai][bj][0][0]), "+v"(acc[ai][bj][0][1]), "+v"(acc[ai][bj][1][0]), "+v"(acc[ai][bj][1][1]), "+v"(acc[ai][bj][2][0]), "+v"(acc[ai][bj][2][1]), "+v"(acc[ai][bj][3][0]), "+v"(acc[ai][bj][3][1]) \
        : "v"(At8[0]), "v"(At8[1]), "v"(At8[2]), "v"(At8[3]), "v"(Bt8[0]), "v"(Bt8[1]))
#define PG8_MMA(ai, bj, At, Bt) do { __builtin_amdgcn_s_setprio(1); if constexpr (FP8) { PG8_MMA8(ai, bj, At##8, Bt##8); } else { \
        _Pragma("unroll") for (int m = 0; m < 4; ++m) _Pragma("unroll") for (int n = 0; n < 2; ++n) _Pragma("unroll") for (int k = 0; k < 2; ++k) \
        acc[ai][bj][m][n] = __builtin_amdgcn_mfma_f32_16x16x32_bf16(Bt[n][k], At[m][k], acc[ai][bj][m][n], 0, 0, 0); } __builtin_amdgcn_s_setprio(0); } while (0)
#define PG8_WAIT_V(n) asm volatile("s_waitcnt vmcnt(" #n ")" ::: "memory")
#define PG8_WAIT_L(n) asm volatile("s_waitcnt lgkmcnt(" #n ")" ::: "memory")
#define PG8_BAR __builtin_amdgcn_s_barrier()
#define PG8_SCHED __builtin_amdgcn_sched_barrier(0)
    Unit cur, nxt; int ui = 0;
    if (!S.next(0, cur)) return;
    f32x4 acc[2][2][4][2];
#pragma unroll
    for (int a = 0; a < 2; ++a)
#pragma unroll
        for (int b = 0; b < 2; ++b)
#pragma unroll
            for (int m = 0; m < 4; ++m)
#pragma unroll
                for (int n = 0; n < 2; ++n) acc[a][b][m][n] = (f32x4){0.f, 0.f, 0.f, 0.f};
    bf16x8 At[4][2], B0[2][2], B1[2][2]; v8i_t At8[4], B08[2], B18[2];
    const char* cA = cur.A; const char* cB = cur.B;
    int ntok[2][2] = {{0, 0}, {0, 0}}, ntok2[2][2] = {{0, 0}, {0, 0}};
    if constexpr (GATHER) { PG8_GIDX(ntok, cur); PG8_GOFF(voffA, ntok); Unit u1; if (S.next(1, u1)) PG8_GIDX(ntok, u1); }
    if constexpr (SP2) {
        PG8_STAGE(PG8_SB(0, 0), cB, voffB); PG8_STAGE(PG8_SB(0, 1), cB + hstepB, voffB); PG8_STAGE(PG8_SA(0, 0), cA, voffA[0]); PG8_STAGE(PG8_SA(0, 1), cA, voffA[1]);
        if (wr == 1) PG8_BAR;
        PG8_WAIT_V(2); PG8_BAR;
        PG8_STAGE(PG8_SB(1, 0), cB + kstep, voffB); PG8_STAGE(PG8_SA(1, 0), cA + kstep, voffA[0]); PG8_STAGE(PG8_SB(1, 1), cB + hstepB + kstep, voffB);
        PG8_WAIT_V(6); PG8_BAR;
    } else {
        PG8_STAGE(PG8_SB(0, 0), cB, voffB); PG8_STAGE(PG8_SA(0, 0), cA, voffA[0]); PG8_STAGE(PG8_SB(0, 1), cB + hstepB, voffB); PG8_STAGE(PG8_SA(0, 1), cA, voffA[1]);
        if (wr == 1) PG8_BAR;
        PG8_WAIT_V(4); PG8_BAR;
        PG8_STAGE(PG8_SB(1, 0), cB + kstep, voffB); PG8_STAGE(PG8_SA(1, 0), cA + kstep, voffA[0]); PG8_STAGE(PG8_SB(1, 1), cB + hstepB + kstep, voffB);
        PG8_WAIT_V(6); PG8_BAR;
    }
    for (;;) {
        const bool has_next = S.next(ui + 1, nxt);
        const char* nA = has_next ? nxt.A : cA; const char* nB = has_next ? nxt.B : cB;
        Unit u2; const bool has_next2 = GATHER ? S.next(ui + 2, u2) : false;
        for (int t = 0; t < nt; t += 2) {
            const bool last = (t == nt - 2);
            unsigned v2A[2][2];
#pragma unroll
            for (int _h = 0; _h < 2; ++_h)
#pragma unroll
                for (int _i = 0; _i < 2; ++_i) v2A[_h][_i] = voffA[_h][_i];
            if constexpr (GATHER) { if (t == 0 && has_next2) PG8_GIDX(ntok2, u2);
                if (last && has_next) PG8_GOFF(v2A, ntok); }
            const char* a1 = cA + (size_t)(t + 1) * kstep;
            const char* a2 = last ? nA : cA + (size_t)(t + 2) * kstep; const char* b2 = last ? nB : cB + (size_t)(t + 2) * kstep;
            const char* a3 = a2 + kstep; const char* b3 = b2 + kstep;
            if constexpr (SP2) {
            PG8_LDB(B0, 0, 0); PG8_LDB(B1, 0, 1); PG8_SCHED; PG8_LDA(At, 0, 0); PG8_STAGE(PG8_SA(1, 1), a1, voffA[1]);
            PG8_WAIT_V(8); PG8_WAIT_L(0); PG8_BAR; PG8_MMA(0, 0, At, B0); PG8_MMA(0, 1, At, B1); PG8_BAR; PG8_SCHED;
            PG8_LDA(At, 0, 1); PG8_STAGE(PG8_SB(0, 0), b2, voffB); PG8_STAGE(PG8_SB(0, 1), b2 + hstepB, voffB); PG8_STAGE(PG8_SA(0, 0), a2, v2A[0]);
            PG8_WAIT_V(8); PG8_WAIT_L(0); PG8_BAR; PG8_MMA(1, 0, At, B0); PG8_MMA(1, 1, At, B1); PG8_BAR; PG8_SCHED;
            PG8_LDB(B0, 1, 0); PG8_LDB(B1, 1, 1); PG8_SCHED; PG8_LDA(At, 1, 0); PG8_STAGE(PG8_SA(0, 1), a2, v2A[1]);
            PG8_WAIT_V(8); PG8_WAIT_L(0); PG8_BAR; PG8_MMA(0, 0, At, B0); PG8_MMA(0, 1, At, B1); PG8_BAR; PG8_SCHED;
            PG8_LDA(At, 1, 1); PG8_STAGE(PG8_SB(1, 0), b3, voffB); PG8_STAGE(PG8_SB(1, 1), b3 + hstepB, voffB); PG8_STAGE(PG8_SA(1, 0), a3, v2A[0]);
            PG8_WAIT_V(8); PG8_WAIT_L(0); PG8_BAR; PG8_MMA(1, 0, At, B0); PG8_MMA(1, 1, At, B1); PG8_BAR; PG8_SCHED;
            } else {
            PG8_LDB(B0, 0, 0); PG8_SCHED; PG8_LDA(At, 0, 0); PG8_STAGE(PG8_SA(1, 1), a1, voffA[1]);
            PG8_WAIT_L(8); PG8_BAR; PG8_WAIT_L(0); PG8_MMA(0, 0, At, B0); PG8_BAR; PG8_SCHED;
            PG8_LDB(B1, 0, 1); PG8_STAGE(PG8_SB(0, 0), b2, voffB);
            PG8_BAR; PG8_WAIT_L(0); PG8_MMA(0, 1, At, B1); PG8_BAR;
            PG8_LDA(At, 0, 1); PG8_STAGE(PG8_SA(0, 0), a2, v2A[0]);
            PG8_BAR; PG8_WAIT_L(0); PG8_MMA(1, 0, At, B0); PG8_BAR; PG8_SCHED;
            PG8_STAGE(PG8_SB(0, 1), b2 + hstepB, voffB);
            PG8_WAIT_V(6); PG8_BAR; PG8_MMA(1, 1, At, B1); PG8_BAR;
            PG8_LDB(B0, 1, 0); PG8_SCHED; PG8_LDA(At, 1, 0); PG8_STAGE(PG8_SA(0, 1), a2, v2A[1]);
            PG8_WAIT_L(8); PG8_BAR; PG8_WAIT_L(0); PG8_MMA(0, 0, At, B0); PG8_BAR; PG8_SCHED;
            PG8_LDB(B1, 1, 1); PG8_STAGE(PG8_SB(1, 0), b3, voffB);
            PG8_BAR; PG8_WAIT_L(0); PG8_MMA(0, 1, At, B1); PG8_BAR;
            PG8_LDA(At, 1, 1); PG8_STAGE(PG8_SA(1, 0), a3, v2A[0]);
            PG8_BAR; PG8_WAIT_L(0); PG8_MMA(1, 0, At, B0); PG8_BAR; PG8_SCHED;
            PG8_STAGE(PG8_SB(1, 1), b3 + hstepB, voffB);
            PG8_WAIT_V(6); PG8_BAR; PG8_MMA(1, 1, At, B1); PG8_BAR;
            }
        }
        if constexpr (ALIGN_EPI) { if (wr == 0) PG8_BAR; }
        if constexpr (FP8) asm volatile("s_nop 15\n\ts_nop 15" ::: "memory");
        E(acc, cur, wr, wc, fr, fq, tid);
        if (!has_next) break;
#pragma unroll
        for (int a = 0; a < 2; ++a)
#pragma unroll
            for (int b = 0; b < 2; ++b)
#pragma unroll
                for (int m = 0; m < 4; ++m)
#pragma unroll
                    for (int n = 0; n < 2; ++n) acc[a][b][m][n] = (f32x4){0.f, 0.f, 0.f, 0.f};
        cur = nxt; cA = nA; cB = nB; ++ui;
        if constexpr (GATHER) { PG8_GOFF(voffA, ntok);
#pragma unroll
            for (int _h = 0; _h < 2; ++_h)
#pragma unroll
                for (int _i = 0; _i < 2; ++_i) ntok[_h][_i] = ntok2[_h][_i]; }
        if constexpr (ALIGN_EPI) { if (wr == 1) PG8_BAR; }
    }
    PG8_WAIT_V(0);
    if constexpr (!ALIGN_EPI) { if (wr == 0) PG8_BAR; }
    PG8_BAR;
#undef PG8_SA
#undef PG8_SB
#undef PG8_STAGE
#undef PG8_LDA
#undef PG8_LDB
#undef PG8_MMA
#undef PG8_MMA8
#undef PG8_WAIT_V
#undef PG8_WAIT_L
#undef PG8_BAR
#undef PG8_SCHED
#undef PG8_GOFF
#undef PG8_GIDX
}

#define EPI_BAR() do { asm volatile("s_waitcnt lgkmcnt(0)" ::: "memory"); __builtin_amdgcn_s_barrier(); asm volatile("" ::: "memory"); } while (0)
typedef f32x4 acc_t[2][2][4][2];

__device__ __forceinline__ float clamp448(float x) { return fminf(fmaxf(x, -448.f), 448.f); }
__device__ __forceinline__ unsigned pk4_fp8(float a, float b, float c, float d) { unsigned w = 0u; w = __builtin_amdgcn_cvt_pk_fp8_f32(clamp448(a), clamp448(b), w, false); w = __builtin_amdgcn_cvt_pk_fp8_f32(clamp448(c), clamp448(d), w, true); return w; }
constexpr float W8_SCALE = 64.0f, W8_INV = 1.0f / 64.0f;

struct EpiPlain {
    static constexpr bool PERM = true;
    bf16_t* O; int ldc; size_t aux_stride;
    __device__ __forceinline__ void operator()(acc_t& acc, const Unit& u, int wr, int wc, int fr, int fq, int tid) const {
        bf16_t* base = O + (size_t)u.aux * aux_stride + (size_t)(u.pm * BM + wr * 64 + fr) * ldc + u.pn * BM + wc * 32 + 8 * fq;
#pragma unroll
        for (int ai = 0; ai < 2; ++ai)
#pragma unroll
            for (int m = 0; m < 4; ++m) { bf16_t* rowp = base + (size_t)(ai * HALF + m * 16) * ldc;
#pragma unroll
                for (int bj = 0; bj < 2; ++bj) { const f32x4 v0 = acc[ai][bj][m][0], v1 = acc[ai][bj][m][1];
                    u32x4 w; w.x = cvt_pk_bf16(v0[0], v0[1]); w.y = cvt_pk_bf16(v0[2], v0[3]); w.z = cvt_pk_bf16(v1[0], v1[1]); w.w = cvt_pk_bf16(v1[2], v1[3]);
                    *(u32x4*)(rowp + bj * HALF) = w; } }
    }
};

constexpr float MK8_SCALE = 64.0f, VW8_SCALE = 4.0f, P8_SCALE = 256.0f;
struct EpiPlain8 {
    static constexpr bool PERM = true;
    unsigned char* O8;
    __device__ __forceinline__ void operator()(acc_t& acc, const Unit& u, int wr, int wc, int fr, int fq, int tid) const {
        const float sc = u.aux < 8 ? MK8_SCALE : VW8_SCALE;
        unsigned char* base = O8 + (size_t)u.aux * (DM * DM) + (size_t)(u.pm * BM + wr * 64 + (fq & 1) * 16 + fr) * DM + u.pn * BM + wc * 32 + 8 * (fq & 2);
#pragma unroll
        for (int ai = 0; ai < 2; ++ai)
#pragma unroll
            for (int m = 0; m < 4; m += 2) { unsigned char* rowp = base + (size_t)(ai * HALF + m * 16) * DM;
#pragma unroll
                for (int bj = 0; bj < 2; ++bj) { u32x2 w[2];
#pragma unroll
                    for (int h = 0; h < 2; ++h) { const f32x4 v0 = acc[ai][bj][m + h][0] * sc, v1 = acc[ai][bj][m + h][1] * sc;
                        w[h].x = pk4_fp8(v0[0], v0[1], v0[2], v0[3]); w[h].y = pk4_fp8(v1[0], v1[1], v1[2], v1[3]); }
                    *(u32x4*)(rowp + bj * HALF) = pair16(w[0], w[1]); } }
    }
};
__device__ __forceinline__ f32x2 silu_mul_pk(f32x2 g, f32x2 up) {
    const f32x2 t = g * (-1.4426950408889634f); f32x2 e; e.x = __builtin_amdgcn_exp2f(t.x); e.y = __builtin_amdgcn_exp2f(t.y);
    const f32x2 d = e + 1.0f; f32x2 r; r.x = __builtin_amdgcn_rcpf(d.x); r.y = __builtin_amdgcn_rcpf(d.y);
    return (g * r) * up;
}
__device__ __forceinline__ f32x2 silu_mul_fold(f32x2 g, f32x2 up, float c1, float k) {
    const f32x2 t = g * c1; f32x2 e; e.x = __builtin_amdgcn_exp2f(t.x); e.y = __builtin_amdgcn_exp2f(t.y);
    const f32x2 d = __builtin_elementwise_fma(e, (f32x2){k, k}, (f32x2){k, k}); f32x2 r; r.x = __builtin_amdgcn_rcpf(d.x); r.y = __builtin_amdgcn_rcpf(d.y);
    return (g * up) * r;
}
__device__ __forceinline__ f32x2 gelu_tanh_fold(f32x2 y, float A, float B, float rinv) {
    const f32x2 p = __builtin_elementwise_fma(y * y, (f32x2){A, A}, (f32x2){B, B}), t = y * p;
    f32x2 e; e.x = __builtin_amdgcn_exp2f(t.x); e.y = __builtin_amdgcn_exp2f(t.y);
    const f32x2 d = __builtin_elementwise_fma(e, (f32x2){rinv, rinv}, (f32x2){rinv, rinv}); f32x2 r; r.x = __builtin_amdgcn_rcpf(d.x); r.y = __builtin_amdgcn_rcpf(d.y);
    return y * r;
}
__device__ __forceinline__ f32x2 gelu_tanh_pk(f32x2 x) {
    const f32x2 x2 = x * x, p = x2 * 0.044715f + 1.0f, t = (x * p) * (-1.5957691216057308f * 1.4426950408889634f);
    f32x2 e; e.x = __builtin_amdgcn_exp2f(t.x); e.y = __builtin_amdgcn_exp2f(t.y);
    const f32x2 d = e + 1.0f; f32x2 r; r.x = __builtin_amdgcn_rcpf(d.x); r.y = __builtin_amdgcn_rcpf(d.y);
    return x * r;
}
struct EpiGluZ {
    static constexpr bool PERM = true;
    bf16_t* ZB; const float* RSS4;
    template <int KIND  >
    __device__ __forceinline__ void tile(acc_t& acc, const Unit& u, int wr, int wc, int fr, int fq, int cofs) const {
        float rsv[2][4];
#pragma unroll
        for (int ai = 0; ai < 2; ++ai)
#pragma unroll
            for (int m = 0; m < 4; ++m) rsv[ai][m] = rstd_from_rss(RSS4, u.pm * BM + ai * HALF + wr * 64 + m * 16 + fr);
#pragma unroll
        for (int ai = 0; ai < 2; ++ai)
#pragma unroll
            for (int m = 0; m < 4; ++m) {
                const int row = u.pm * BM + ai * HALF + wr * 64 + m * 16 + fr; const float rs = rsv[ai][m], rinv = __builtin_amdgcn_rcpf(rs);
                bf16_t* rowp = ZB + (size_t)row * ZW + wc * 32 + 8 * fq + cofs;
                if (KIND != 1) {
                    float o[8];
#pragma unroll
                    for (int n = 0; n < 2; ++n)
#pragma unroll
                        for (int e = 0; e < 4; e += 2) { const f32x2 a = (f32x2){acc[ai][0][m][n][e], acc[ai][0][m][n][e + 1]}, b = (f32x2){acc[ai][1][m][n][e], acc[ai][1][m][n][e + 1]}; f32x2 q;
                            if (KIND == 0) { const f32x2 t = b * (-1.4426950408889634f * rs); f32x2 ex; ex.x = __builtin_amdgcn_exp2f(t.x); ex.y = __builtin_amdgcn_exp2f(t.y);
                                const f32x2 d = __builtin_elementwise_fma(ex, (f32x2){rinv, rinv}, (f32x2){rinv, rinv}); f32x2 rc; rc.x = __builtin_amdgcn_rcpf(d.x); rc.y = __builtin_amdgcn_rcpf(d.y); q = a * rc; }
                            else q = (a * b) * (rs * rs);
                            o[n * 4 + e] = q.x; o[n * 4 + e + 1] = q.y; }
                    u32x4 w; w.x = cvt_pk_bf16(o[0], o[1]); w.y = cvt_pk_bf16(o[2], o[3]); w.z = cvt_pk_bf16(o[4], o[5]); w.w = cvt_pk_bf16(o[6], o[7]);
                    *(u32x4*)rowp = w;
                } else {
#pragma unroll
                    for (int bj = 0; bj < 2; ++bj) { const f32x4 v0 = acc[ai][bj][m][0] * rs, v1 = acc[ai][bj][m][1] * rs;
                        u32x4 w; w.x = cvt_pk_bf16(v0[0], v0[1]); w.y = cvt_pk_bf16(v0[2], v0[3]); w.z = cvt_pk_bf16(v1[0], v1[1]); w.w = cvt_pk_bf16(v1[2], v1[3]);
                        *(u32x4*)(rowp + bj * HALF) = w; }
                }
            }
    }
    __device__ __forceinline__ void operator()(acc_t& acc, const Unit& u, int wr, int wc, int fr, int fq, int tid) const {
        const int pn = u.pn;
        if (pn < 4) tile<0>(acc, u, wr, wc, fr, fq, 128 * pn);
        else if (pn < 6) tile<1>(acc, u, wr, wc, fr, fq, 512 + 256 * (pn - 4));
        else tile<2>(acc, u, wr, wc, fr, fq, 1024 + 128 * (pn - 6));
    }
};

template <bool MOE> struct EpiSwiGLU {
    static constexpr bool PERM = true;
    bf16_t* ACT; int ldc; const float* RSx; float sc;
    __device__ __forceinline__ void operator()(acc_t& acc, const Unit& u, int wr, int wc, int fr, int fq, int tid) const {
        float rsv[2][4];
#pragma unroll
        for (int ai = 0; ai < 2; ++ai)
#pragma unroll
            for (int m = 0; m < 4; ++m) { const int rl = ai * HALF + wr * 64 + m * 16 + fr;
                if (MOE) { const int mx = u.aux2 - 1; const float t = RSx[u.pm + (rl < mx ? rl : mx)]; rsv[ai][m] = rl < u.aux2 ? t : 0.f; } else rsv[ai][m] = rstd_from_rss(RSx, u.pm * BM + rl) * sc; }
#pragma unroll
        for (int ai = 0; ai < 2; ++ai)
#pragma unroll
            for (int m = 0; m < 4; ++m) {
                const int rl = ai * HALF + wr * 64 + m * 16 + fr;
                const float rs = rsv[ai][m];
                const int orow = (MOE ? u.aux : u.pm) * BM + rl;
                const float c1 = -1.4426950408889634f * rs, kk = __builtin_amdgcn_rcpf(rs * rs);
                bf16_t* AO = ACT;
                float o[8];
#pragma unroll
                for (int n = 0; n < 2; ++n)
#pragma unroll
                    for (int e = 0; e < 4; e += 2) { const f32x2 g = (f32x2){acc[ai][0][m][n][e], acc[ai][0][m][n][e + 1]}, up = (f32x2){acc[ai][1][m][n][e], acc[ai][1][m][n][e + 1]};
                        f32x2 r; if (MOE) r = silu_mul_pk(g * rs, up * rs); else r = silu_mul_fold(g, up, c1, kk); o[n * 4 + e] = r.x; o[n * 4 + e + 1] = r.y; }
                u32x4 w; w.x = cvt_pk_bf16(o[0], o[1]); w.y = cvt_pk_bf16(o[2], o[3]); w.z = cvt_pk_bf16(o[4], o[5]); w.w = cvt_pk_bf16(o[6], o[7]);
                __builtin_nontemporal_store(w, (u32x4*)(AO + (size_t)orow * ldc + 128 * u.pn + wc * 32 + 8 * fq));
            }
    }
};

template <bool BASE_F32, bool SCALED = false, bool OUT8 = false> struct EpiResid {
    static constexpr bool PERM = true;
    const void* base; bf16_t* HB; float* RSS4; LAS float* T; float sc; unsigned char* H8;
    __device__ __forceinline__ void operator()(acc_t& acc, const Unit& u, int wr, int wc, int fr, int fq, int tid) const {
        const int col0 = u.pn * BM + wc * 32 + 8 * fq;
        u32x4 bw[2][4][2];
        if (!BASE_F32) {
#pragma unroll
            for (int ai = 0; ai < 2; ++ai)
#pragma unroll
                for (int m = 0; m < 4; ++m)
#pragma unroll
                    for (int bj = 0; bj < 2; ++bj) bw[ai][m][bj] = *(const u32x4*)((const bf16_t*)base + (size_t)(u.pm * BM + ai * HALF + wr * 64 + m * 16 + fr) * DM + col0 + bj * HALF);
        }
#pragma unroll
        for (int ai = 0; ai < 2; ++ai) {
            u32x2 w8e[2];
#pragma unroll
            for (int m = 0; m < 4; ++m) {
                const int rl = ai * HALF + wr * 64 + m * 16 + fr; const size_t off = (size_t)(u.pm * BM + rl) * DM + col0; float ss = 0.f;
#pragma unroll
                for (int bj = 0; bj < 2; ++bj) {
                    f32x4 b0, b1;
                    if (BASE_F32) { b0 = *(const f32x4*)((const float*)base + off + bj * HALF); b1 = *(const f32x4*)((const float*)base + off + bj * HALF + 4); }
                    else { const u32x4 w = bw[ai][m][bj]; b0 = (f32x4){bf_lo(w.x), bf_hi(w.x), bf_lo(w.y), bf_hi(w.y)}; b1 = (f32x4){bf_lo(w.z), bf_hi(w.z), bf_lo(w.w), bf_hi(w.w)}; }
                    const f32x4 v0 = SCALED ? b0 + acc[ai][bj][m][0] * sc : b0 + acc[ai][bj][m][0], v1 = SCALED ? b1 + acc[ai][bj][m][1] * sc : b1 + acc[ai][bj][m][1];
                    if (OUT8) { u32x2 w8; w8.x = pk4_fp8(v0[0], v0[1], v0[2], v0[3]); w8.y = pk4_fp8(v1[0], v1[1], v1[2], v1[3]);
                        if ((m & 1) == 0) w8e[bj] = w8; else *(u32x4*)(H8 + (size_t)(u.pm * BM + rl - 16 + (fq & 1) * 16) * DM + u.pn * BM + wc * 32 + 8 * (fq & 2) + bj * HALF) = pair16(w8e[bj], w8); }
                    const f32x4 q = v0 * v0 + v1 * v1; ss += (q[0] + q[1]) + (q[2] + q[3]);
                    u32x4 o; o.x = cvt_pk_bf16(v0[0], v0[1]); o.y = cvt_pk_bf16(v0[2], v0[3]); o.z = cvt_pk_bf16(v1[0], v1[1]); o.w = cvt_pk_bf16(v1[2], v1[3]);
                    *(u32x4*)(HB + off + bj * HALF) = o; }
                ss = sum32(sum16(ss));
                if (fq == 0) T[rl * 4 + wc] = ss;
            } }
        EPI_BAR();
        if (tid < 256) { const f32x4 p = *(const LAS f32x4*)(T + tid * 4); RSS4[(size_t)(u.pm * BM + tid) * 4 + u.pn] = (p.x + p.y) + (p.z + p.w); }
    }
};

template <bool F8> struct EpiSoftmax {
    static constexpr bool PERM = true;
    bf16_t* PB; const float* RSS4; LAS float* T;
    __device__ __forceinline__ void operator()(acc_t& acc, const Unit& u, int wr, int wc, int fr, int fq, int tid) const {
        LAS f32x2* T2 = (LAS f32x2*)T;
        float mw[2][4];
#pragma unroll
        for (int ai = 0; ai < 2; ++ai)
#pragma unroll
            for (int m = 0; m < 4; ++m) {
                const int rl = ai * HALF + wr * 64 + m * 16 + fr; const float rs = rstd_from_rss(RSS4, u.pm * BM + rl) * (F8 ? 1.0f / MK8_SCALE : 1.0f);
                float mx = -3.0e38f;
#pragma unroll
                for (int bj = 0; bj < 2; ++bj)
#pragma unroll
                    for (int n = 0; n < 2; ++n) { const f32x4 v = acc[ai][bj][m][n]; mx = fmaxf(fmaxf(mx, fmaxf(v[0], v[1])), fmaxf(v[2], v[3])); }
                mx = max32(max16(mx));
                const float cs = rs * 1.4426950408889634f, mc = -mx * cs; mx *= rs;
                float l = 0.f;
#pragma unroll
                for (int bj = 0; bj < 2; ++bj)
#pragma unroll
                    for (int n = 0; n < 2; ++n) { f32x4 v = __builtin_elementwise_fma(acc[ai][bj][m][n], (f32x4){cs, cs, cs, cs}, (f32x4){mc, mc, mc, mc}); v[0] = __builtin_amdgcn_exp2f(v[0]); v[1] = __builtin_amdgcn_exp2f(v[1]); v[2] = __builtin_amdgcn_exp2f(v[2]); v[3] = __builtin_amdgcn_exp2f(v[3]); acc[ai][bj][m][n] = v; l += (v[0] + v[1]) + (v[2] + v[3]); }
                l = sum32(sum16(l));
                if (fq == 0) T2[rl * 4 + wc] = (f32x2){mx, l};
                mw[ai][m] = mx;
            }
        EPI_BAR();
#pragma unroll
        for (int ai = 0; ai < 2; ++ai) {
            u32x2 w8e[2];
#pragma unroll
            for (int m = 0; m < 4; ++m) {
                const int rl = ai * HALF + wr * 64 + m * 16 + fr;
                const f32x2 p0 = T2[rl * 4 + 0], p1 = T2[rl * 4 + 1], p2 = T2[rl * 4 + 2], p3 = T2[rl * 4 + 3];
                const float M = fmaxf(fmaxf(p0.x, p1.x), fmaxf(p2.x, p3.x));
                const float L = (p0.y * fast_exp(p0.x - M) + p1.y * fast_exp(p1.x - M)) + (p2.y * fast_exp(p2.x - M) + p3.y * fast_exp(p3.x - M));
                const float f = fast_exp(mw[ai][m] - M) * __builtin_amdgcn_rcpf(L) * (F8 ? P8_SCALE : 1.0f);
                const size_t eo = (size_t)(u.pm * BM + rl) * DM + u.pn * BM + wc * 32 + 8 * fq;
#pragma unroll
                for (int bj = 0; bj < 2; ++bj) { const f32x4 v0 = acc[ai][bj][m][0] * f, v1 = acc[ai][bj][m][1] * f;
                    if (F8) { u32x2 w8; w8.x = pk4_fp8(v0[0], v0[1], v0[2], v0[3]); w8.y = pk4_fp8(v1[0], v1[1], v1[2], v1[3]);
                        if ((m & 1) == 0) w8e[bj] = w8; else *(u32x4*)((unsigned char*)PB + (size_t)(u.pm * BM + rl - 16 + (fq & 1) * 16) * DM + u.pn * BM + wc * 32 + 8 * (fq & 2) + bj * HALF) = pair16(w8e[bj], w8); }
                    else { u32x4 w; w.x = cvt_pk_bf16(v0[0], v0[1]); w.y = cvt_pk_bf16(v0[2], v0[3]); w.z = cvt_pk_bf16(v1[0], v1[1]); w.w = cvt_pk_bf16(v1[2], v1[3]);
                        *(u32x4*)(PB + eo + bj * HALF) = w; } }
            } }
    }
};

struct EpiGeluUV {
    static constexpr bool PERM = true;
    bf16_t* UV; const float* RSS4; f32x2* VST; LAS float* T;
    __device__ __forceinline__ void operator()(acc_t& acc, const Unit& u, int wr, int wc, int fr, int fq, int tid) const {
        LAS f32x2* T2 = (LAS f32x2*)T;
        float rsv[2][4];
#pragma unroll
        for (int ai = 0; ai < 2; ++ai)
#pragma unroll
            for (int m = 0; m < 4; ++m) rsv[ai][m] = rstd_from_rss(RSS4, u.pm * BM + ai * HALF + wr * 64 + m * 16 + fr);
#pragma unroll
        for (int ai = 0; ai < 2; ++ai)
#pragma unroll
            for (int m = 0; m < 4; ++m) {
                const int rl = ai * HALF + wr * 64 + m * 16 + fr; const float rs = rsv[ai][m];
                const float gB = (-1.5957691216057308f * 1.4426950408889634f) * rs, gA = 0.044715f * gB * rs * rs, rinv = __builtin_amdgcn_rcpf(rs);
                bf16_t* rowp = UV + (size_t)(u.pm * BM + rl) * 2048 + u.pn * BM + wc * 32 + 8 * fq; float s1 = 0.f, s2 = 0.f;
#pragma unroll
                for (int bj = 0; bj < 2; ++bj) { f32x4 v0 = acc[ai][bj][m][0], v1 = acc[ai][bj][m][1];
#pragma unroll
                    for (int e = 0; e < 4; e += 2) { const f32x2 a = gelu_tanh_fold((f32x2){v0[e], v0[e + 1]}, gA, gB, rinv), b = gelu_tanh_fold((f32x2){v1[e], v1[e + 1]}, gA, gB, rinv); v0[e] = a.x; v0[e + 1] = a.y; v1[e] = b.x; v1[e + 1] = b.y;
                        const f32x2 sm = a + b, sq = a * a + b * b; s1 += sm.x + sm.y; s2 += sq.x + sq.y; }
                    u32x4 w; w.x = cvt_pk_bf16(v0[0], v0[1]); w.y = cvt_pk_bf16(v0[2], v0[3]); w.z = cvt_pk_bf16(v1[0], v1[1]); w.w = cvt_pk_bf16(v1[2], v1[3]);
                    *(u32x4*)(rowp + bj * HALF) = w; }
                s1 = sum32(sum16(s1)); s2 = sum32(sum16(s2));
                if (fq == 0) T2[rl * 4 + wc] = (f32x2){s1, s2};
            }
        EPI_BAR();
        if (u.pn >= 4 && tid < 256) { const f32x2 p0 = T2[tid * 4 + 0], p1 = T2[tid * 4 + 1], p2 = T2[tid * 4 + 2], p3 = T2[tid * 4 + 3];
            VST[(size_t)(u.pm * BM + tid) * 4 + (u.pn - 4)] = (f32x2){(p0.x + p1.x) + (p2.x + p3.x), (p0.y + p1.y) + (p2.y + p3.y)}; }
    }
};

struct EpiSwiGLU8 {
    static constexpr bool PERM = true;
    unsigned char* ACT8;
    __device__ __forceinline__ void operator()(acc_t& acc, const Unit& u, int wr, int wc, int fr, int fq, int tid) const {
#pragma unroll
        for (int ai = 0; ai < 2; ++ai)
#pragma unroll
            for (int m = 0; m < 4; m += 2) { u32x2 w[2];
#pragma unroll
                for (int h = 0; h < 2; ++h) { float o[8];
#pragma unroll
                    for (int n = 0; n < 2; ++n)
#pragma unroll
                        for (int e = 0; e < 4; e += 2) { const f32x2 g = (f32x2){acc[ai][0][m + h][n][e], acc[ai][0][m + h][n][e + 1]}, up = (f32x2){acc[ai][1][m + h][n][e], acc[ai][1][m + h][n][e + 1]};
                            const f32x2 r = silu_mul_fold(g, up, -1.4426950408889634f * W8_INV, W8_SCALE * W8_SCALE); o[n * 4 + e] = r.x; o[n * 4 + e + 1] = r.y; }
                    w[h].x = pk4_fp8(o[0], o[1], o[2], o[3]); w[h].y = pk4_fp8(o[4], o[5], o[6], o[7]); }
                const int rl = ai * HALF + wr * 64 + (m + (fq & 1)) * 16 + fr;
                *(u32x4*)(ACT8 + (size_t)(u.aux * BM + rl) * DFF + 128 * u.pn + wc * 32 + 8 * (fq & 2)) = pair16(w[0], w[1]);
            }
    }
};
struct EpiMoeDown8 {
    static constexpr bool PERM = true;
    bf16_t* Y; const float* SGW;
    __device__ __forceinline__ void operator()(acc_t& acc, const Unit& u, int wr, int wc, int fr, int fq, int tid) const {
        const int col0 = u.pn * BM + wc * 32 + 8 * fq;
        float gwv[2][4];
#pragma unroll
        for (int ai = 0; ai < 2; ++ai)
#pragma unroll
            for (int m = 0; m < 4; ++m) { const int rl = ai * HALF + wr * 64 + m * 16 + fr, mx = u.aux2 - 1; gwv[ai][m] = SGW[u.pm + (rl < mx ? rl : mx)] * W8_INV; }
#pragma unroll
        for (int ai = 0; ai < 2; ++ai)
#pragma unroll
            for (int m = 0; m < 4; ++m) {
                const int rl = ai * HALF + wr * 64 + m * 16 + fr; const float gw = gwv[ai][m];
                bf16_t* rowp = Y + (size_t)(u.aux * BM + rl) * DM + col0;
#pragma unroll
                for (int bj = 0; bj < 2; ++bj) { const f32x4 v0 = acc[ai][bj][m][0] * gw, v1 = acc[ai][bj][m][1] * gw;
                    u32x4 o; o.x = cvt_pk_bf16(v0[0], v0[1]); o.y = cvt_pk_bf16(v0[2], v0[3]); o.z = cvt_pk_bf16(v1[0], v1[1]); o.w = cvt_pk_bf16(v1[2], v1[3]);
                    *(u32x4*)(rowp + bj * HALF) = o; }
            }
    }
};
#define XB_TMO      128
#define XB_XCNT(j)  (256  + 64 * (j))
#define XB_XSUB(j)  (1280 + 64 * (j))
#define XB_XGEN(j)  (2304 + 64 * (j))
#define XB_TOP      3328
#define XB_TOPGEN   3392
#define XCD_BAR_WORDS 3456
#define XB_SPIN_CAP (1u << 18)
__device__ __forceinline__ unsigned xb_ld(unsigned* p)              { return __hip_atomic_load(p, __ATOMIC_RELAXED, __HIP_MEMORY_SCOPE_AGENT); }
__device__ __forceinline__ unsigned xb_add(unsigned* p, unsigned v) { return __hip_atomic_fetch_add(p, v, __ATOMIC_RELAXED, __HIP_MEMORY_SCOPE_AGENT); }
__device__ __forceinline__ unsigned xb_xcc_id() { return (unsigned)__builtin_amdgcn_s_getreg((3 << 11) | 20) & 0xFu; }
#define XB_SPIN(cond, bar) do { unsigned _sp = 0; while (cond) { __builtin_amdgcn_s_sleep(1); \
    if ((++_sp & 255u) == 0u) { if (xb_ld(&(bar)[XB_TMO])) break; if (_sp > XB_SPIN_CAP) { atomicAdd(&(bar)[XB_TMO], 1u); break; } } } } while (0)
struct XcdBarrier { unsigned* bar; unsigned x; volatile LAS unsigned* st; };
__device__ __forceinline__ XcdBarrier xcd_barrier_post(unsigned* bar, volatile LAS unsigned* st) {
    XcdBarrier b; b.bar = bar; b.x = xb_xcc_id(); b.st = st;
    if (threadIdx.x == 0) (void)xb_add(&bar[XB_XCNT(b.x)], 1u);
    return b;
}
__device__ __forceinline__ void xcd_barrier_complete(unsigned* bar, unsigned x, unsigned& nloc, unsigned& nx) {
    const unsigned G = gridDim.x * gridDim.y * gridDim.z;
    unsigned sum, cnt, mine, sp = 0u;
    for (;;) {
        sum = 0u; cnt = 0u; mine = 0u;
#pragma unroll
        for (unsigned j = 0; j < 16; ++j) { const unsigned c = xb_ld(&bar[XB_XCNT(j)]); sum += c; cnt += (c > 0u) ? 1u : 0u; mine = (j == x) ? c : mine; }
        if (sum == G) break;
        __builtin_amdgcn_s_sleep(1);
        if ((++sp & 255u) == 0u) { if (xb_ld(&bar[XB_TMO])) break; if (sp > XB_SPIN_CAP) { atomicAdd(&bar[XB_TMO], 1u); break; } }
    }
    nloc = mine > 0u ? mine : 1u; nx = cnt > 0u ? cnt : 1u;
}
__device__ __forceinline__ void xcd_barrier(const XcdBarrier& b) {
    asm volatile("s_waitcnt vmcnt(0)" ::: "memory");
    __syncthreads();
    if (threadIdx.x == 0) {
        unsigned* bar = b.bar;
        __builtin_amdgcn_s_waitcnt(0);
        unsigned nloc = b.st[0], nx = b.st[1];
        if (nloc == 0u) { xcd_barrier_complete(bar, b.x, nloc, nx); b.st[0] = nloc; b.st[1] = nx; }
        const unsigned old = xb_add(&bar[XB_XSUB(b.x)], 1u);
        const unsigned gen = old / nloc;
        if (old + 1u == (gen + 1u) * nloc) {
            __builtin_amdgcn_fence(__ATOMIC_RELEASE, "agent");
            asm volatile("s_waitcnt vmcnt(0)" ::: "memory");
            const unsigned og = xb_add(&bar[XB_TOP], 1u);
            const unsigned tg = og / nx;
            if (og + 1u == (tg + 1u) * nx) xb_add(&bar[XB_TOPGEN], 1u);
            else XB_SPIN(xb_ld(&bar[XB_TOPGEN]) == tg, bar);
            __builtin_amdgcn_fence(__ATOMIC_ACQUIRE, "agent");
            xb_add(&bar[XB_XGEN(b.x)], 1u);
            asm volatile("s_waitcnt vmcnt(0)" ::: "memory");
        } else {
            XB_SPIN(xb_ld(&bar[XB_XGEN(b.x)]) == gen, bar);
            __builtin_amdgcn_fence(__ATOMIC_ACQUIRE, "agent");
            asm volatile("s_waitcnt vmcnt(0)" ::: "memory");
        }
    }
    __syncthreads();
}

struct Args { const float* in[31]; float* out; unsigned char* ws; int ph_lo, ph_hi; };
struct Frame { LAS unsigned char* lds; int tid, lane, wave, G, bx; float* H; unsigned char* ws; };
__device__ __forceinline__ const float* karg_in(int k) { typedef const float* __attribute__((address_space(4))) const* kp_t; return ((kp_t)__builtin_amdgcn_kernarg_segment_ptr())[k]; }

__device__ __forceinline__ void transpose_item(const float* W, int ldw, int k0, int n0, bf16_t* WT, int K, int dst_row0, const float* gk, LAS float* scr, int lane) {
    f32x4 tv[16]; float gv[16]; const int kr = lane >> 4, c4 = (lane & 15) * 4;
    const float* gs = gk ? gk : W; const float gm = gk ? 1.0f : 0.0f;
#pragma unroll
    for (int i = 0; i < 16; ++i) gv[i] = gs[k0 + 4 * i + kr];
#pragma unroll
    for (int i = 0; i < 16; ++i) tv[i] = __builtin_nontemporal_load((const f32x4*)(W + (size_t)(k0 + 4 * i + kr) * ldw + n0 + c4));
#pragma unroll
    for (int i = 0; i < 16; ++i) { const int k = 4 * i + kr; const float g = __builtin_fmaf(gv[i], gm, 1.0f - gm); *(LAS f32x4*)(scr + k * 64 + (c4 ^ (((k >> 3) & 7) << 3))) = tv[i] * g; }
    LDS_WAIT(); asm volatile("" ::: "memory");
    const int c = lane & 7;
#pragma unroll
    for (int j = 0; j < 8; ++j) { const int n = (lane >> 3) + 8 * j; const LAS float* s = scr + (8 * c) * 64 + (n ^ (c << 3));
        u32x4 o; o.x = cvt_pk_bf16(s[0 * 64], s[1 * 64]); o.y = cvt_pk_bf16(s[2 * 64], s[3 * 64]); o.z = cvt_pk_bf16(s[4 * 64], s[5 * 64]); o.w = cvt_pk_bf16(s[6 * 64], s[7 * 64]);
        *(u32x4*)(WT + (size_t)(dst_row0 + n) * K + k0 + 8 * c) = o; }
    LDS_WAIT(); asm volatile("" ::: "memory");
}
__device__ __forceinline__ void transpose_item_fp8(const float* W, int ldw, int k0, int n0, unsigned char* WT8, int K, int dst_row0, const float* gk, float scale, LAS float* scr, int lane) {
    f32x4 tv[16]; float gv[16]; const int kr = lane >> 4, c4 = (lane & 15) * 4;
    const float* gs = gk ? gk : W; const float gm = gk ? 1.0f : 0.0f;
#pragma unroll
    for (int i = 0; i < 16; ++i) gv[i] = gs[k0 + 4 * i + kr];
#pragma unroll
    for (int i = 0; i < 16; ++i) tv[i] = __builtin_nontemporal_load((const f32x4*)(W + (size_t)(k0 + 4 * i + kr) * ldw + n0 + c4));
#pragma unroll
    for (int i = 0; i < 16; ++i) { const int k = 4 * i + kr; const float g = __builtin_fmaf(gv[i], gm * scale, (1.0f - gm) * scale); *(LAS f32x4*)(scr + k * 64 + (c4 ^ (((k >> 3) & 7) << 3))) = tv[i] * g; }
    LDS_WAIT(); asm volatile("" ::: "memory");
    const int c = lane & 3;
#pragma unroll
    for (int j = 0; j < 4; ++j) { const int n = (lane >> 2) + 16 * j; float v[16];
#pragma unroll
        for (int e = 0; e < 16; ++e) v[e] = scr[(16 * c + e) * 64 + (n ^ (((2 * c + (e >> 3)) & 7) << 3))];
        u32x4 o; o.x = pk4_fp8(v[0], v[1], v[2], v[3]); o.y = pk4_fp8(v[4], v[5], v[6], v[7]); o.z = pk4_fp8(v[8], v[9], v[10], v[11]); o.w = pk4_fp8(v[12], v[13], v[14], v[15]);
        __builtin_nontemporal_store(o, (u32x4*)(WT8 + (size_t)(dst_row0 + n) * K + k0 + 16 * c)); }
    LDS_WAIT(); asm volatile("" ::: "memory");
}
__device__ __forceinline__ int glu5_map(int n0) {
    if (n0 < 512) return 256 * (n0 >> 7) + (n0 & 127);
    if (n0 < 1024) { const int c = n0 - 512; return 256 * (c >> 7) + 128 + (c & 127); }
    if (n0 < 1536) return n0;
    if (n0 < 2048) { const int c = n0 - 1536; return 1536 + 256 * (c >> 7) + (c & 127); }
    const int c = n0 - 2048; return 1536 + 256 * (c >> 7) + 128 + (c & 127);
}
__device__ __forceinline__ int gu_map(int n0, int up) { return 256 * (n0 >> 7) + 128 * up + (n0 & 127); }

template <int MAP  >
__device__ __forceinline__ void conv_matrix(const float* W, int ldw, int nkb, int nnb, bf16_t* WT, int K, int up, const float* gk, int item0, int gw, int NGW, LAS float* scr, int lane) {
    const int n = nkb * nnb; int first = (gw - item0) % NGW; if (first < 0) first += NGW;
    for (int r = first; r < n; r += NGW) { const int kb = r / nnb, nb = r % nnb;
        const int dst = MAP == 0 ? 64 * nb : (MAP == 1 ? glu5_map(64 * nb) : gu_map(64 * nb, up));
        transpose_item(W, ldw, 64 * kb, 64 * nb, WT, K, dst, gk, scr, lane); }
}
template <int MAP>
__device__ __forceinline__ void conv_matrix8(const float* W, int ldw, int nkb, int nnb, unsigned char* WT8, int K, int up, const float* gk, float scale, int item0, int gw, int NGW, LAS float* scr, int lane) {
    const int n = nkb * nnb; int first = (gw - item0) % NGW; if (first < 0) first += NGW;
    for (int r = first; r < n; r += NGW) { const int kb = r / nnb, nb = r % nnb;
        const int dst = MAP == 0 ? 64 * nb : gu_map(64 * nb, up);
        transpose_item_fp8(W, ldw, 64 * kb, 64 * nb, WT8, K, dst, gk, scale, scr, lane); }
}
constexpr int BG_PER_E = 3 * 704, BG_HEAD = FK_FFN8 ? 2 * 704 : 0, BG_ITEMS = BG_HEAD + NEXP * BG_PER_E, CW_BGQ = 6144;
__device__ __forceinline__ void bg_item(Frame& F, int idx) {
    LAS float* scr = (LAS float*)(F.lds + RING_OFF + F.wave * 16384);
    if (idx < BG_HEAD) { const int which = idx / 704, r = idx - which * 704, kb = r / 44, nb = r - kb * 44;
        transpose_item_fp8(karg_in(18 + which), 2816, 64 * kb, 64 * nb, (unsigned char*)(F.ws + WS_WGU0), 1024, gu_map(64 * nb, which), karg_in(5), W8_SCALE, scr, F.lane); return; }
    idx -= BG_HEAD;
    const int e = idx / BG_PER_E, rem = idx - e * BG_PER_E, which = rem / 704, r = rem - which * 704;
    const bool gu = which < 2; const int nnb = gu ? 44 : 16, kb = r / nnb, nb = r - kb * nnb;
    const float* W = karg_in(28 + which) + (size_t)e * DM * DFF;
    unsigned char* WT8 = gu ? (unsigned char*)(F.ws + WS_WGU1) + (size_t)e * 5632 * DM : (unsigned char*)(F.ws + WS_WD1) + (size_t)e * DM * DFF;
    transpose_item_fp8(W, gu ? 2816 : 1024, 64 * kb, 64 * nb, WT8, gu ? 1024 : 2816, gu ? gu_map(64 * nb, which) : 64 * nb, gu ? karg_in(5) + DM : nullptr, W8_SCALE, scr, F.lane);
}
__device__ __forceinline__ void bg_claim(Frame& F, volatile LAS unsigned* q) {
    unsigned base = (unsigned)BG_ITEMS;
    if (!q[5]) { base = xb_add((unsigned*)(F.ws + WS_CTL) + CW_BGQ, 8u); if (base >= (unsigned)BG_ITEMS) q[5] = 1u; }
    q[3] = base;
}
__device__ __forceinline__ void bg_drain_to(Frame& F, volatile LAS unsigned* q, const unsigned need) {
    for (;;) {
        if (F.tid == 0) { if (q[5] || xb_ld((unsigned*)(F.ws + WS_CTL) + CW_BGQ) >= need) q[3] = (unsigned)BG_ITEMS; else bg_claim(F, q); }
        LDS_WAIT(); __syncthreads();
        const unsigned base = q[3];
        if (base >= (unsigned)BG_ITEMS) break;
        bg_item(F, (int)base + F.wave);
        LDS_WAIT(); __syncthreads();
    }
}
__device__ __forceinline__ void xcd_barrier_bg(const XcdBarrier& b, Frame& F) {
    asm volatile("s_waitcnt vmcnt(0)" ::: "memory");
    __syncthreads();
    volatile LAS unsigned* q = b.st + 4;
    if (threadIdx.x == 0) {
        unsigned* bar = b.bar;
        __builtin_amdgcn_s_waitcnt(0);
        unsigned nloc = b.st[0], nx = b.st[1];
        if (nloc == 0u) { xcd_barrier_complete(bar, b.x, nloc, nx); b.st[0] = nloc; b.st[1] = nx; }
        const unsigned old = xb_add(&bar[XB_XSUB(b.x)], 1u);
        const unsigned gen = old / nloc;
        if (old + 1u == (gen + 1u) * nloc) {
            __builtin_amdgcn_fence(__ATOMIC_RELEASE, "agent");
            asm volatile("s_waitcnt vmcnt(0)" ::: "memory");
            const unsigned og = xb_add(&bar[XB_TOP], 1u);
            const unsigned tg = og / nx;
            if (og + 1u == (tg + 1u) * nx) xb_add(&bar[XB_TOPGEN], 1u);
            else XB_SPIN(xb_ld(&bar[XB_TOPGEN]) == tg, bar);
            __builtin_amdgcn_fence(__ATOMIC_ACQUIRE, "agent");
            xb_add(&bar[XB_XGEN(b.x)], 1u);
            asm volatile("s_waitcnt vmcnt(0)" ::: "memory");
            q[0] = 0u;
        } else { q[0] = 1u; q[1] = gen; }
    }
    LDS_WAIT(); __syncthreads();
    if (q[0]) {
        unsigned* bar = b.bar; const unsigned gen = q[1]; unsigned sp = 0u;
        for (;;) {
            if (threadIdx.x == 0) {
                bool rel = xb_ld(&bar[XB_XGEN(b.x)]) != gen;
                if (!rel && (++sp & 63u) == 0u) { if (xb_ld(&bar[XB_TMO])) rel = true; else if (sp > XB_SPIN_CAP) { atomicAdd(&bar[XB_TMO], 1u); rel = true; } }
                q[2] = rel ? 1u : 0u; if (!rel) bg_claim(F, q);
            }
            LDS_WAIT(); __syncthreads();
            const unsigned rel = q[2], base = q[3];
            if (rel) break;
            if (base < (unsigned)BG_ITEMS) bg_item(F, (int)base + F.wave); else __builtin_amdgcn_s_sleep(4);
            LDS_WAIT(); __syncthreads();
        }
        if (threadIdx.x == 0) { __builtin_amdgcn_fence(__ATOMIC_ACQUIRE, "agent"); asm volatile("s_waitcnt vmcnt(0)" ::: "memory"); }
        __syncthreads();
    }
}
#ifdef FK_TPROBE
#define P0_TP_BEGIN(k) do { if ((k) == FK_TPROBE && blockIdx.x == 0 && threadIdx.x == 0) *(volatile unsigned long long*)(F.ws + 32768) = __builtin_amdgcn_s_memrealtime(); } while (0)
#define P0_TP_END(k) do { if ((k) == FK_TPROBE && blockIdx.x == 0 && threadIdx.x == 0) *(volatile unsigned long long*)(F.ws + 32776) = __builtin_amdgcn_s_memrealtime() - *(volatile unsigned long long*)(F.ws + 32768); } while (0)
#else
#define P0_TP_BEGIN(k) do { } while (0)
#define P0_TP_END(k) do { } while (0)
#endif
#ifndef FK_XSPLIT
#define FK_XSPLIT 16384
#endif
constexpr int X_SPLIT = FK_XSPLIT;
__device__ __forceinline__ void x_rows(Frame& F, int rbeg, int rend, int w, int nw) {
    const int lane = F.lane; unsigned char* ws = F.ws;
    for (int r0 = rbeg + 4 * w; r0 < rend; r0 += 4 * nw) {
        f32x4 v[4][4];
#pragma unroll
        for (int q = 0; q < 4; ++q) { const f32x4* src = (const f32x4*)(karg_in(0) + (size_t)(r0 + q) * DM) + lane;
#pragma unroll
            for (int j = 0; j < 4; ++j) v[q][j] = __builtin_nontemporal_load(src + 64 * j); }
#pragma unroll
        for (int q = 0; q < 4; ++q) { const int r = r0 + q; u32x2* dst = (u32x2*)((bf16_t*)(ws + WS_HB) + (size_t)r * DM) + lane; float s = 0.f;
#pragma unroll
            for (int j = 0; j < 4; ++j) s += (v[q][j][0] * v[q][j][0] + v[q][j][1] * v[q][j][1]) + (v[q][j][2] * v[q][j][2] + v[q][j][3] * v[q][j][3]);
            s = wave_sum(s);
#pragma unroll
            for (int j = 0; j < 4; ++j) { u32x2 w2; w2.x = cvt_pk_bf16(v[q][j][0], v[q][j][1]); w2.y = cvt_pk_bf16(v[q][j][2], v[q][j][3]); dst[64 * j] = w2; }
            if (lane == 0) *(f32x4*)((float*)(ws + WS_RSS) + (size_t)r * 4) = (f32x4){s, 0.f, 0.f, 0.f}; } }
}
__device__ __forceinline__ void p0_prologue(Frame& F) {
    LAS float* scr = (LAS float*)(F.lds + RING_OFF + F.wave * 16384);
    const int gw = F.bx * 8 + F.wave, NGW = F.G * 8, lane = F.lane;
    unsigned char* ws = F.ws;
    constexpr int I_SQ = 256, I_WIN = 16 * 40, I_GU = 16 * 44, I_DN = 44 * 16, I_SG = 16 * 32;
    int o = 0;
    conv_matrix<1>(karg_in(11), 2560, 16, 40, (bf16_t*)(ws + WS_WIN0), 1024, 0, karg_in(2), o, gw, NGW, scr, lane); o += I_WIN;
    conv_matrix<0>(karg_in(17), 1024, 16, 16, (bf16_t*)(ws + WS_WOUT0), 1024, 0, nullptr, o, gw, NGW, scr, lane); o += I_SQ;
#if FK_FFN8
#else
    conv_matrix<2>(karg_in(18), 2816, 16, 44, (bf16_t*)(ws + WS_WGU0), 1024, 0, karg_in(5), o, gw, NGW, scr, lane); o += I_GU;
    conv_matrix<2>(karg_in(19), 2816, 16, 44, (bf16_t*)(ws + WS_WGU0), 1024, 1, karg_in(5), o, gw, NGW, scr, lane); o += I_GU;
#endif
    conv_matrix<0>(karg_in(20), 1024, 44, 16, (bf16_t*)(ws + WS_WD0), 2816, 0, nullptr, o, gw, NGW, scr, lane); o += I_DN;
    for (int l = 0; l < 2; ++l) {
        conv_matrix<0>(karg_in(10) + (size_t)l * DM * DM, 1024, 16, 16, (bf16_t*)(ws + WS_WOT) + (size_t)l * DM * DM, 1024, 0, nullptr, o, gw, NGW, scr, lane); o += I_SQ;
        conv_matrix<0>(karg_in(8) + (size_t)l * DM * DM, 1024, 16, 16, (bf16_t*)(ws + WS_WKT) + (size_t)l * DM * DM, 1024, 0, nullptr, o, gw, NGW, scr, lane); o += I_SQ;
        conv_matrix<0>(karg_in(9) + (size_t)l * DM * DM, 1024, 16, 16, (bf16_t*)(ws + WS_WKT) + (size_t)(2 + l) * DM * DM, 1024, 0, nullptr, o, gw, NGW, scr, lane); o += I_SQ;
    }
    conv_matrix<0>(karg_in(21), 2048, 16, 32, (bf16_t*)(ws + WS_WSG), 1024, 0, karg_in(2) + DM, o, gw, NGW, scr, lane); o += I_SG;
    conv_matrix<0>(karg_in(26), 1024, 16, 16, (bf16_t*)(ws + WS_WSO), 1024, 0, nullptr, o, gw, NGW, scr, lane); o += I_SQ;
    for (int r = gw; r < 2 * DM; r += NGW) { const int l = r >> 10, k = r & 1023; const float g = karg_in(3)[l * DM + k] * 0.0625f;
        const f32x4* src = (const f32x4*)(karg_in(7) + (size_t)r * DM) + lane; u32x2* dst = (u32x2*)((bf16_t*)(ws + WS_WQS) + (size_t)r * DM) + lane;
#pragma unroll
        for (int j = 0; j < 4; ++j) { const f32x4 v = src[64 * j] * g; u32x2 w; w.x = cvt_pk_bf16(v[0], v[1]); w.y = cvt_pk_bf16(v[2], v[3]); dst[64 * j] = w; } }
    for (int r = gw; r < 2 * 4 * MEML; r += NGW) { const int l = r >> 10, mr = r & 1023;
        const f32x4* src = (const f32x4*)(karg_in(1) + (size_t)mr * DM) + lane; const f32x4* gg = (const f32x4*)(karg_in(4) + l * DM) + lane;
        u32x2* dst = (u32x2*)((bf16_t*)(ws + WS_MEMN) + (size_t)r * DM) + lane; f32x4 v[4]; float s = 0.f;
#pragma unroll
        for (int j = 0; j < 4; ++j) { v[j] = src[64 * j]; s += (v[j][0] * v[j][0] + v[j][1] * v[j][1]) + (v[j][2] * v[j][2] + v[j][3] * v[j][3]); }
        const float rs = rsqrtf(wave_sum(s) * (1.0f / DM) + 1e-6f);
#pragma unroll
        for (int j = 0; j < 4; ++j) { const f32x4 o = v[j] * rs * gg[64 * j]; u32x2 w; w.x = cvt_pk_bf16(o[0], o[1]); w.y = cvt_pk_bf16(o[2], o[3]); dst[64 * j] = w; } }
    x_rows(F, 0, X_SPLIT, gw, NGW);
}

struct KvOrder {
    const char* memn; const char* wkt; int G, c;
    __device__ __forceinline__ bool next(int i, Unit& u) const { const int L = i * G + c; if (L >= 64) return false;
        const int which = L >> 4, t = L & 15, l = which & 1; u.pm = t >> 2; u.pn = t & 3; u.aux = which;
        u.A = memn + ((size_t)l * DM * DM + (size_t)u.pm * BM * DM) * 2; u.B = wkt + ((size_t)which * DM * DM + (size_t)u.pn * BM * DM) * 2; return true; }
};
struct MkVwOrder {
    const char* kp; const char* wqs; const char* wot; int G, c;
    __device__ __forceinline__ bool next(int i, Unit& u) const { const int L = i * G + c; if (L >= 256) return false;
        const int vw = L >> 7, q = L & 127, l = q >> 6, b = (q >> 4) & 3, hd = (q >> 2) & 3, t = q & 3;
        if (!vw) { u.pm = hd; u.pn = t; u.aux = l * 4 + b;
            u.A = kp + ((size_t)l * DM * DM + (size_t)(b * MEML) * DM + hd * 256) * 2; u.B = wqs + ((size_t)l * DM * DM + (size_t)(t * BM) * DM + hd * 256) * 2; }
        else { u.pm = t; u.pn = hd; u.aux = 8 + l * 4 + b;
            u.A = wot + ((size_t)l * DM * DM + (size_t)(t * BM) * DM + hd * 256) * 2; u.B = kp + ((size_t)(2 + l) * DM * DM + (size_t)(b * MEML) * DM + hd * 256) * 2; }
        return true; }
};

__device__ __forceinline__ void conv_phase(Frame& F) {
    const int tid = F.tid, half = tid >> 8, t2 = tid & 255, c0 = 2 * t2, wih = (tid >> 6) & 3, lane = F.lane;
    const bf16_t* ZB = (const bf16_t*)(F.ws + WS_ZB); bf16_t* MIX = (bf16_t*)(F.ws + WS_MIX);
    LAS float* RED = (LAS float*)(F.lds + RING_OFF);
    f32x2 wa[31], wb[3];
#pragma unroll
    for (int k = 0; k < 31; ++k) wa[k] = *(const f32x2*)(karg_in(12) + k * 512 + c0);
#pragma unroll
    for (int k = 0; k < 3; ++k) wb[k] = *(const f32x2*)(karg_in(16) + k * 512 + c0);
    const f32x2 bias = *(const f32x2*)(karg_in(13) + c0), lg = *(const f32x2*)(karg_in(14) + c0), lb = *(const f32x2*)(karg_in(15) + c0);
    unsigned xin[38], gb[8], gh[10];
#define CONV_LOAD(it_) do { const int blk_ = (F.bx * 8 + (it_)) * 2 + half, tk_ = blk_ * 8, tp_ = tk_ & (SEQL - 1); \
        _Pragma("unroll") for (int j = 0; j < 38; ++j) { const int pos = tp_ - 30 + j; xin[j] = (pos >= 0) ? *(const unsigned*)(ZB + (size_t)(tk_ - 30 + j) * ZW + c0) : 0u; } \
        _Pragma("unroll") for (int j = 0; j < 8; ++j) gb[j] = __builtin_nontemporal_load((const unsigned*)(ZB + (size_t)(tk_ + j) * ZW + 512 + c0)); \
        _Pragma("unroll") for (int j = 0; j < 10; ++j) { const int pos = tp_ - 2 + j; gh[j] = (pos >= 0) ? *(const unsigned*)(ZB + (size_t)(tk_ - 2 + j) * ZW + 1024 + c0) : 0u; } } while (0)
    CONV_LOAD(0);
    for (int it = 0; it < 8; ++it) {
        const int blk = (F.bx * 8 + it) * 2 + half, tok0 = blk * 8;
        f32x2 a[8], bo[8];
#pragma unroll
        for (int o = 0; o < 8; ++o) a[o] = bias;
#pragma unroll
        for (int j = 0; j < 38; ++j) { const f32x2 x = (f32x2){bf_lo(xin[j]), bf_hi(xin[j])};
#pragma unroll
            for (int o = 0; o < 8; ++o) { const int k = j - o; if (k >= 0 && k < 31) a[o] = __builtin_elementwise_fma(wa[k], x, a[o]); } }
#pragma unroll
        for (int o = 0; o < 8; ++o) { f32x2 b = (f32x2){0.f, 0.f};
#pragma unroll
            for (int k = 0; k < 3; ++k) b = __builtin_elementwise_fma(wb[k], (f32x2){bf_lo(gh[o + k]), bf_hi(gh[o + k])}, b);
            bo[o] = b * (f32x2){bf_lo(gb[o]), bf_hi(gb[o])}; }
        if (it < 7) CONV_LOAD(it + 1);
        {
          float v16[16];
#pragma unroll
          for (int o = 0; o < 8; ++o) { const f32x2 sq = a[o] * a[o]; v16[2 * o] = a[o].x + a[o].y; v16[2 * o + 1] = sq.x + sq.y; }
          float v8[8], v4[4], v2[2], v1;
#pragma unroll
          for (int i = 0; i < 8; ++i) v8[i] = tr32(v16[i], v16[i + 8]);
#pragma unroll
          for (int i = 0; i < 4; ++i) v4[i] = tr16(v8[i], v8[i + 4]);
#pragma unroll
          for (int i = 0; i < 2; ++i) v2[i] = tr8(v4[i], v4[i + 2], lane);
          v1 = tr4(v2[0], v2[1], lane);
          v1 += dpp<DPP_XOR2>(v1); v1 += dpp<DPP_XOR1>(v1);
          if ((lane & 3) == 0) RED[(it & 1) * 128 + (half * 4 + wih) * 16 + ((lane >> 2) & 15)] = v1; }
        LDS_WAIT(); __syncthreads();
#pragma unroll
        for (int o = 0; o < 8; ++o) { float s1 = 0.f, s2 = 0.f;
#pragma unroll
            for (int w = 0; w < 4; ++w) { s1 += RED[(it & 1) * 128 + ((half * 4 + w) * 8 + o) * 2 + 0]; s2 += RED[(it & 1) * 128 + ((half * 4 + w) * 8 + o) * 2 + 1]; }
            const float mu = s1 * (1.0f / 512.f), var = s2 * (1.0f / 512.f) - mu * mu, rstd = rsqrtf(fmaxf(var, 0.f) + 1e-5f);
            const f32x2 y = (a[o] - mu) * rstd * lg + lb;
            *(unsigned*)(MIX + (size_t)(tok0 + o) * DM + c0) = cvt_pk_bf16(y.x * fast_sigmoid(y.x), y.y * fast_sigmoid(y.y));
            *(unsigned*)(MIX + (size_t)(tok0 + o) * DM + 512 + c0) = cvt_pk_bf16(bo[o].x, bo[o].y); }
    }
#undef CONV_LOAD
}

__device__ __forceinline__ void spatial_phase(Frame& F) {
    const int tid = F.tid, lane = F.lane, wv = F.wave, fr = lane & 15, fq = lane >> 4, g = F.bx & 7;
    constexpr int RS = 272;
    LAS unsigned char* WL = F.lds + RING_OFF;
    LAS unsigned char* VT = F.lds + RING_OFF + 128 * RS;
    const bf16_t* UV = (const bf16_t*)(F.ws + WS_UV); bf16_t* US = (bf16_t*)(F.ws + WS_US); const f32x4* VST = (const f32x4*)(F.ws + WS_VST);
    { const int i = tid >> 2, jq = (tid & 3) * 32; const float* src = karg_in(24) + ((size_t)g * 128 + i) * 128 + jq;
#pragma unroll
        for (int q = 0; q < 4; ++q) { const f32x4 a = *(const f32x4*)(src + 8 * q), b = *(const f32x4*)(src + 8 * q + 4); const bool ok = ((jq + 8 * q) >> 6) <= (i >> 6);
            u32x4 w; w.x = cvt_pk_bf16(a[0], a[1]); w.y = cvt_pk_bf16(a[2], a[3]); w.z = cvt_pk_bf16(b[0], b[1]); w.w = cvt_pk_bf16(b[2], b[3]);
            if (!ok) w = (u32x4){0u, 0u, 0u, 0u}; *(LAS u32x4*)(WL + i * RS + (jq + 8 * q) * 2) = w; } }
    const int j = tid >> 2, cq = (tid & 3) * 8;
    f32x4 lgv[8], lbv[8];
#pragma unroll
    for (int q = 0; q < 8; ++q) { lgv[q] = *(const f32x4*)(karg_in(22) + g * 128 + cq + 32 * (q >> 1) + 4 * (q & 1)); lbv[q] = *(const f32x4*)(karg_in(23) + g * 128 + cq + 32 * (q >> 1) + 4 * (q & 1)); }
    u32x4 vw[4]; f32x4 st0, st1;
#define SP_LOADV(r_) do { const size_t tk_ = (size_t)((F.bx >> 3) + 32 * (r_)) * 128 + j; st0 = VST[tk_ * 2]; st1 = VST[tk_ * 2 + 1]; const bf16_t* vr_ = UV + tk_ * 2048 + 1024 + g * 128 + cq; \
        _Pragma("unroll") for (int q = 0; q < 4; ++q) vw[q] = __builtin_nontemporal_load((const u32x4*)(vr_ + 32 * q)); } while (0)
#define SP_NORM(vb) do { LAS unsigned char* VTw = VT + (vb) * (128 * RS); \
        const float s1 = (st0[0] + st0[2]) + (st1[0] + st1[2]), s2 = (st0[1] + st0[3]) + (st1[1] + st1[3]); \
        const float mu = s1 * (1.0f / 1024.f), var = s2 * (1.0f / 1024.f) - mu * mu, rstd = rsqrtf(fmaxf(var, 0.f) + 1e-5f); \
        _Pragma("unroll") for (int q = 0; q < 4; ++q) { const u32x4 w = vw[q]; \
            const float v[8] = {bf_lo(w.x), bf_hi(w.x), bf_lo(w.y), bf_hi(w.y), bf_lo(w.z), bf_hi(w.z), bf_lo(w.w), bf_hi(w.w)}; \
            const float gg[8] = {lgv[2 * q][0], lgv[2 * q][1], lgv[2 * q][2], lgv[2 * q][3], lgv[2 * q + 1][0], lgv[2 * q + 1][1], lgv[2 * q + 1][2], lgv[2 * q + 1][3]}; \
            const float bbv[8] = {lbv[2 * q][0], lbv[2 * q][1], lbv[2 * q][2], lbv[2 * q][3], lbv[2 * q + 1][0], lbv[2 * q + 1][1], lbv[2 * q + 1][2], lbv[2 * q + 1][3]}; \
            _Pragma("unroll") for (int e = 0; e < 8; e += 2) { const unsigned pk = cvt_pk_bf16((v[e] - mu) * rstd * gg[e] + bbv[e], (v[e + 1] - mu) * rstd * gg[e + 1] + bbv[e + 1]); \
                *(LAS unsigned short*)(VTw + (cq + 32 * q + e) * RS + j * 2) = (unsigned short)(pk & 0xffffu); \
                *(LAS unsigned short*)(VTw + (cq + 32 * q + e + 1) * RS + j * 2) = (unsigned short)(pk >> 16); } } } while (0)
    SP_LOADV(0); SP_NORM(0);
    LDS_WAIT(); __syncthreads();
    for (int r = 0; r < 8; ++r) {
        const int nb = (F.bx >> 3) + 32 * r; const LAS unsigned char* VTr = VT + (r & 1) * (128 * RS);
        u32x4 uu[4];
#pragma unroll
        for (int b = 0; b < 4; ++b) { const size_t tok = (size_t)nb * 128 + (4 * (wv >> 2) + b) * 16 + fr; uu[b] = __builtin_nontemporal_load((const u32x4*)(UV + tok * 2048 + g * 128 + 32 * (wv & 3) + 8 * fq)); }
        float bsv[4];
#pragma unroll
        for (int b = 0; b < 4; ++b) bsv[b] = karg_in(25)[g * 128 + (4 * (wv >> 2) + b) * 16 + fr];
        if (r < 7) SP_LOADV(r + 1);
        f32x4 acc[2][4];
#pragma unroll
        for (int a = 0; a < 2; ++a)
#pragma unroll
            for (int b = 0; b < 4; ++b) acc[a][b] = (f32x4){0.f, 0.f, 0.f, 0.f};
#pragma unroll
        for (int ks = 0; ks < 4; ++ks) {
            bf16x8 xf[2], yf[4];
#pragma unroll
            for (int a = 0; a < 2; ++a) xf[a] = *(const LAS bf16x8*)(VTr + (32 * (wv & 3) + 8 * (fr >> 2) + 4 * a + (fr & 3)) * RS + (ks * 32 + fq * 8) * 2);
#pragma unroll
            for (int b = 0; b < 4; ++b) yf[b] = *(const LAS bf16x8*)(WL + ((4 * (wv >> 2) + b) * 16 + fr) * RS + (ks * 32 + fq * 8) * 2);
#pragma unroll
            for (int a = 0; a < 2; ++a)
#pragma unroll
                for (int b = 0; b < 4; ++b) acc[a][b] = __builtin_amdgcn_mfma_f32_16x16x32_bf16(xf[a], yf[b], acc[a][b], 0, 0, 0);
        }
        if (r < 7) SP_NORM((r + 1) & 1);
#pragma unroll
        for (int b = 0; b < 4; ++b) { const int i = (4 * (wv >> 2) + b) * 16 + fr; const size_t tok = (size_t)nb * 128 + i; const float bs = bsv[b]; const u32x4 u4 = uu[b];
            u32x4 o; o.x = cvt_pk_bf16(bf_lo(u4.x) * (acc[0][b][0] + bs), bf_hi(u4.x) * (acc[0][b][1] + bs)); o.y = cvt_pk_bf16(bf_lo(u4.y) * (acc[0][b][2] + bs), bf_hi(u4.y) * (acc[0][b][3] + bs));
            o.z = cvt_pk_bf16(bf_lo(u4.z) * (acc[1][b][0] + bs), bf_hi(u4.z) * (acc[1][b][1] + bs)); o.w = cvt_pk_bf16(bf_lo(u4.w) * (acc[1][b][2] + bs), bf_hi(u4.w) * (acc[1][b][3] + bs));
            *(u32x4*)(US + tok * DM + g * 128 + 32 * (wv & 3) + 8 * fq) = o; }
        LDS_WAIT(); __syncthreads();
    }
#undef SP_NORM
#undef SP_LOADV
}

__device__ __forceinline__ void router_phase(Frame& F) {
    const int lane = F.lane, wv = F.wave, tid = F.tid;
    LAS int* CL = (LAS int*)(F.lds + RSCR_OFF); LAS int* BASE = CL + 16; LAS unsigned* TE = (LAS unsigned*)(CL + 32);
    LAS int* TR1 = (LAS int*)(TE + 128); LAS int* TR2 = TR1 + 128; LAS float* TW1 = (LAS float*)(TR2 + 128); LAS float* TW2 = TW1 + 128; LAS float* TRS = TW2 + 128;
    if (tid < 16) CL[tid] = 0;
    float wr[16][8];
#pragma unroll
    for (int j = 0; j < 2; ++j)
#pragma unroll
        for (int e8 = 0; e8 < 8; ++e8) { const int k = 8 * lane + 512 * j + e8; const float g = karg_in(5)[DM + k]; const f32x4 a = *(const f32x4*)(karg_in(27) + k * 8), b = *(const f32x4*)(karg_in(27) + k * 8 + 4);
            wr[j * 8 + e8][0] = a[0] * g; wr[j * 8 + e8][1] = a[1] * g; wr[j * 8 + e8][2] = a[2] * g; wr[j * 8 + e8][3] = a[3] * g; wr[j * 8 + e8][4] = b[0] * g; wr[j * 8 + e8][5] = b[1] * g; wr[j * 8 + e8][6] = b[2] * g; wr[j * 8 + e8][7] = b[3] * g; }
    __syncthreads();
    const bf16_t* HBr = (const bf16_t*)(F.ws + WS_HB);
    const float rsl = rstd_from_rss((const float*)(F.ws + WS_RSS), F.bx * 128 + wv * 16 + (lane & 15));
    u32x4 hw[2]; { const u32x4* hr = (const u32x4*)(HBr + (size_t)(F.bx * 128 + wv * 16) * DM) + lane; hw[0] = __builtin_nontemporal_load(hr); hw[1] = __builtin_nontemporal_load(hr + 64); }
#pragma unroll 2
    for (int q = 0; q < 16; ++q) {
        const int il = wv * 16 + q, t = F.bx * 128 + il;
        const u32x4 w0 = hw[0], w1v = hw[1];
        if (q < 15) { const u32x4* hr = (const u32x4*)(HBr + (size_t)(t + 1) * DM) + lane; hw[0] = __builtin_nontemporal_load(hr); hw[1] = __builtin_nontemporal_load(hr + 64); }
        float lg[8];
#pragma unroll
        for (int e = 0; e < 8; ++e) lg[e] = 0.f;
#pragma unroll
        for (int j = 0; j < 2; ++j) { const u32x4 w = j ? w1v : w0; const float x[8] = {bf_lo(w.x), bf_hi(w.x), bf_lo(w.y), bf_hi(w.y), bf_lo(w.z), bf_hi(w.z), bf_lo(w.w), bf_hi(w.w)};
#pragma unroll
            for (int e8 = 0; e8 < 8; ++e8)
#pragma unroll
                for (int e = 0; e < 8; e += 2) { const f32x2 r = __builtin_elementwise_fma((f32x2){x[e8], x[e8]}, (f32x2){wr[j * 8 + e8][e], wr[j * 8 + e8][e + 1]}, (f32x2){lg[e], lg[e + 1]}); lg[e] = r.x; lg[e + 1] = r.y; } }
        const float rs = __int_as_float(__builtin_amdgcn_readlane(__float_as_int(rsl), q));
        { u32x2 q0, q1;
          q0.x = pk4_fp8(bf_lo(w0.x) * rs, bf_hi(w0.x) * rs, bf_lo(w0.y) * rs, bf_hi(w0.y) * rs); q0.y = pk4_fp8(bf_lo(w0.z) * rs, bf_hi(w0.z) * rs, bf_lo(w0.w) * rs, bf_hi(w0.w) * rs);
          q1.x = pk4_fp8(bf_lo(w1v.x) * rs, bf_hi(w1v.x) * rs, bf_lo(w1v.y) * rs, bf_hi(w1v.y) * rs); q1.y = pk4_fp8(bf_lo(w1v.z) * rs, bf_hi(w1v.z) * rs, bf_lo(w1v.w) * rs, bf_hi(w1v.w) * rs);
          u32x2* h8 = (u32x2*)(F.ws + WS_HB8 + (size_t)t * DM) + lane; h8[0] = q0; h8[64] = q1; }
        { float k4[4], k2[2], k1;
#pragma unroll
          for (int i = 0; i < 4; ++i) k4[i] = tr32(lg[i], lg[i + 4]);
#pragma unroll
          for (int i = 0; i < 2; ++i) k2[i] = tr16(k4[i], k4[i + 2]);
          k1 = tr8(k2[0], k2[1], lane);
          k1 += xor4(k1); k1 += dpp<DPP_XOR2>(k1); k1 += dpp<DPP_XOR1>(k1);
#pragma unroll
          for (int e = 0; e < 8; ++e) lg[e] = __int_as_float(__builtin_amdgcn_readlane(__float_as_int(k1), 8 * e)) * rs; }
        int i1 = 0; float v1 = lg[0];
#pragma unroll
        for (int e = 1; e < 8; ++e) if (lg[e] > v1) { v1 = lg[e]; i1 = e; }
        int i2 = 0; float v2 = -3.0e38f;
#pragma unroll
        for (int e = 0; e < 8; ++e) if (e != i1 && lg[e] > v2) { v2 = lg[e]; i2 = e; }
        const float e2 = __expf(v2 - v1), w1 = 1.0f / (1.0f + e2), w2 = e2 / (1.0f + e2);
        if (lane == 0) { TE[il] = (unsigned)i1 | ((unsigned)i2 << 8); TW1[il] = w1; TW2[il] = w2;
            TR1[il] = __hip_atomic_fetch_add(&CL[i1], 1, __ATOMIC_RELAXED, __HIP_MEMORY_SCOPE_WORKGROUP); TR2[il] = __hip_atomic_fetch_add(&CL[8 + i2], 1, __ATOMIC_RELAXED, __HIP_MEMORY_SCOPE_WORKGROUP); }
    }
    LDS_WAIT(); __syncthreads();
    if (tid < 16) BASE[tid] = (int)__hip_atomic_fetch_add((unsigned*)(F.ws + WS_CTL) + CW_SEG + 16 * tid, (unsigned)CL[tid], __ATOMIC_RELAXED, __HIP_MEMORY_SCOPE_AGENT);
    LDS_WAIT(); __syncthreads();
    if (tid < 128) { const unsigned te = TE[tid]; const int e1 = (int)(te & 0xffu), e2 = (int)(te >> 8), t = F.bx * 128 + tid;
        const int s1 = e1 * SEGCAP + BASE[e1] + TR1[tid], s2 = (8 + e2) * SEGCAP + BASE[8 + e2] + TR2[tid];
        int* STOK = (int*)(F.ws + WS_STOK); float* SGW = (float*)(F.ws + WS_SGW);
        STOK[s1] = t; SGW[s1] = TW1[tid]; STOK[s2] = t; SGW[s2] = TW2[tid]; ((int*)(F.ws + WS_TSL))[2 * t] = s1; ((int*)(F.ws + WS_TSL))[2 * t + 1] = s2; }
}
__device__ __forceinline__ void moe_tables(Frame& F) {
    LAS int* MT = (LAS int*)(F.lds + MT_OFF); LAS int* CN = MT + 32;
    if (F.tid < 16) CN[F.tid] = (int)__hip_atomic_load((unsigned*)(F.ws + WS_CTL) + CW_SEG + 16 * F.tid, __ATOMIC_RELAXED, __HIP_MEMORY_SCOPE_AGENT);
    LDS_WAIT(); __syncthreads();
    if (F.tid == 0) { int a = 0; for (int s = 0; s < 16; ++s) { MT[s] = a; a += (CN[s] + 255) >> 8; } MT[16] = a; }
    LDS_WAIT(); __syncthreads();
}
#ifndef FK_MOE_WGM
#define FK_MOE_WGM 8
#endif
struct MoeOrder {
    const char* A; const char* W; size_t wstride; int lda_b, ldb_b, nN, G, c; const LAS int* MT; int gather_a; const int* stok; int rev;
    int mode;
    __device__ __forceinline__ bool next(int i, Unit& u) const {
        const int T = MT[16]; int pm, pn;
        if (mode == 2) { if (i > 0 || c >= 4 * (T - 256)) return false; pm = 256 + (c >> 2); pn = c & 3; }
        else { const int nM = (mode == 1 && T > 256) ? 256 : T; if (!tile_order(i, G, c, nM, nN, pm, pn, FK_MOE_WGM)) return false;
            if (rev) pm = nM - 1 - pm; }
        int s = 0;
#pragma unroll
        for (int q = 1; q < 16; ++q) s += (pm >= MT[q]) ? 1 : 0;
        const int tis = pm - MT[s], cnt = MT[32 + s];
        u.pm = s * SEGCAP + tis * BM; u.aux2 = cnt - tis * BM; u.pn = pn; u.aux = pm;
        u.A = gather_a ? A : A + (size_t)pm * BM * lda_b; u.B = W + (size_t)(s & 7) * wstride + (size_t)pn * BM * ldb_b; return true; }
};

__device__ __forceinline__ f32x4 bfx4_lo(const u32x4 a) { return (f32x4){bf_lo(a.x), bf_hi(a.x), bf_lo(a.y), bf_hi(a.y)}; }
__device__ __forceinline__ f32x4 bfx4_hi(const u32x4 a) { return (f32x4){bf_lo(a.z), bf_hi(a.z), bf_lo(a.w), bf_hi(a.w)}; }
__device__ __forceinline__ void final_rows(Frame& F, const int mode, const int R) {
    const int lane = F.lane;
    const LAS int* MT = (const LAS int*)(F.lds + MT_OFF);
    const f32x4 g0 = ((const f32x4*)karg_in(6))[2 * lane], g1 = ((const f32x4*)karg_in(6))[2 * lane + 1], g2 = ((const f32x4*)karg_in(6))[128 + 2 * lane], g3 = ((const f32x4*)karg_in(6))[128 + 2 * lane + 1];
    const bf16_t* HB = (const bf16_t*)(F.ws + WS_HB); const bf16_t* Y = (const bf16_t*)(F.ws + WS_Y); const int* TSL = (const int*)(F.ws + WS_TSL);
    const int NW = (mode == 0 ? F.G - R : F.G) * 8, w = (mode == 0 ? F.bx - R : F.bx) * 8 + F.wave;
    const int rb = (int)(((long long)w * NTOK) / NW), n = (int)(((long long)(w + 1) * NTOK) / NW) - rb;
    const int rr = rb + lane < NTOK ? rb + lane : NTOK - 1;
    const int s1 = TSL[2 * rr], s2 = TSL[2 * rr + 1];
    const int cv1 = MT[s1 >> 15] * BM + (s1 & (SEGCAP - 1)), cv2 = MT[s2 >> 15] * BM + (s2 & (SEGCAP - 1));
    const unsigned late = (unsigned)__ballot((cv1 >= 65536 || cv2 >= 65536) && lane < n), valid = (n >= 32) ? 0xffffffffu : ((1u << n) - 1u);
    unsigned todo = __builtin_amdgcn_readfirstlane((mode == 0 ? ~late : late) & valid);
    u32x4 a[2], b[2], a1[2], b1[2], a2[2], b2[2];
    unsigned lo_ = (unsigned)lane * 16u, so_ = (unsigned)lane * 32u; asm volatile("" : "+v"(lo_), "+v"(so_));
#define FIN_NEXT(iv) do { iv = todo ? (int)__builtin_ctz(todo) : -1; todo &= todo - 1u; } while (0)
#define FIN_LOAD(buf, i) do { const int c1 = __builtin_amdgcn_readlane(cv1, (i)), c2 = __builtin_amdgcn_readlane(cv2, (i)); \
            const char* p = (const char*)(HB + (size_t)(rb + (i)) * DM) + lo_; const char* y1 = (const char*)(Y + (size_t)c1 * DM) + lo_; const char* y2 = (const char*)(Y + (size_t)c2 * DM) + lo_; \
            a[buf] = __builtin_nontemporal_load((const u32x4*)p); b[buf] = __builtin_nontemporal_load((const u32x4*)(p + 1024)); a1[buf] = __builtin_nontemporal_load((const u32x4*)y1); b1[buf] = __builtin_nontemporal_load((const u32x4*)(y1 + 1024)); \
            a2[buf] = __builtin_nontemporal_load((const u32x4*)y2); b2[buf] = __builtin_nontemporal_load((const u32x4*)(y2 + 1024)); } while (0)
#define FIN_DO(cb, i) do { \
            const f32x4 v0 = bfx4_lo(a[cb]) + bfx4_lo(a1[cb]) + bfx4_lo(a2[cb]), v1 = bfx4_hi(a[cb]) + bfx4_hi(a1[cb]) + bfx4_hi(a2[cb]), v2 = bfx4_lo(b[cb]) + bfx4_lo(b1[cb]) + bfx4_lo(b2[cb]), v3 = bfx4_hi(b[cb]) + bfx4_hi(b1[cb]) + bfx4_hi(b2[cb]); \
            float s = ((v0[0] * v0[0] + v0[1] * v0[1]) + (v0[2] * v0[2] + v0[3] * v0[3])) + ((v1[0] * v1[0] + v1[1] * v1[1]) + (v1[2] * v1[2] + v1[3] * v1[3])); \
            s += ((v2[0] * v2[0] + v2[1] * v2[1]) + (v2[2] * v2[2] + v2[3] * v2[3])) + ((v3[0] * v3[0] + v3[1] * v3[1]) + (v3[2] * v3[2] + v3[3] * v3[3])); \
            const float rs = rsqrtf(wave_sum(s) * (1.0f / DM) + 1e-6f); \
            char* o = (char*)(F.H + (size_t)(rb + (i)) * DM) + so_; \
            *(f32x4*)o = v0 * rs * g0; *(f32x4*)(o + 16) = v1 * rs * g1; *(f32x4*)(o + 2048) = v2 * rs * g2; *(f32x4*)(o + 2064) = v3 * rs * g3; } while (0)
    while (todo) {
        int ia, ib; FIN_NEXT(ia); FIN_NEXT(ib);
        const int ibl = ib >= 0 ? ib : ia;
        FIN_LOAD(0, ia); FIN_LOAD(1, ibl);
        FIN_DO(0, ia);
        if (ib >= 0) FIN_DO(1, ib);
    }
#undef FIN_NEXT
#undef FIN_LOAD
#undef FIN_DO
}
constexpr int NPHASE = 19;
__global__ void __launch_bounds__(512, 2) mega(Args args) {
    extern __shared__ __attribute__((aligned(16))) unsigned char lds_raw[];
    Frame F;
    F.lds = (LAS unsigned char*)lds_raw;
    F.tid = threadIdx.x; F.lane = F.tid & 63; F.wave = __builtin_amdgcn_readfirstlane(F.tid >> 6); F.G = gridDim.x; F.bx = blockIdx.x;
    F.H = args.out; F.ws = args.ws;
    unsigned char* ws = args.ws;
    volatile LAS unsigned* MISC = (volatile LAS unsigned*)(F.lds + MISC_OFF);
    for (int u = F.tid; u < (LDS_BYTES - LDSCTL_OFF) / 4; u += 512) ((LAS unsigned*)(F.lds + LDSCTL_OFF))[u] = 0u;
    __syncthreads();
    const int lo = args.ph_lo, hi = args.ph_hi;
    const bool use_bar = (hi - lo) > 1;
    XcdBarrier bar; bar.bar = (unsigned*)(ws + WS_CTL) + CW_BAR; bar.x = 0; bar.st = nullptr;
    if (use_bar) bar = xcd_barrier_post((unsigned*)(ws + WS_CTL) + CW_BAR, MISC + 8);
#ifndef FK_PHASE_MASK
#define FK_PHASE_MASK 0x7ffff
#endif
#define IN(k) (((FK_PHASE_MASK >> (k)) & 1) && lo <= (k) && (k) < hi)
#define SEAM(k) do { if (IN((k) + 1)) xcd_barrier(bar); } while (0)
#ifndef FK_REV3
#define FK_REV3 0
#endif
#ifndef FK_REV8
#define FK_REV8 0
#endif
#ifndef FK_REV12
#define FK_REV12 0
#endif
#ifndef FK_ATT8
#define FK_ATT8 1
#endif
#ifndef FK_FFN8
#define FK_FFN8 1
#endif
#ifndef FK_REPEAT_MASK
#define FK_REPEAT_MASK 0
#endif
#define REP(k) ((FK_REPEAT_MASK >> (k)) & 1)
#ifdef FK_TPROBE
#define TP_BEGIN(k) do { if ((k) == FK_TPROBE && blockIdx.x == 0 && F.tid == 0) *(volatile unsigned long long*)(ws + 32768) = __builtin_amdgcn_s_memrealtime(); } while (0)
#define TP_END(k) do { if ((k) == FK_TPROBE && blockIdx.x == 0 && F.tid == 0) *(volatile unsigned long long*)(ws + 32776) = __builtin_amdgcn_s_memrealtime() - *(volatile unsigned long long*)(ws + 32768); } while (0)
#else
#define TP_BEGIN(k) do { } while (0)
#define TP_END(k) do { } while (0)
#endif
#ifdef FK_TPROBE2
#define TP2_FLAG(k) do { if (F.tid == 0) MISC[20] = ((k) == FK_TPROBE2) ? 1u : 0u; LDS_WAIT(); __syncthreads(); } while (0)
#define TP2_OUT(k) do { if ((k) == FK_TPROBE2 && blockIdx.x == 0 && F.tid == 0) *(volatile unsigned long long*)(ws + 32776) = *(volatile LAS unsigned long long*)(F.lds + MISC_OFF + 96); } while (0)
#else
#define TP2_FLAG(k) do { } while (0)
#define TP2_OUT(k) do { } while (0)
#endif
#ifdef FK_TPROBE3
#define TP3_A(k) do { if ((k) == FK_TPROBE3 && blockIdx.x == FK_TP3_BLOCK && F.tid == 0) *(volatile unsigned long long*)(ws + 32768) = __builtin_amdgcn_s_memrealtime(); } while (0)
#define TP3_B(k) do { if ((k) == FK_TPROBE3 && blockIdx.x == FK_TP3_BLOCK && F.tid == 0) *(volatile unsigned long long*)(ws + 32776) = __builtin_amdgcn_s_memrealtime() - *(volatile unsigned long long*)(ws + 32768); } while (0)
#else
#define TP3_A(k) do { } while (0)
#define TP3_B(k) do { } while (0)
#endif
#define SEAMB(k) do { if (IN((k) + 1)) xcd_barrier_bg(bar, F); } while (0)
#define PHASEB(k, ...) if (IN(k)) { TP_BEGIN(k); { __VA_ARGS__ } SEAMB(k); TP_END(k); }
#define PHASE(k, ...) if (IN(k)) { TP2_FLAG(k); TP_BEGIN(k); { __VA_ARGS__ } if (REP(k)) { if (use_bar) xcd_barrier(bar); { __VA_ARGS__ } } TP3_A(k); SEAM(k); TP3_B(k); TP_END(k); TP2_OUT(k); }
    LAS unsigned char* ring = F.lds + RING_OFF; LAS float* TAB = (LAS float*)(F.lds + TAB_OFF);
    float* RSS = (float*)(ws + WS_RSS); bf16_t* HB = (bf16_t*)(ws + WS_HB);
    const int c = (int)blockIdx.x, G = (int)gridDim.x;

    PHASEB(0, p0_prologue(F);)
    PHASEB(1, if (c >= 64) x_rows(F, X_SPLIT, NTOK, (c - 64) * 8 + F.wave, (G - 64) * 8);
        KvOrder S{(const char*)(ws + WS_MEMN), (const char*)(ws + WS_WKT), G, c}; EpiPlain E{(bf16_t*)(ws + WS_KP), DM, (size_t)DM * DM};
        gemm_phase<EpiPlain, KvOrder>(ring, DM, DM, DM, S, E);)
    PHASEB(3, DenseOrder S; S.init(HB, ws + WS_WIN0, NTOK, 2560, DM, DM, G, c); S.rev = FK_REV3; EpiGluZ E{(bf16_t*)(ws + WS_ZB), RSS};
        gemm_phase<EpiGluZ, DenseOrder>(ring, DM, DM, DM, S, E);)
    PHASE(4, conv_phase(F); LDS_WAIT(); __syncthreads();
        { MkVwOrder S{(const char*)(ws + WS_KP), (const char*)(ws + WS_WQS), (const char*)(ws + WS_WOT), G, c}; if constexpr (FK_ATT8) { EpiPlain8 E{ws + WS_MK}; gemm_phase<EpiPlain8, MkVwOrder>(ring, 256, DM, DM, S, E); }
        else { EpiPlain E{(bf16_t*)(ws + WS_MK), DM, (size_t)DM * DM}; gemm_phase<EpiPlain, MkVwOrder>(ring, 256, DM, DM, S, E); } } if (BG_HEAD) { LDS_WAIT(); __syncthreads(); bg_drain_to(F, MISC + 12, (unsigned)BG_HEAD); })
    PHASEB(5, DenseOrder S; S.init(ws + WS_MIX, ws + WS_WOUT0, NTOK, DM, DM, DM, G, c);
        if constexpr (FK_ATT8) { EpiResid<false, false, true> E{HB, HB, RSS, TAB, 1.0f, ws + WS_HB8}; gemm_phase<EpiResid<false, false, true>, DenseOrder>(ring, DM, DM, DM, S, E); }
        else { EpiResid<false> E{HB, HB, RSS, TAB, 1.0f, nullptr}; gemm_phase<EpiResid<false>, DenseOrder>(ring, DM, DM, DM, S, E); })
    PHASEB(6, if constexpr (FK_ATT8) { DenseOrder S; S.init(ws + WS_HB8, ws + WS_MK + (size_t)0 * DM * DM, NTOK, DM, DM, DM, G, c, 32, (size_t)DM * DM); S.es = 1; EpiSoftmax<true> E{(bf16_t*)(ws + WS_PB), RSS, TAB};
            gemm_phase<EpiSoftmax<true>, DenseOrder, false, true>(ring, DM, DM, DM, S, E); }
        else { DenseOrder S; S.init(HB, ws + WS_MK + (size_t)0 * DM * DM * 2, NTOK, DM, DM, DM, G, c, 32, (size_t)DM * DM * 2); EpiSoftmax<false> E{(bf16_t*)(ws + WS_PB), RSS, TAB};
            gemm_phase<EpiSoftmax<false>, DenseOrder>(ring, DM, DM, DM, S, E); })
    PHASEB(7, if constexpr (FK_ATT8) { DenseOrder S; S.init(ws + WS_PB, ws + WS_MK + (size_t)8 * DM * DM, NTOK, DM, DM, DM, G, c, 32, (size_t)DM * DM); S.es = 1; EpiResid<false, true, FK_FFN8 != 0> E{HB, HB, RSS, TAB, 1.0f / (P8_SCALE * VW8_SCALE), ws + WS_HB8};
            gemm_phase<EpiResid<false, true, FK_FFN8 != 0>, DenseOrder, false, true>(ring, DM, DM, DM, S, E); }
        else { DenseOrder S; S.init(ws + WS_PB, ws + WS_MK + (size_t)8 * DM * DM * 2, NTOK, DM, DM, DM, G, c, 32, (size_t)DM * DM * 2); EpiResid<false> E{HB, HB, RSS, TAB, 1.0f, nullptr};
            gemm_phase<EpiResid<false>, DenseOrder>(ring, DM, DM, DM, S, E); })
#if FK_FFN8
    PHASEB(8, DenseOrder S; S.init(ws + WS_HB8, ws + WS_WGU0, NTOK, 2 * DFF, DM, DM, G, c); S.es = 1; S.rev = FK_REV8; EpiSwiGLU<false> E{(bf16_t*)(ws + WS_ACT0), DFF, RSS, W8_INV};
        gemm_phase<EpiSwiGLU<false>, DenseOrder, false, true>(ring, DM, DM, DM, S, E);)
#else
    PHASEB(8, DenseOrder S; S.init(HB, ws + WS_WGU0, NTOK, 2 * DFF, DM, DM, G, c); S.rev = FK_REV8; EpiSwiGLU<false> E{(bf16_t*)(ws + WS_ACT0), DFF, RSS, 1.0f};
        gemm_phase<EpiSwiGLU<false>, DenseOrder>(ring, DM, DM, DM, S, E);)
#endif
    PHASEB(9, DenseOrder S; S.init(ws + WS_ACT0, ws + WS_WD0, NTOK, DM, DFF, DFF, G, c); S.rev = 1; EpiResid<false> E{HB, HB, RSS, TAB, 1.0f, nullptr};
        gemm_phase<EpiResid<false>, DenseOrder>(ring, DFF, DFF, DFF, S, E);)
    PHASEB(10, DenseOrder S; S.init(HB, ws + WS_WSG, NTOK, 2048, DM, DM, G, c); EpiGeluUV E{(bf16_t*)(ws + WS_UV), RSS, (f32x2*)(ws + WS_VST), TAB};
        gemm_phase<EpiGeluUV, DenseOrder>(ring, DM, DM, DM, S, E);)
    PHASE(11, spatial_phase(F);)
    PHASEB(12, DenseOrder S; S.init(ws + WS_US, ws + WS_WSO, NTOK, DM, DM, DM, G, c); S.rev = FK_REV12;
        if constexpr (FK_ATT8) { EpiResid<false, false, true> E{HB, HB, RSS, TAB, 1.0f, ws + WS_HB8}; gemm_phase<EpiResid<false, false, true>, DenseOrder>(ring, DM, DM, DM, S, E); }
        else { EpiResid<false> E{HB, HB, RSS, TAB, 1.0f, nullptr}; gemm_phase<EpiResid<false>, DenseOrder>(ring, DM, DM, DM, S, E); })
    PHASEB(13, if constexpr (FK_ATT8) { DenseOrder S; S.init(ws + WS_HB8, ws + WS_MK + (size_t)4 * DM * DM, NTOK, DM, DM, DM, G, c, 32, (size_t)DM * DM); S.es = 1; EpiSoftmax<true> E{(bf16_t*)(ws + WS_PB), RSS, TAB};
            gemm_phase<EpiSoftmax<true>, DenseOrder, false, true>(ring, DM, DM, DM, S, E); }
        else { DenseOrder S; S.init(HB, ws + WS_MK + (size_t)4 * DM * DM * 2, NTOK, DM, DM, DM, G, c, 32, (size_t)DM * DM * 2); EpiSoftmax<false> E{(bf16_t*)(ws + WS_PB), RSS, TAB};
            gemm_phase<EpiSoftmax<false>, DenseOrder>(ring, DM, DM, DM, S, E); })
    PHASEB(14, if constexpr (FK_ATT8) { DenseOrder S; S.init(ws + WS_PB, ws + WS_MK + (size_t)12 * DM * DM, NTOK, DM, DM, DM, G, c, 32, (size_t)DM * DM); S.es = 1; EpiResid<false, true, false> E{HB, HB, RSS, TAB, 1.0f / (P8_SCALE * VW8_SCALE), nullptr};
            gemm_phase<EpiResid<false, true, false>, DenseOrder, false, true>(ring, DM, DM, DM, S, E); }
        else { DenseOrder S; S.init(ws + WS_PB, ws + WS_MK + (size_t)12 * DM * DM * 2, NTOK, DM, DM, DM, G, c, 32, (size_t)DM * DM * 2); EpiResid<false> E{HB, HB, RSS, TAB, 1.0f, nullptr};
            gemm_phase<EpiResid<false>, DenseOrder>(ring, DM, DM, DM, S, E); })
    PHASE(15, router_phase(F); LDS_WAIT(); __syncthreads(); bg_drain_to(F, MISC + 12, (unsigned)BG_ITEMS);)
    if (hi > 16) moe_tables(F);
    const LAS int* MT = (const LAS int*)(F.lds + MT_OFF);
    PHASE(16, MoeOrder S{(const char*)(ws + WS_HB8), (const char*)(ws + WS_WGU1), (size_t)2 * DFF * DM, DM, DM, 22, G, c, MT, 1, (const int*)(ws + WS_STOK), 0, 0}; EpiSwiGLU8 E{(unsigned char*)(ws + WS_ACT8)};
        gemm_phase<EpiSwiGLU8, MoeOrder, true, true>(ring, DM, DM, DM, S, E);)
    if (IN(17)) { TP_BEGIN(17);
        const int T_ = MT[16], R_ = 4 * (T_ - 256);
        for (int pass = 0; pass < 3; ++pass) {
            asm volatile("" : "+s"(pass));
            if (pass > 0) xcd_barrier(bar);
            if (pass == 0 || (pass == 1 && c < R_)) { MoeOrder S{(const char*)(ws + WS_ACT8), (const char*)(ws + WS_WD1), (size_t)DM * DFF, DFF, DFF, 4, G, c, MT, 0, nullptr, 0, pass + 1}; EpiMoeDown8 E{(bf16_t*)(ws + WS_Y), (const float*)(ws + WS_SGW)};
                gemm_phase<EpiMoeDown8, MoeOrder, false, true>(ring, DFF, DFF, DFF, S, E); }
            else final_rows(F, pass - 1, R_);
        }
        TP_END(17); }
#undef IN
#undef SEAM
}

#if defined(FK_TPROBE) || defined(FK_TPROBE2) || defined(FK_TPROBE3)
#if defined(FK_TPROBE2) || defined(FK_TPROBE3)
#define FK_TPAMP 64ull
#else
#define FK_TPAMP 8ull
#endif
__global__ void k_tprobe_spin(const unsigned char* ws) { const unsigned long long d = *(const volatile unsigned long long*)(ws + 32776), te = __builtin_amdgcn_s_memrealtime(); while (__builtin_amdgcn_s_memrealtime() - te < FK_TPAMP * d) __builtin_amdgcn_s_sleep(32); }
#endif
static int fk_grid = 0;
static bool fk_setup() {
    if (fk_grid == 0) {
        int dev = 0, cus = 0, per_cu = 0;
        if (hipGetDevice(&dev) != hipSuccess || hipDeviceGetAttribute(&cus, hipDeviceAttributeMultiprocessorCount, dev) != hipSuccess) { fk_grid = -1; return false; }
        if (hipFuncSetAttribute((const void*)mega, hipFuncAttributeMaxDynamicSharedMemorySize, LDS_BYTES) != hipSuccess) { fprintf(stderr, "hipFuncSetAttribute failed\n"); fk_grid = -1; return false; }
        if (hipOccupancyMaxActiveBlocksPerMultiprocessor(&per_cu, (const void*)mega, 512, LDS_BYTES) != hipSuccess || per_cu < 1) fprintf(stderr, "note: occupancy query says %d\n", per_cu);
        (void)hipGetLastError();
        fk_grid = 256;
        if (cus != 256) fprintf(stderr, "note: %d CUs reported; this kernel is built for 256\n", cus);
    }
    return fk_grid > 0;
}
static void fk_run(hipStream_t stream, void* const* d_in, void* d_out, void* d_ws, int lo, int hi, bool per_phase) {
    if (!fk_setup()) return;
    Args a{};
    for (int i = 0; i < 31; ++i) a.in[i] = (const float*)d_in[i];
    a.out = (float*)d_out; a.ws = (unsigned char*)d_ws;
#ifndef FK_HOST_REPEAT_MASK
#define FK_HOST_REPEAT_MASK 0
#endif
    if (per_phase) { for (int p = lo; p < hi; ++p) { a.ph_lo = p; a.ph_hi = p + 1; const int reps = ((FK_HOST_REPEAT_MASK >> p) & 1) ? 2 : 1;
        for (int q = 0; q < reps; ++q) hipLaunchKernelGGL(mega, dim3(fk_grid), dim3(512), LDS_BYTES, stream, a); } }
    else { a.ph_lo = lo; a.ph_hi = hi; hipLaunchKernelGGL(mega, dim3(fk_grid), dim3(512), LDS_BYTES, stream, a); }
#if defined(FK_TPROBE) || defined(FK_TPROBE2) || defined(FK_TPROBE3)
    hipLaunchKernelGGL(k_tprobe_spin, dim3(1), dim3(1), 0, stream, (const unsigned char*)d_ws);
#endif
    const hipError_t le = hipPeekAtLastError();
    if (le != hipSuccess) fprintf(stderr, "kernel_launch: launch failed: %s\n", hipGetErrorName(le));
}
}

#ifndef FK_MODE
#define FK_MODE 1
#endif
#ifndef FK_NSUB
#define FK_NSUB 1
#endif
extern "C" void kernel_launch(void* const* d_in, const int* in_sizes, int n_in, void* d_out, int out_size, void* d_ws, size_t ws_size, hipStream_t stream) {
    if (n_in != 31 || out_size != fk::NTOK * fk::DM || ws_size < fk::WS_END) { fprintf(stderr, "kernel_launch: unexpected shapes (n_in %d out %d ws %zu)\n", n_in, out_size, ws_size); return; }
    (void)hipMemsetAsync((char*)d_ws + fk::WS_CTL, 0, fk::CTL_ZERO_BYTES, stream);
#if FK_MODE == 1
    fk::fk_run(stream, d_in, d_out, d_ws, 0, fk::NPHASE, false);
#elif FK_MODE == 2
    fk::fk_run(stream, d_in, d_out, d_ws, 0, fk::NPHASE, true);
#elif FK_MODE == 3
    { constexpr int endph[7] = {0, 6, 8, 10, 13, 15, 18};
      float* h = (float*)d_out;
      if (FK_NSUB == 0) (void)hipMemcpyAsync(h, d_in[0], (size_t)nv::NTOK * nv::DM * 4, hipMemcpyDeviceToDevice, stream);
      else fk::fk_run(stream, d_in, d_out, d_ws, 0, endph[FK_NSUB], true);
      const nv::Bufs B = nv::carve(d_ws);
      for (int s = FK_NSUB; s < 6; ++s) nv::sublayer(stream, s, h, d_in, B);
      nv::final_norm(stream, h, d_in); }
#else
    { float* h = (float*)d_out;
      (void)hipMemcpyAsync(h, d_in[0], (size_t)nv::NTOK * nv::DM * 4, hipMemcpyDeviceToDevice, stream);
      const nv::Bufs B = nv::carve(d_ws);
      for (int s = 0; s < 6; ++s) nv::sublayer(stream, s, h, d_in, B);
      nv::final_norm(stream, h, d_in); }
#endif
}
```
